# Optimizing an MI355X kernel written in HIP

```python
import math
import jax, jax.numpy as jnp
from jax import lax
import numpy as np

D_MODEL = 1024
BATCH = 2
SEQ = 8192
DEPTH = 4

BRANCH_WIDTH = D_MODEL // 2
N_BRANCHES = 3
GDN_HEAD_DIM = 128
GDN_HEADS = BRANCH_WIDTH // GDN_HEAD_DIM
GDN_CONV = 4
GDN_CHUNK = 64
DIFF_V_DIM = 128
DIFF_QK_DIM = DIFF_V_DIM // 2
DIFF_HEADS = BRANCH_WIDTH // DIFF_V_DIM
Q_BLOCK = 128
SC_CONV = 3
NORM_EPS = 1e-6
NEG_INF = -1e30
SPLIT_SIZES = (3 * BRANCH_WIDTH, BRANCH_WIDTH, GDN_HEADS, GDN_HEADS,
               BRANCH_WIDTH, BRANCH_WIDTH, BRANCH_WIDTH, BRANCH_WIDTH,
               BRANCH_WIDTH, BRANCH_WIDTH, BRANCH_WIDTH, BRANCH_WIDTH,
               N_BRANCHES * D_MODEL)
N_IN = sum(SPLIT_SIZES)

kernel_name = 'hybrid_gdn_diffattn_shortconv_block'


def rms_norm(x, w, eps=NORM_EPS):
    x32 = x.astype(jnp.float32)
    y = x32 * lax.rsqrt(jnp.mean(x32 * x32, axis=-1, keepdims=True) + eps)
    return (y * w.astype(jnp.float32)).astype(x.dtype)


def l2_normalize(x, eps=1e-6):
    return x * lax.rsqrt(jnp.sum(x * x, axis=-1, keepdims=True) + eps)


def causal_dwconv(x, w):
    k_width, channels = w.shape
    return lax.conv_general_dilated(
        x, w[:, None, :].astype(x.dtype), window_strides=(1,),
        padding=[(k_width - 1, 0)], dimension_numbers=('NWC', 'WIO', 'NWC'),
        feature_group_count=channels)


def alibi_slopes(n_heads):
    return 2.0 ** (-8.0 * jnp.arange(1, n_heads + 1, dtype=jnp.float32) / n_heads)


def chunk_gated_delta_rule(q, k, v, g, beta):
    bsz, seq, n_h, dk = q.shape
    dv = v.shape[-1]
    n_chunks = seq // GDN_CHUNK

    def to_chunks(t):
        t = jnp.moveaxis(t, 2, 1)
        return t.reshape(t.shape[:2] + (n_chunks, GDN_CHUNK) + t.shape[3:])

    q = to_chunks(q * dk ** -0.5)
    k = to_chunks(k)
    v = to_chunks(v)
    beta = to_chunks(beta)
    g = jnp.cumsum(to_chunks(g), axis=-1)
    k_beta = k * beta[..., None]
    v_beta = v * beta[..., None]
    tril = jnp.tril(jnp.ones((GDN_CHUNK, GDN_CHUNK), bool))
    strict = jnp.tril(jnp.ones((GDN_CHUNK, GDN_CHUNK), bool), k=-1)
    decay = jnp.exp(jnp.where(tril, g[..., :, None] - g[..., None, :], -jnp.inf))
    lower = jnp.where(strict, jnp.einsum('bhncd,bhnsd->bhncs', k_beta, k) * decay, 0.0)
    unit_lower = lower + jnp.eye(GDN_CHUNK, dtype=lower.dtype)
    rhs = jnp.concatenate([v_beta, k_beta * jnp.exp(g)[..., None]], axis=-1)
    sol = lax.linalg.triangular_solve(unit_lower, rhs, left_side=True, lower=True,
                                      unit_diagonal=True)
    u, w = sol[..., :dv], sol[..., dv:]
    qk = jnp.where(tril, jnp.einsum('bhncd,bhnsd->bhncs', q, k) * decay, 0.0)
    q_dec = q * jnp.exp(g)[..., None]
    k_dec = k * jnp.exp(g[..., -1:] - g)[..., None]
    g_last = jnp.exp(g[..., -1])

    def step(state, inp):
        u_c, w_c, qk_c, q_dec_c, k_dec_c, g_last_c = inp
        v_new = u_c - w_c @ state
        o_c = q_dec_c @ state + qk_c @ v_new
        state = state * g_last_c[..., None, None] + jnp.einsum('bhcd,bhce->bhde', k_dec_c, v_new)
        return state, o_c

    xs = [jnp.moveaxis(t, 2, 0) for t in (u, w, qk, q_dec, k_dec, g_last)]
    state0 = jnp.zeros((bsz, n_h, dk, dv), jnp.float32)
    _, o = lax.scan(step, state0, tuple(xs))
    o = jnp.moveaxis(o, 0, 2).reshape(bsz, n_h, seq, dv)
    return jnp.moveaxis(o, 1, 2)


def gdn_branch(qkv_pre, z, b, a, conv_w, a_log, dt_bias, norm_w):
    bsz, seq, _ = qkv_pre.shape
    qkv = jax.nn.silu(causal_dwconv(qkv_pre, conv_w)).astype(jnp.float32)
    q, k, v = jnp.split(qkv, 3, axis=-1)
    shp = (bsz, seq, GDN_HEADS, GDN_HEAD_DIM)
    q = l2_normalize(q.reshape(shp))
    k = l2_normalize(k.reshape(shp))
    v = v.reshape(shp)
    beta = jax.nn.sigmoid(b.astype(jnp.float32))
    g = -jnp.exp(a_log.astype(jnp.float32)) * jax.nn.softplus(
        a.astype(jnp.float32) + dt_bias.astype(jnp.float32))
    o = chunk_gated_delta_rule(q, k, v, g, beta)
    o = rms_norm(o.astype(z.dtype), norm_w).reshape(bsz, seq, BRANCH_WIDTH)
    return o * jax.nn.silu(z)


def diff_attn_branch(q, k, v, z, lam_vecs, lam_init, norm_w):
    bsz, seq, _ = q.shape
    q = (q * DIFF_QK_DIM ** -0.5).reshape(bsz, seq, DIFF_HEADS, 2, DIFF_QK_DIM)
    k = k.reshape(bsz, seq, DIFF_HEADS, 2, DIFF_QK_DIM)
    v = v.reshape(bsz, seq, DIFF_HEADS, DIFF_V_DIM)
    lv = lam_vecs.astype(jnp.float32)
    lam = jnp.exp(jnp.sum(lv[0] * lv[1])) - jnp.exp(jnp.sum(lv[2] * lv[3])) + lam_init
    slopes = alibi_slopes(DIFF_HEADS)
    n_blk = seq // Q_BLOCK
    q_blocks = jnp.moveaxis(q.reshape(bsz, n_blk, Q_BLOCK, DIFF_HEADS, 2, DIFF_QK_DIM), 1, 0)
    k_pos = jnp.arange(seq)

    def attend(args):
        q_blk, blk = args
        s = jnp.einsum('bqhmd,bkhmd->bhmqk', q_blk, k).astype(jnp.float32)
        dist = (blk * Q_BLOCK + jnp.arange(Q_BLOCK))[:, None] - k_pos[None, :]
        s = jnp.where(dist >= 0, s - slopes[:, None, None, None] * dist.astype(jnp.float32), NEG_INF)
        p = jax.nn.softmax(s, axis=-1)
        p = p[:, :, 0] - lam * p[:, :, 1]
        return jnp.einsum('bhqk,bkhe->bqhe', p.astype(v.dtype), v)

    o = lax.map(attend, (q_blocks, jnp.arange(n_blk)))
    o = jnp.moveaxis(o, 0, 1).reshape(bsz, seq, DIFF_HEADS, DIFF_V_DIM)
    o = (rms_norm(o, norm_w) * (1.0 - lam_init)).reshape(bsz, seq, BRANCH_WIDTH)
    return o * jax.nn.silu(z)


def short_conv_branch(b, c, x_in, z, conv_w):
    y = b * causal_dwconv(c * x_in, conv_w)
    return y * jax.nn.silu(z)


def setup_inputs(seed: int = 0) -> dict:
    key = jax.random.key(seed)
    ks = jax.random.split(key, 14)
    f32 = jnp.float32
    nrm = jax.random.normal
    x = nrm(ks[0], (BATCH, SEQ, D_MODEL), f32)
    norm_pre = 1.0 + 0.1 * nrm(ks[1], (DEPTH, D_MODEL), f32)
    norm_post = 1.0 + 0.1 * nrm(ks[2], (DEPTH, D_MODEL), f32)
    w_in = nrm(ks[3], (DEPTH, D_MODEL, N_IN), f32) * D_MODEL ** -0.5
    gdn_conv_w = nrm(ks[4], (DEPTH, GDN_CONV, 3 * BRANCH_WIDTH), f32) * GDN_CONV ** -0.5
    gdn_a_log = jnp.log(jax.random.uniform(ks[5], (DEPTH, GDN_HEADS), f32, 1.0, 16.0))
    dt = jnp.exp(jax.random.uniform(ks[6], (DEPTH, GDN_HEADS), f32, math.log(1e-3), math.log(1e-1)))
    gdn_dt_bias = dt + jnp.log(-jnp.expm1(-dt))
    gdn_norm_w = 1.0 + 0.1 * nrm(ks[7], (DEPTH, GDN_HEAD_DIM), f32)
    diff_lambda = 0.1 * nrm(ks[8], (DEPTH, 4, DIFF_QK_DIM), f32)
    diff_norm_w = 1.0 + 0.1 * nrm(ks[9], (DEPTH, DIFF_V_DIM), f32)
    sc_conv_w = nrm(ks[10], (DEPTH, SC_CONV, BRANCH_WIDTH), f32) * SC_CONV ** -0.5
    w_branch = nrm(ks[11], (DEPTH, N_BRANCHES, BRANCH_WIDTH, D_MODEL), f32) * BRANCH_WIDTH ** -0.5
    w_out = nrm(ks[12], (DEPTH, D_MODEL, D_MODEL), f32) * D_MODEL ** -0.5
    return {'x': x, 'norm_pre': norm_pre, 'norm_post': norm_post, 'w_in': w_in,
            'gdn_conv_w': gdn_conv_w, 'gdn_a_log': gdn_a_log, 'gdn_dt_bias': gdn_dt_bias,
            'gdn_norm_w': gdn_norm_w, 'diff_lambda': diff_lambda, 'diff_norm_w': diff_norm_w,
            'sc_conv_w': sc_conv_w, 'w_branch': w_branch, 'w_out': w_out}


def reference(x, norm_pre, norm_post, w_in, gdn_conv_w, gdn_a_log, gdn_dt_bias, gdn_norm_w,
              diff_lambda, diff_norm_w, sc_conv_w, w_branch, w_out):
    bsz, seq, _ = x.shape
    split_at = [int(i) for i in np.cumsum(SPLIT_SIZES)[:-1]]
    for l in range(DEPTH):
        h = rms_norm(x, norm_pre[l])
        proj = jnp.einsum('bld,dn->bln', h, w_in[l])
        (gdn_qkv, gdn_z, gdn_b, gdn_a, d_q, d_k, d_v, d_z,
         s_b, s_c, s_x, s_z, merge_logits) = jnp.split(proj, split_at, axis=-1)
        lam_init = 0.8 - 0.6 * math.exp(-0.3 * l)
        y_a = gdn_branch(gdn_qkv, gdn_z, gdn_b, gdn_a, gdn_conv_w[l], gdn_a_log[l],
                         gdn_dt_bias[l], gdn_norm_w[l])
        y_b = diff_attn_branch(d_q, d_k, d_v, d_z, diff_lambda[l], lam_init, diff_norm_w[l])
        y_c = short_conv_branch(s_b, s_c, s_x, s_z, sc_conv_w[l])
        branches = jnp.stack([y_a, y_b, y_c], axis=2)
        branch_out = jnp.einsum('blkw,kwd->blkd', branches, w_branch[l])
        gates = jax.nn.sigmoid(merge_logits.reshape(bsz, seq, N_BRANCHES, D_MODEL))
        merged = jnp.sum(gates * branch_out, axis=2)
        out = jnp.einsum('bld,de->ble', merged, w_out[l])
        x = x + rms_norm(out, norm_post[l])
    return x
```

```cpp
#include <hip/hip_runtime.h>
#include <hip/hip_cooperative_groups.h>
#include <cstdio>
#include <cstdint>
namespace cg = cooperative_groups;
__device__ __forceinline__ int mk_lane() { int r; asm volatile("v_mbcnt_lo_u32_b32 %0, -1, 0\n\tv_mbcnt_hi_u32_b32 %0, -1, %0" : "=v"(r)); return r; }
namespace pg8 {
#define PG8_LAS __attribute__((address_space(3)))
typedef unsigned short bf16_t;
typedef short bf16x8 __attribute__((ext_vector_type(8)));
typedef float f32x4 __attribute__((ext_vector_type(4)));
typedef unsigned u32x4 __attribute__((ext_vector_type(4)));
constexpr int BM = 256, BK = 64, HALF = 128, HTB = HALF * BK * 2  , STAGE_BYTES = 8 * HTB, NXCD = 8, WGM = 8;

__host__ __device__ __forceinline__ int lds_byte(int r, int c) { const int st = (r >> 4) * 2 + (c >> 5), rr = r & 15, cc = c & 31, ob = rr * 64 + cc * 2; return st * 1024 + (ob ^ (((ob >> 9) & 1) << 5)); }
__host__ __device__ __forceinline__ void stage_rc(int b, int& R, int& C) { const int st = b / 1024, sb = b % 1024, swz = sb ^ (((sb >> 9) & 1) << 5); R = (st >> 1) * 16 + swz / 64; C = (st & 1) * 32 + (swz % 64) / 2; }
__host__ __device__ __forceinline__ int perm32(int rho) { const int n = rho >> 4, i = rho & 15; return 8 * (i >> 2) + 4 * n + (i & 3); }

struct Unit { int pm, pn; };
struct Gemm { const bf16_t* A; const bf16_t* Bt; int M, N, K; };

struct StaticOrder {
    int nM, nN, nwg, G, c;
    __host__ __device__ void init(int M, int N, int G_, int c_) { nM = M / BM; nN = N / BM; nwg = nM * nN; G = G_; c = c_; }
    __host__ __device__ bool next(int i, Unit& u) const {
        const long L = (long)i * G + c; if (L >= nwg) return false;
        int wgid = (int)L; { const int q = nwg / NXCD, r = nwg % NXCD, xcd = wgid % NXCD, off = wgid / NXCD; wgid = (xcd < r ? xcd * (q + 1) : r * (q + 1) + (xcd - r) * q) + off; }
        const int nig = WGM * nN, gid = wgid / nig, fm = gid * WGM, gsz = (nM - fm) < WGM ? (nM - fm) : WGM;
        u.pm = fm + ((wgid % nig) % gsz); u.pn = (wgid % nig) / gsz; return true;
    }
    __device__ __forceinline__ void a_ready(const Unit&) const {}
    __device__ __forceinline__ void done(const Unit&) const {}
};
__device__ __forceinline__ unsigned cvt_pk_bf16(float lo, float hi) { unsigned r; asm volatile("v_cvt_pk_bf16_f32 %0, %1, %2" : "=v"(r) : "v"(lo), "v"(hi)); return r; }
typedef float f32x2 __attribute__((ext_vector_type(2)));
template <class Epi, class Sched, bool ALIGN_EPI = false, bool SP2 = false>
__device__ __forceinline__ void gemm_phase(PG8_LAS unsigned char* lds, const Gemm g, const Sched& S, const Epi& E, int wv_) {
    int tid_ = wv_ * 64 + mk_lane(); asm volatile("" : "+v"(tid_)); const int tid = tid_, wid = __builtin_amdgcn_readfirstlane(tid >> 6), lane = tid & 63, wr = wid >> 2, wc = wid & 3, fr = lane & 15, fq = lane >> 4;
    const int K = g.K, nt = K / BK;
    unsigned voffA[2], voffB[2];
#pragma unroll
    for (int i = 0; i < 2; ++i) { int R, C; stage_rc(tid * 16 + i * 8192, R, C); const int Rb = Epi::PERM ? ((R & ~31) + perm32(R & 31)) : R;
        voffA[i] = (unsigned)(R * K + C) * 2u; voffB[i] = (unsigned)(Rb * K + C) * 2u; }
    const size_t kstep = (size_t)(BK * 2);
    const size_t hstep = (size_t)HALF * K * 2;
    const size_t tstep = 2 * hstep;
    const unsigned ldsw = (unsigned)wid * 1024u;
    const int aoff = lds_byte(wr * 64 + fr, fq * 8), boff = lds_byte(wc * 32 + fr, fq * 8);
#define PG8_SA(b, h) (((b) * 2 + (h)) * HTB)
#define PG8_SB(b, h) ((4 + (b) * 2 + (h)) * HTB)
#define PG8_STAGE(bufoff, gbase, voff) do { _Pragma("unroll") for (int _i = 0; _i < 2; ++_i) \
        __builtin_amdgcn_global_load_lds((const unsigned*)((const char*)(gbase) + (voff)[_i]), (PG8_LAS unsigned*)(lds + (bufoff) + ldsw + _i * 8192), 16, 0, 0); } while (0)
#define PG8_LDA(dst, b, h) do { _Pragma("unroll") for (int m = 0; m < 4; ++m) _Pragma("unroll") for (int k = 0; k < 2; ++k) dst[m][k] = *(const PG8_LAS bf16x8*)(lds + PG8_SA(b, h) + aoff + m * 2048 + k * 1024); } while (0)
#define PG8_LDB(dst, b, h) do { _Pragma("unroll") for (int n = 0; n < 2; ++n) _Pragma("unroll") for (int k = 0; k < 2; ++k) dst[n][k] = *(const PG8_LAS bf16x8*)(lds + PG8_SB(b, h) + boff + n * 2048 + k * 1024); } while (0)
#define PG8_MMA(ai, bj, At, Bt) do { __builtin_amdgcn_s_setprio(1); _Pragma("unroll") for (int m = 0; m < 4; ++m) _Pragma("unroll") for (int n = 0; n < 2; ++n) _Pragma("unroll") for (int k = 0; k < 2; ++k) \
        acc[ai][bj][m][n] = __builtin_amdgcn_mfma_f32_16x16x32_bf16(Bt[n][k], At[m][k], acc[ai][bj][m][n], 0, 0, 0); __builtin_amdgcn_s_setprio(0); } while (0)
#define PG8_WAIT_V(n) asm volatile("s_waitcnt vmcnt(" #n ")" ::: "memory")
#define PG8_WAIT_L(n) asm volatile("s_waitcnt lgkmcnt(" #n ")" ::: "memory")
#define PG8_BAR __builtin_amdgcn_s_barrier()
#define PG8_SCHED __builtin_amdgcn_sched_barrier(0)
    Unit cur, nxt; int ui = 0;
    if (!S.next(0, cur)) return;
    f32x4 acc[2][2][4][2];
#pragma unroll
    for (int a = 0; a < 2; ++a)
#pragma unroll
        for (int b = 0; b < 2; ++b)
#pragma unroll
            for (int m = 0; m < 4; ++m)
#pragma unroll
                for (int n = 0; n < 2; ++n) acc[a][b][m][n] = (f32x4){0.f, 0.f, 0.f, 0.f};
    bf16x8 At[4][2], B0[2][2], B1[2][2];
    const char* cA = (const char*)g.A + (size_t)cur.pm * tstep; const char* cB = (const char*)g.Bt + (size_t)cur.pn * tstep;
    S.a_ready(cur);
    if constexpr (SP2) {
        PG8_STAGE(PG8_SB(0, 0), cB, voffB); PG8_STAGE(PG8_SB(0, 1), cB + hstep, voffB); PG8_STAGE(PG8_SA(0, 0), cA, voffA); PG8_STAGE(PG8_SA(0, 1), cA + hstep, voffA);
        if (wr == 1) PG8_BAR;
        PG8_WAIT_V(2); PG8_BAR;
        PG8_STAGE(PG8_SB(1, 0), cB + kstep, voffB); PG8_STAGE(PG8_SA(1, 0), cA + kstep, voffA); PG8_STAGE(PG8_SB(1, 1), cB + hstep + kstep, voffB);
        PG8_WAIT_V(6); PG8_BAR;
    } else {
        PG8_STAGE(PG8_SB(0, 0), cB, voffB); PG8_STAGE(PG8_SA(0, 0), cA, voffA); PG8_STAGE(PG8_SB(0, 1), cB + hstep, voffB); PG8_STAGE(PG8_SA(0, 1), cA + hstep, voffA);
        if (wr == 1) PG8_BAR;
        PG8_WAIT_V(4); PG8_BAR;
        PG8_STAGE(PG8_SB(1, 0), cB + kstep, voffB); PG8_STAGE(PG8_SA(1, 0), cA + kstep, voffA); PG8_STAGE(PG8_SB(1, 1), cB + hstep + kstep, voffB);
        PG8_WAIT_V(6); PG8_BAR;
    }
    for (;;) {
        const bool has_next = S.next(ui + 1, nxt);
        const char* nA = has_next ? (const char*)g.A + (size_t)nxt.pm * tstep : cA; const char* nB = has_next ? (const char*)g.Bt + (size_t)nxt.pn * tstep : cB;
        for (int t = 0; t < nt; t += 2) {
            const bool last = (t == nt - 2);
            const char* a1 = cA + (size_t)(t + 1) * kstep;
            const char* a2 = last ? nA : cA + (size_t)(t + 2) * kstep; const char* b2 = last ? nB : cB + (size_t)(t + 2) * kstep;
            const char* a3 = a2 + kstep; const char* b3 = b2 + kstep;
            if (last && has_next) S.a_ready(nxt);
            if constexpr (SP2) {
            PG8_LDB(B0, 0, 0); PG8_LDB(B1, 0, 1); PG8_SCHED; PG8_LDA(At, 0, 0); PG8_STAGE(PG8_SA(1, 1), a1 + hstep, voffA);
            PG8_WAIT_V(8); PG8_WAIT_L(0); PG8_BAR; PG8_MMA(0, 0, At, B0); PG8_MMA(0, 1, At, B1); PG8_BAR; PG8_SCHED;
            PG8_LDA(At, 0, 1); PG8_STAGE(PG8_SB(0, 0), b2, voffB); PG8_STAGE(PG8_SB(0, 1), b2 + hstep, voffB); PG8_STAGE(PG8_SA(0, 0), a2, voffA);
            PG8_WAIT_V(8); PG8_WAIT_L(0); PG8_BAR; PG8_MMA(1, 0, At, B0); PG8_MMA(1, 1, At, B1); PG8_BAR; PG8_SCHED;
            PG8_LDB(B0, 1, 0); PG8_LDB(B1, 1, 1); PG8_SCHED; PG8_LDA(At, 1, 0); PG8_STAGE(PG8_SA(0, 1), a2 + hstep, voffA);
            PG8_WAIT_V(8); PG8_WAIT_L(0); PG8_BAR; PG8_MMA(0, 0, At, B0); PG8_MMA(0, 1, At, B1); PG8_BAR; PG8_SCHED;
            PG8_LDA(At, 1, 1); PG8_STAGE(PG8_SB(1, 0), b3, voffB); PG8_STAGE(PG8_SB(1, 1), b3 + hstep, voffB); PG8_STAGE(PG8_SA(1, 0), a3, voffA);
            PG8_WAIT_V(8); PG8_WAIT_L(0); PG8_BAR; PG8_MMA(1, 0, At, B0); PG8_MMA(1, 1, At, B1); PG8_BAR; PG8_SCHED;
            } else {
            PG8_LDB(B0, 0, 0); PG8_SCHED; PG8_LDA(At, 0, 0); PG8_STAGE(PG8_SA(1, 1), a1 + hstep, voffA);
            PG8_WAIT_L(8); PG8_BAR; PG8_WAIT_L(0); PG8_MMA(0, 0, At, B0); PG8_BAR; PG8_SCHED;
            PG8_LDB(B1, 0, 1); PG8_STAGE(PG8_SB(0, 0), b2, voffB);
            PG8_BAR; PG8_WAIT_L(0); PG8_MMA(0, 1, At, B1); PG8_BAR;
            PG8_LDA(At, 0, 1); PG8_STAGE(PG8_SA(0, 0), a2, voffA);
            PG8_BAR; PG8_WAIT_L(0); PG8_MMA(1, 0, At, B0); PG8_BAR; PG8_SCHED;
            PG8_STAGE(PG8_SB(0, 1), b2 + hstep, voffB);
            PG8_WAIT_V(6); PG8_BAR; PG8_MMA(1, 1, At, B1); PG8_BAR;
            PG8_LDB(B0, 1, 0); PG8_SCHED; PG8_LDA(At, 1, 0); PG8_STAGE(PG8_SA(0, 1), a2 + hstep, voffA);
            PG8_WAIT_L(8); PG8_BAR; PG8_WAIT_L(0); PG8_MMA(0, 0, At, B0); PG8_BAR; PG8_SCHED;
            PG8_LDB(B1, 1, 1); PG8_STAGE(PG8_SB(1, 0), b3, voffB);
            PG8_BAR; PG8_WAIT_L(0); PG8_MMA(0, 1, At, B1); PG8_BAR;
            PG8_LDA(At, 1, 1); PG8_STAGE(PG8_SA(1, 0), a3, voffA);
            PG8_BAR; PG8_WAIT_L(0); PG8_MMA(1, 0, At, B0); PG8_BAR; PG8_SCHED;
            PG8_STAGE(PG8_SB(1, 1), b3 + hstep, voffB);
            PG8_WAIT_V(6); PG8_BAR; PG8_MMA(1, 1, At, B1); PG8_BAR;
            }
        }
        if constexpr (ALIGN_EPI) { if (wr == 0) PG8_BAR; }
        if constexpr (!Epi::AFTER_DRAIN) { E(acc, cur, wr, wc, fr, fq); S.done(cur); }
        if (!has_next) break;
#pragma unroll
        for (int a = 0; a < 2; ++a)
#pragma unroll
            for (int b = 0; b < 2; ++b)
#pragma unroll
                for (int m = 0; m < 4; ++m)
#pragma unroll
                    for (int n = 0; n < 2; ++n) acc[a][b][m][n] = (f32x4){0.f, 0.f, 0.f, 0.f};
        cur = nxt; cA = nA; cB = nB; ++ui;
        if constexpr (ALIGN_EPI) { if (wr == 1) PG8_BAR; }
    }
    PG8_WAIT_V(0);
    if constexpr (!ALIGN_EPI) { if (wr == 0) PG8_BAR; }
    PG8_BAR;
    if constexpr (Epi::AFTER_DRAIN) { E.fused(acc, cur, wr, wc, fr, fq, lds, wid, lane); S.done(cur); }
#undef PG8_SA
#undef PG8_SB
#undef PG8_STAGE
#undef PG8_LDA
#undef PG8_LDB
#undef PG8_MMA
#undef PG8_WAIT_V
#undef PG8_WAIT_L
#undef PG8_BAR
#undef PG8_SCHED
}
}
constexpr int BATCH = 2, SEQ = 8192, DM = 1024, DEPTH = 4, M = BATCH * SEQ;
constexpr int NIN = 9224, NP = 9216, NPAD = 9472, BW = 512;
constexpr int C_GQ = 0, C_GK = 512, C_GV = 1024, C_GZ = 1536, C_DQ = 2048, C_DK = 2560, C_DV = 3072, C_DZ = 3584,
              C_SB = 4096, C_SC = 4608, C_SX = 5120, C_SZ = 5632, C_MG = 6144;
constexpr float EPS = 1e-6f;
constexpr int NWAVES = 8, NTHR = 512;
constexpr int LDS_BYTES = 147456;
constexpr size_t MiB = 1u << 20;
constexpr size_t WS_CTL = 0;
constexpr size_t WS_WIN = 2 * MiB;
constexpr size_t WIN_L = (size_t)NPAD * DM;
constexpr size_t WS_WBR = 76 * MiB;
constexpr size_t WS_WOUT = 88 * MiB;
constexpr size_t WS_PROJ = 96 * MiB;
constexpr size_t WS_BA = 384 * MiB;
constexpr size_t WS_REGB = 386 * MiB;
constexpr size_t WS_REGC = 418 * MiB;
constexpr size_t WS_REGD = 482 * MiB;
constexpr size_t WS_GL = 554 * MiB;
constexpr size_t WS_END = 555 * MiB;
constexpr int NUNIT = BATCH * 4 * 128;
constexpr size_t GD_U = 0, GD_W = (size_t)NUNIT * 8192, GD_QD = 2 * GD_W, GD_KD = 3 * GD_W, GD_QK = 4 * GD_W;

typedef unsigned short bf16;
typedef unsigned v4u __attribute__((ext_vector_type(4)));
typedef unsigned v2u __attribute__((ext_vector_type(2)));
typedef float f32x4 __attribute__((ext_vector_type(4)));
#define LAS __attribute__((address_space(3)))

__device__ __forceinline__ unsigned f2bf(float f) { unsigned u = __builtin_bit_cast(unsigned, f); return (u + 0x7fffu + ((u >> 16) & 1u)) >> 16; }
__device__ __forceinline__ unsigned pk2(float lo, float hi) { return f2bf(lo) | (f2bf(hi) << 16); }
__device__ __forceinline__ float bf2f(unsigned short b) { return __builtin_bit_cast(float, (unsigned)b << 16); }
__device__ __forceinline__ float bflo(unsigned w) { return __builtin_bit_cast(float, w << 16); }
__device__ __forceinline__ float bfhi(unsigned w) { return __builtin_bit_cast(float, w & 0xffff0000u); }
__device__ __forceinline__ void ld8(const bf16* p, float* f) { const v4u w = *(const v4u*)p; f[0] = bflo(w.x); f[1] = bfhi(w.x); f[2] = bflo(w.y); f[3] = bfhi(w.y); f[4] = bflo(w.z); f[5] = bfhi(w.z); f[6] = bflo(w.w); f[7] = bfhi(w.w); }
__device__ __forceinline__ void st8(bf16* p, const float* f) { v4u w; w.x = pk2(f[0], f[1]); w.y = pk2(f[2], f[3]); w.z = pk2(f[4], f[5]); w.w = pk2(f[6], f[7]); *(v4u*)p = w; }
__device__ __forceinline__ float wave_sum(float v) {
#pragma unroll
    for (int o = 1; o < 64; o <<= 1) v += __shfl_xor(v, o);
    return v;
}
__device__ __forceinline__ float sigmoidf_(float x) { return 1.f / (1.f + __expf(-x)); }
__device__ __forceinline__ float siluf_(float x) { return x / (1.f + __expf(-x)); }
__device__ __forceinline__ int srccol(int p) { return p < 2048 ? p : (p < 9216 ? p + 8 : (p < 9224 ? 2048 + (p - 9216) : -1)); }

struct Args {
    const float* x; const float* norm_pre; const float* norm_post; const float* w_in; const float* gdn_conv_w; const float* gdn_a_log; const float* gdn_dt_bias;
    const float* gdn_norm_w; const float* diff_lambda; const float* diff_norm_w; const float* sc_conv_w; const float* w_branch; const float* w_out;
    float* out; unsigned char* ws; int ph_lo, ph_hi, coop, pad;
};

struct EpiProj {
    static constexpr bool PERM = true, AFTER_DRAIN = false;
    bf16* P; float* BA;
    __device__ __forceinline__ void operator()(const pg8::f32x4 (&acc)[2][2][4][2], const pg8::Unit& u, int wr, int wc, int fr, int fq) const {
        const int row0 = u.pm * 256 + wr * 64 + fr;
        if (u.pn == 36) {
            if (wc == 0 && fq == 0) {
#pragma unroll
                for (int ai = 0; ai < 2; ++ai)
#pragma unroll
                    for (int m = 0; m < 4; ++m) { float* o = BA + (size_t)(row0 + ai * 128 + m * 16) * 8; *(pg8::f32x4*)o = acc[ai][0][m][0]; *(pg8::f32x4*)(o + 4) = acc[ai][0][m][1]; }
            }
            return;
        }
        const int colt = u.pn * 256; const float sc = (colt >= C_DQ && colt < C_DK) ? 0.125f : 1.f;
        const int col0 = colt + wc * 32 + 8 * fq;
#pragma unroll
        for (int ai = 0; ai < 2; ++ai)
#pragma unroll
            for (int m = 0; m < 4; ++m) { bf16* rowp = P + (size_t)(row0 + ai * 128 + m * 16) * NP + col0;
#pragma unroll
                for (int bj = 0; bj < 2; ++bj) { const pg8::f32x4 v0 = acc[ai][bj][m][0] * sc, v1 = acc[ai][bj][m][1] * sc; v4u w;
                    w.x = pg8::cvt_pk_bf16(v0[0], v0[1]); w.y = pg8::cvt_pk_bf16(v0[2], v0[3]); w.z = pg8::cvt_pk_bf16(v1[0], v1[1]); w.w = pg8::cvt_pk_bf16(v1[2], v1[3]);
                    *(v4u*)(rowp + bj * 128) = w; } }
    }
};
template <int KB> struct EpiBranch {
    static constexpr bool PERM = true, AFTER_DRAIN = false;
    const bf16* P; float* MG; bf16* MB;
    __device__ __forceinline__ void operator()(const pg8::f32x4 (&acc)[2][2][4][2], const pg8::Unit& u, int wr, int wc, int fr, int fq) const {
        const int row0 = u.pm * 256 + wr * 64 + fr; const int col0 = u.pn * 256 + wc * 32 + 8 * fq;
#pragma unroll
        for (int ai = 0; ai < 2; ++ai)
#pragma unroll
            for (int m = 0; m < 4; ++m) { const size_t row = (size_t)(row0 + ai * 128 + m * 16);
#pragma unroll
                for (int bj = 0; bj < 2; ++bj) { const int col = col0 + bj * 128; float lg[8]; ld8(P + row * NP + C_MG + KB * 1024 + col, lg);
                    float v[8];
#pragma unroll
                    for (int j = 0; j < 4; ++j) { v[j] = acc[ai][bj][m][0][j] * sigmoidf_(lg[j]); v[4 + j] = acc[ai][bj][m][1][j] * sigmoidf_(lg[4 + j]); }
                    float* mp = MG + row * DM + col;
                    if (KB > 0) { const pg8::f32x4 a = *(const pg8::f32x4*)mp, b = *(const pg8::f32x4*)(mp + 4);
#pragma unroll
                        for (int j = 0; j < 4; ++j) { v[j] += a[j]; v[4 + j] += b[j]; } }
                    if (KB < 2) { *(pg8::f32x4*)mp = (pg8::f32x4){v[0], v[1], v[2], v[3]}; *(pg8::f32x4*)(mp + 4) = (pg8::f32x4){v[4], v[5], v[6], v[7]}; }
                    else st8(MB + row * DM + col, v); } }
    }
};
struct EpiOutF32 {
    static constexpr bool PERM = true, AFTER_DRAIN = false;
    float* O;
    __device__ __forceinline__ void operator()(const pg8::f32x4 (&acc)[2][2][4][2], const pg8::Unit& u, int wr, int wc, int fr, int fq) const {
        const int row0 = u.pm * 256 + wr * 64 + fr; const int col0 = u.pn * 256 + wc * 32 + 8 * fq;
#pragma unroll
        for (int ai = 0; ai < 2; ++ai)
#pragma unroll
            for (int m = 0; m < 4; ++m) { float* rowp = O + (size_t)(row0 + ai * 128 + m * 16) * DM + col0;
#pragma unroll
                for (int bj = 0; bj < 2; ++bj) { *(pg8::f32x4*)(rowp + bj * 128) = acc[ai][bj][m][0]; *(pg8::f32x4*)(rowp + bj * 128 + 4) = acc[ai][bj][m][1]; } }
    }
};

__device__ __forceinline__ void tr_item(const float* W, int ldw, int K, bf16* WT, int k0, int p0, int mode, float* scr, int lane) {
    const int n = lane & 31; const int p = p0 + n; const int sc = mode ? srccol(p) : p;
#pragma unroll 8
    for (int i = 0; i < 32; ++i) { const int kk = 2 * i + (lane >> 5); scr[kk * 33 + n] = sc >= 0 ? W[(size_t)(k0 + kk) * ldw + sc] : 0.f; }
    asm volatile("s_waitcnt lgkmcnt(0)" ::: "memory");
    const int c = lane & 7;
#pragma unroll
    for (int j = 0; j < 4; ++j) { const int nn = (lane >> 3) + 8 * j; const float* s = scr + (8 * c) * 33 + nn;
        v4u o; o.x = pk2(s[0 * 33], s[1 * 33]); o.y = pk2(s[2 * 33], s[3 * 33]); o.z = pk2(s[4 * 33], s[5 * 33]); o.w = pk2(s[6 * 33], s[7 * 33]);
        *(v4u*)(WT + (size_t)(p0 + nn) * K + k0 + 8 * c) = o; }
    asm volatile("s_waitcnt lgkmcnt(0)" ::: "memory");
}
__device__ __forceinline__ void norm_row_to_h(const float* xrow, const float* wpre, bf16* hrow, int lane) {
    f32x4 v[4]; float s = 0.f;
#pragma unroll
    for (int j = 0; j < 4; ++j) { v[j] = *(const f32x4*)(xrow + 4 * lane + 256 * j); s += (v[j].x * v[j].x + v[j].y * v[j].y) + (v[j].z * v[j].z + v[j].w * v[j].w); }
    const float rs = rsqrtf(wave_sum(s) * (1.f / DM) + EPS);
#pragma unroll
    for (int j = 0; j < 4; ++j) { const f32x4 w = *(const f32x4*)(wpre + 4 * lane + 256 * j); v2u o; o.x = pk2(v[j].x * rs * w.x, v[j].y * rs * w.y); o.y = pk2(v[j].z * rs * w.z, v[j].w * rs * w.w);
        *(v2u*)(hrow + 4 * lane + 256 * j) = o; }
}
__device__ __forceinline__ void phase_prologue(const Args& a, unsigned char* lds, int wv_) {
    int tid_ = wv_ * 64 + mk_lane(); asm volatile("" : "+v"(tid_)); const int tid = tid_, lane = tid & 63, wave = tid >> 6;
    float* scr = (float*)(lds + wave * 16384);
    const int gw = blockIdx.x * NWAVES + wave, NGW = gridDim.x * NWAVES;
    constexpr int I_IN = (DM / 64) * (NPAD / 32), I_BR = (BW / 64) * (DM / 32), I_OUT = (DM / 64) * (DM / 32);
    constexpr int NITEMS = DEPTH * I_IN + DEPTH * 3 * I_BR + DEPTH * I_OUT;
    bf16* win = (bf16*)(a.ws + WS_WIN); bf16* wbr = (bf16*)(a.ws + WS_WBR); bf16* wout = (bf16*)(a.ws + WS_WOUT);
    for (int it = gw; it < NITEMS; it += NGW) {
        int r = it;
        if (r < DEPTH * I_IN) { const int l = r / I_IN; r %= I_IN; const int nb = NPAD / 32, kb = r / nb, pb = r % nb;
            tr_item(a.w_in + (size_t)l * DM * NIN, NIN, DM, win + (size_t)l * WIN_L, kb * 64, pb * 32, 1, scr, lane); continue; }
        r -= DEPTH * I_IN;
        if (r < DEPTH * 3 * I_BR) { const int lk = r / I_BR; r %= I_BR; const int nb = DM / 32, kb = r / nb, pb = r % nb;
            tr_item(a.w_branch + (size_t)lk * BW * DM, DM, BW, wbr + (size_t)lk * DM * BW, kb * 64, pb * 32, 0, scr, lane); continue; }
        r -= DEPTH * 3 * I_BR;
        { const int l = r / I_OUT; r %= I_OUT; const int nb = DM / 32, kb = r / nb, pb = r % nb;
            tr_item(a.w_out + (size_t)l * DM * DM, DM, DM, wout + (size_t)l * DM * DM, kb * 64, pb * 32, 0, scr, lane); }
    }
    bf16* H = (bf16*)(a.ws + WS_REGB);
    for (int m = gw; m < M; m += NGW) norm_row_to_h(a.x + (size_t)m * DM, a.norm_pre, H + (size_t)m * DM, lane);
}

__device__ __forceinline__ void phase_attn_v1(const Args& a, unsigned char* lds, int l, int wv_) {
    const bf16* P = (const bf16*)(a.ws + WS_PROJ); float* OATT = (float*)(a.ws + WS_REGC);
    float* Ks = (float*)lds;
    float* Vs = Ks + 32 * 64;
    float* Qs = Vs + 32 * 128;
    int tid_ = wv_ * 64 + mk_lane(); asm volatile("" : "+v"(tid_)); const int tid = tid_, qi = tid & 63, slice = tid >> 6;
#pragma unroll 1
    for (int it = blockIdx.x; it < 1024; it += gridDim.x) {
        const int stream = it >> 6, pp = it & 63;
        const int bb = stream >> 3, h = (stream >> 1) & 3, mp = stream & 1;
        const float slope = exp2f(-2.f * (float)(h + 1));
#pragma unroll 1
        for (int uu = 0; uu < 2; ++uu) {
            const int qb = uu == 0 ? pp : 127 - pp;
            const int t = qb * 64 + qi; const size_t row = (size_t)bb * SEQ + t;
            __syncthreads();
            { const int r = tid >> 3, d8 = (tid & 7) * 8; float f[8]; ld8(P + ((size_t)bb * SEQ + qb * 64 + r) * NP + C_DQ + h * 128 + mp * 64 + d8, f);
#pragma unroll
              for (int x = 0; x < 8; ++x) Qs[r * 65 + d8 + x] = f[x]; }
            float o[16];
#pragma unroll
            for (int e = 0; e < 16; ++e) o[e] = 0.f;
            float mrun = -1e30f, lsum = 0.f;
            const int nkt = (qb * 64 + 64) / 32;
#pragma unroll 1
            for (int kt = 0; kt < nkt; ++kt) {
                __syncthreads();
                { const int j = tid >> 4, d4 = (tid & 15) * 4; const bf16* src = P + ((size_t)bb * SEQ + kt * 32 + j) * NP + C_DK + h * 128 + mp * 64 + d4;
                  const v2u w = *(const v2u*)src; Ks[j * 64 + d4] = bflo(w.x); Ks[j * 64 + d4 + 1] = bfhi(w.x); Ks[j * 64 + d4 + 2] = bflo(w.y); Ks[j * 64 + d4 + 3] = bfhi(w.y); }
                { const int j = tid >> 4, e8 = (tid & 15) * 8; float f[8]; ld8(P + ((size_t)bb * SEQ + kt * 32 + j) * NP + C_DV + h * 128 + e8, f);
#pragma unroll
                  for (int x = 0; x < 8; ++x) Vs[j * 128 + e8 + x] = f[x]; }
                __syncthreads();
#pragma unroll 1
                for (int jj = 0; jj < 32; ++jj) {
                    const int j = kt * 32 + jj;
                    if (j > qb * 64 + 63) break;
                    const float* kr = Ks + jj * 64; const float* qr = Qs + qi * 65; float acc = 0.f;
#pragma unroll 8
                    for (int d = 0; d < 64; ++d) acc += qr[d] * kr[d];
                    acc -= slope * (float)(t - j); const float s = (j <= t) ? acc : -1e30f;
                    const float mx = fmaxf(mrun, s); const float corr = __expf(mrun - mx), p = __expf(s - mx); mrun = mx; lsum = lsum * corr + p;
                    const float* vr = Vs + jj * 128 + slice * 16;
#pragma unroll
                    for (int e = 0; e < 16; ++e) o[e] = o[e] * corr + p * vr[e];
                }
            }
            const float inv = 1.f / lsum; float* dst = OATT + ((row * 4 + h) * 2 + mp) * 128 + slice * 16;
#pragma unroll
            for (int e = 0; e < 16; e += 4) *(f32x4*)(dst + e) = (f32x4){o[e] * inv, o[e + 1] * inv, o[e + 2] * inv, o[e + 3] * inv};
        }
    }
    __syncthreads();
}

__device__ __forceinline__ void phase_gdn_local_v1(const Args& a, unsigned char* lds, int l, int wv_) {
    const bf16* P = (const bf16*)(a.ws + WS_PROJ); const float* BA = (const float*)(a.ws + WS_BA);
    bf16* GD = (bf16*)(a.ws + WS_REGD); float* GL = (float*)(a.ws + WS_GL);
    float* qs = (float*)lds; float* ks = qs + 64 * 129; float* vs = ks + 64 * 129; float* KKs = vs + 64 * 129; float* QKs = KKs + 64 * 65;
    float* beta = QKs + 64 * 65; float* gc = beta + 64;
    int tid_ = wv_ * 64 + mk_lane(); asm volatile("" : "+v"(tid_)); const int tid = tid_, lane = tid & 63, wave = tid >> 6;
    const float* cw = a.gdn_conv_w + (size_t)l * 4 * 1536;
    for (int unit = blockIdx.x; unit < NUNIT; unit += gridDim.x) {
        const int bb = unit >> 9, h = (unit >> 7) & 3, n = unit & 127;
        __syncthreads();
#pragma unroll 1
        for (int idx = tid; idx < 3 * 64 * 128; idx += NTHR) {
            const int mat = idx >> 13, rem = idx & 8191, t = rem >> 7, c = rem & 127, col = mat * 512 + h * 128 + c;
            float acc = 0.f;
#pragma unroll
            for (int j = 0; j < 4; ++j) { const int tt = n * 64 + t - 3 + j; if (tt >= 0) acc += cw[j * 1536 + col] * bf2f(P[((size_t)bb * SEQ + tt) * NP + col]); }
            (mat == 0 ? qs : mat == 1 ? ks : vs)[t * 129 + c] = siluf_(acc);
        }
        if (tid < 64) {
            const size_t row = (size_t)bb * SEQ + n * 64 + tid;
            beta[tid] = sigmoidf_(BA[row * 8 + h]);
            const float xx = BA[row * 8 + 4 + h] + a.gdn_dt_bias[l * 4 + h];
            const float sp = xx > 20.f ? xx : log1pf(__expf(xx));
            gc[tid] = -__expf(a.gdn_a_log[l * 4 + h]) * sp;
        }
        __syncthreads();
        if (tid == 0) { float run = 0.f;
#pragma unroll 1
            for (int c = 0; c < 64; ++c) { run += gc[c]; gc[c] = run; } }
        __syncthreads();
#pragma unroll 1
        for (int r = wave * 8; r < wave * 8 + 8; ++r) {
            { float x0 = qs[r * 129 + lane], x1 = qs[r * 129 + 64 + lane]; const float sc = rsqrtf(wave_sum(x0 * x0 + x1 * x1) + 1e-6f) * 0.08838834764831845f; qs[r * 129 + lane] = x0 * sc; qs[r * 129 + 64 + lane] = x1 * sc; }
            { float x0 = ks[r * 129 + lane], x1 = ks[r * 129 + 64 + lane]; const float sc = rsqrtf(wave_sum(x0 * x0 + x1 * x1) + 1e-6f); ks[r * 129 + lane] = x0 * sc; ks[r * 129 + 64 + lane] = x1 * sc; }
        }
        __syncthreads();
#pragma unroll 1
        for (int i = 0; i < 8; ++i) { const int idx = tid + NTHR * i, c = idx >> 6, s = idx & 63; float kk = 0.f, qk = 0.f;
#pragma unroll 4
            for (int d = 0; d < 128; ++d) { const float kv = ks[s * 129 + d]; kk += ks[c * 129 + d] * kv; qk += qs[c * 129 + d] * kv; }
            const float dec = (s <= c) ? __expf(gc[c] - gc[s]) : 0.f;
            KKs[c * 65 + s] = (s < c) ? kk * beta[c] * dec : 0.f; QKs[c * 65 + s] = qk * dec; }
        __syncthreads();
        const size_t ub = (size_t)unit * 8192;
        { const float gl = gc[63];
          for (int idx = tid; idx < 8192; idx += NTHR) { const int c = idx >> 7, d = idx & 127;
              GD[GD_QD + ub + idx] = (bf16)f2bf(qs[c * 129 + d] * __expf(gc[c])); GD[GD_KD + ub + idx] = (bf16)f2bf(ks[c * 129 + d] * __expf(gl - gc[c])); }
          for (int idx = tid; idx < 4096; idx += NTHR) { const int c = idx >> 6, s = idx & 63; GD[GD_QK + (size_t)unit * 4096 + idx] = (bf16)f2bf(QKs[c * 65 + s]); }
          if (tid == 0) GL[unit] = __expf(gl); }
        __syncthreads();
        for (int idx = tid; idx < 8192; idx += NTHR) { const int c = idx >> 7, d = idx & 127; vs[c * 129 + d] *= beta[c]; ks[c * 129 + d] *= beta[c] * __expf(gc[c]); }
        __syncthreads();
        if (tid < 256) {
            float* X = (tid < 128 ? vs : ks) + (tid & 127);
#pragma unroll 1
            for (int c = 1; c < 64; ++c) { float acc = X[c * 129]; const float* Ar = KKs + c * 65;
#pragma unroll 4
                for (int s = 0; s < c; ++s) acc -= Ar[s] * X[s * 129];
                X[c * 129] = acc; }
            bf16* dst = GD + (tid < 128 ? GD_U : GD_W) + ub + (tid & 127);
            for (int c = 0; c < 64; ++c) dst[c * 128] = (bf16)f2bf(X[c * 129]);
        }
    }
    __syncthreads();
}

__device__ __forceinline__ void phase_gdn_scan_v1(const Args& a, unsigned char* lds, int l, int wv_) {
    const bf16* GD = (const bf16*)(a.ws + WS_REGD); const float* GL = (const float*)(a.ws + WS_GL); float* OG = (float*)(a.ws + WS_REGB);
    float* Ws = (float*)lds; float* QDs = Ws + 64 * 129; float* KDs = QDs + 64 * 129; float* QKs = KDs + 64 * 129; float* Us = QKs + 64 * 65; float* Vn = Us + 64 * 16; float* S = Vn + 64 * 17;
    int tid_ = wv_ * 64 + mk_lane(); asm volatile("" : "+v"(tid_)); const int tid = tid_;
    for (int item = blockIdx.x; item < 64; item += gridDim.x) {
        const int bh = item >> 3, sl = item & 7, bb = bh >> 2, h = bh & 3;
        __syncthreads();
        for (int i = tid; i < 128 * 17; i += NTHR) S[i] = 0.f;
#pragma unroll 1
        for (int n = 0; n < 128; ++n) {
            const int unit = bh * 128 + n; const size_t ub = (size_t)unit * 8192;
            __syncthreads();
            for (int idx = tid; idx < 8192; idx += NTHR) { const int c = idx >> 7, d = idx & 127;
                Ws[c * 129 + d] = bf2f(GD[GD_W + ub + idx]); QDs[c * 129 + d] = bf2f(GD[GD_QD + ub + idx]); KDs[c * 129 + d] = bf2f(GD[GD_KD + ub + idx]); }
            for (int idx = tid; idx < 4096; idx += NTHR) QKs[(idx >> 6) * 65 + (idx & 63)] = bf2f(GD[GD_QK + (size_t)unit * 4096 + idx]);
            for (int idx = tid; idx < 1024; idx += NTHR) { const int c = idx >> 4, j = idx & 15; Us[idx] = bf2f(GD[GD_U + ub + c * 128 + sl * 16 + j]); }
            const float glast = GL[unit];
            __syncthreads();
#pragma unroll 1
            for (int i = 0; i < 2; ++i) { const int idx = tid + NTHR * i, c = idx >> 4, j = idx & 15; float acc = Us[idx];
#pragma unroll 4
                for (int d = 0; d < 128; ++d) acc -= Ws[c * 129 + d] * S[d * 17 + j];
                Vn[c * 17 + j] = acc; }
            __syncthreads();
#pragma unroll 1
            for (int i = 0; i < 2; ++i) { const int idx = tid + NTHR * i, c = idx >> 4, j = idx & 15; float acc = 0.f;
#pragma unroll 4
                for (int d = 0; d < 128; ++d) acc += QDs[c * 129 + d] * S[d * 17 + j];
#pragma unroll 4
                for (int s = 0; s < 64; ++s) acc += QKs[c * 65 + s] * Vn[s * 17 + j];
                OG[((size_t)bb * SEQ + n * 64 + c) * BW + h * 128 + sl * 16 + j] = acc; }
            float sn[4];
#pragma unroll
            for (int i = 0; i < 4; ++i) { const int idx = tid + NTHR * i, d = idx >> 4, j = idx & 15; float acc = S[d * 17 + j] * glast;
#pragma unroll 4
                for (int c = 0; c < 64; ++c) acc += KDs[c * 129 + d] * Vn[c * 17 + j];
                sn[i] = acc; }
            __syncthreads();
#pragma unroll
            for (int i = 0; i < 4; ++i) { const int idx = tid + NTHR * i; S[(idx >> 4) * 17 + (idx & 15)] = sn[i]; }
        }
    }
    __syncthreads();
}

__device__ __forceinline__ void phase_finalize(const Args& a, int l, int wv_) {
    const bf16* P = (const bf16*)(a.ws + WS_PROJ); const float* OG = (const float*)(a.ws + WS_REGB); const float* OATT = (const float*)(a.ws + WS_REGC);
    bf16* Y = (bf16*)(a.ws + WS_REGD);
    int tid_ = wv_ * 64 + mk_lane(); asm volatile("" : "+v"(tid_)); const int tid = tid_, lane = tid & 63, wave = tid >> 6;
    const int gw = blockIdx.x * NWAVES + wave, NGW = gridDim.x * NWAVES;
    const float lam_init = 0.8f - 0.6f * expf(-0.3f * (float)l);
    const float* lv = a.diff_lambda + (size_t)l * 256;
    const float lam = expf(wave_sum(lv[lane] * lv[64 + lane])) - expf(wave_sum(lv[128 + lane] * lv[192 + lane])) + lam_init;
    const int e0 = (lane & 15) * 8, hh = lane >> 4, c0 = lane * 8;
    float gnw[8], dnw[8], scw[3][8];
#pragma unroll
    for (int j = 0; j < 8; ++j) { gnw[j] = a.gdn_norm_w[l * 128 + e0 + j]; dnw[j] = a.diff_norm_w[l * 128 + e0 + j] * (1.f - lam_init);
#pragma unroll
        for (int k = 0; k < 3; ++k) scw[k][j] = a.sc_conv_w[((size_t)l * 3 + k) * BW + c0 + j]; }
    for (int row = gw; row < M; row += NGW) {
        const int t = row & (SEQ - 1);
        const bf16* pr = P + (size_t)row * NP;
        float y[8], z[8];
        { const f32x4 o0 = *(const f32x4*)(OG + (size_t)row * BW + c0), o1 = *(const f32x4*)(OG + (size_t)row * BW + c0 + 4);
          float o[8] = {o0.x, o0.y, o0.z, o0.w, o1.x, o1.y, o1.z, o1.w}; float ss = 0.f;
#pragma unroll
          for (int j = 0; j < 8; ++j) ss += o[j] * o[j];
          ss += __shfl_xor(ss, 1); ss += __shfl_xor(ss, 2); ss += __shfl_xor(ss, 4); ss += __shfl_xor(ss, 8);
          const float rs = rsqrtf(ss * (1.f / 128.f) + EPS); ld8(pr + C_GZ + c0, z);
#pragma unroll
          for (int j = 0; j < 8; ++j) y[j] = o[j] * rs * gnw[j] * siluf_(z[j]);
          st8(Y + (size_t)row * BW + c0, y); }
        { const float* op = OATT + (((size_t)row * 4 + hh) * 2) * 128 + e0;
          const f32x4 a0 = *(const f32x4*)op, a1 = *(const f32x4*)(op + 4), b0 = *(const f32x4*)(op + 128), b1 = *(const f32x4*)(op + 132);
          float d[8] = {a0.x - lam * b0.x, a0.y - lam * b0.y, a0.z - lam * b0.z, a0.w - lam * b0.w, a1.x - lam * b1.x, a1.y - lam * b1.y, a1.z - lam * b1.z, a1.w - lam * b1.w}; float ss = 0.f;
#pragma unroll
          for (int j = 0; j < 8; ++j) ss += d[j] * d[j];
          ss += __shfl_xor(ss, 1); ss += __shfl_xor(ss, 2); ss += __shfl_xor(ss, 4); ss += __shfl_xor(ss, 8);
          const float rs = rsqrtf(ss * (1.f / 128.f) + EPS); ld8(pr + C_DZ + c0, z);
#pragma unroll
          for (int j = 0; j < 8; ++j) y[j] = d[j] * rs * dnw[j] * siluf_(z[j]);
          st8(Y + (size_t)M * BW + (size_t)row * BW + c0, y); }
        { float acc[8];
#pragma unroll
          for (int j = 0; j < 8; ++j) acc[j] = 0.f;
#pragma unroll
          for (int k = 0; k < 3; ++k) { const int tt = t - 2 + k; if (tt >= 0) { float cc[8], xx[8]; const bf16* p2 = P + (size_t)(row - 2 + k) * NP; ld8(p2 + C_SC + c0, cc); ld8(p2 + C_SX + c0, xx);
#pragma unroll
              for (int j = 0; j < 8; ++j) acc[j] += scw[k][j] * (cc[j] * xx[j]); } }
          float sb[8]; ld8(pr + C_SB + c0, sb); ld8(pr + C_SZ + c0, z);
#pragma unroll
          for (int j = 0; j < 8; ++j) y[j] = sb[j] * acc[j] * siluf_(z[j]);
          st8(Y + 2 * (size_t)M * BW + (size_t)row * BW + c0, y); }
    }
}

__device__ __forceinline__ void phase_postnorm(const Args& a, int l, int wv_) {
    const float* OUT = (const float*)(a.ws + WS_REGC); bf16* H = (bf16*)(a.ws + WS_REGB);
    const float* xin = (l == 0) ? a.x : a.out;
    int tid_ = wv_ * 64 + mk_lane(); asm volatile("" : "+v"(tid_)); const int tid = tid_, lane = tid & 63, wave = tid >> 6;
    const int gw = blockIdx.x * NWAVES + wave, NGW = gridDim.x * NWAVES;
    const float* wpost = a.norm_post + (size_t)l * DM; const float* wpre = a.norm_pre + (size_t)(l + 1 < DEPTH ? l + 1 : l) * DM;
    for (int row = gw; row < M; row += NGW) {
        f32x4 o[4], x[4]; float s = 0.f;
#pragma unroll
        for (int j = 0; j < 4; ++j) { o[j] = *(const f32x4*)(OUT + (size_t)row * DM + 4 * lane + 256 * j); x[j] = *(const f32x4*)(xin + (size_t)row * DM + 4 * lane + 256 * j);
            s += (o[j].x * o[j].x + o[j].y * o[j].y) + (o[j].z * o[j].z + o[j].w * o[j].w); }
        const float rs = rsqrtf(wave_sum(s) * (1.f / DM) + EPS); float s2 = 0.f;
#pragma unroll
        for (int j = 0; j < 4; ++j) { const f32x4 w = *(const f32x4*)(wpost + 4 * lane + 256 * j); x[j] = x[j] + o[j] * rs * w; *(f32x4*)(a.out + (size_t)row * DM + 4 * lane + 256 * j) = x[j];
            s2 += (x[j].x * x[j].x + x[j].y * x[j].y) + (x[j].z * x[j].z + x[j].w * x[j].w); }
        if (l + 1 < DEPTH) { const float rs2 = rsqrtf(wave_sum(s2) * (1.f / DM) + EPS);
#pragma unroll
            for (int j = 0; j < 4; ++j) { const f32x4 w = *(const f32x4*)(wpre + 4 * lane + 256 * j); v2u ob; ob.x = pk2(x[j].x * rs2 * w.x, x[j].y * rs2 * w.y); ob.y = pk2(x[j].z * rs2 * w.z, x[j].w * rs2 * w.w);
                *(v2u*)(H + (size_t)row * DM + 4 * lane + 256 * j) = ob; } }
    }
}

constexpr int ARGS_OFF = 143360;
constexpr int ARGS_WORDS = (int)(sizeof(Args) / 4);
__device__ __forceinline__ void load_args(Args& b, unsigned char* lds) {
    volatile LAS unsigned* s = (volatile LAS unsigned*)((LAS unsigned char*)lds + ARGS_OFF); unsigned w[ARGS_WORDS];
#pragma unroll
    for (int i = 0; i < ARGS_WORDS; ++i) w[i] = (unsigned)__builtin_amdgcn_readfirstlane((int)s[i]);
    __builtin_memcpy(&b, w, sizeof(Args));
}
template <int L> __device__ __forceinline__ void run_layer(unsigned char* lds, cg::grid_group& grid, int wv) {
    PG8_LAS unsigned char* lds3 = (PG8_LAS unsigned char*)lds;
    constexpr int l = L;
    {
        Args a; load_args(a, lds); const int G = gridDim.x;
        bf16* WIN = (bf16*)(a.ws + WS_WIN); bf16* PROJ = (bf16*)(a.ws + WS_PROJ); float* BA = (float*)(a.ws + WS_BA); bf16* REGB = (bf16*)(a.ws + WS_REGB);
        pg8::Gemm g{REGB, WIN + (size_t)l * WIN_L, M, NPAD, DM}; pg8::StaticOrder S; S.init(M, NPAD, G, (int)blockIdx.x);
        EpiProj E{PROJ, BA};
        pg8::gemm_phase<EpiProj, pg8::StaticOrder, true, true>(lds3, g, S, E, wv);
    }
    grid.sync();
    { Args a; load_args(a, lds); phase_gdn_local_v1(a, lds, l, wv); }
    { Args a; load_args(a, lds); phase_attn_v1(a, lds, l, wv); }
    grid.sync();
    { Args a; load_args(a, lds); phase_gdn_scan_v1(a, lds, l, wv); }
    grid.sync();
    { Args a; load_args(a, lds); phase_finalize(a, l, wv); }
    grid.sync();
    {
        Args a; load_args(a, lds); const int G = gridDim.x;
        bf16* WBR = (bf16*)(a.ws + WS_WBR); bf16* PROJ = (bf16*)(a.ws + WS_PROJ); bf16* REGB = (bf16*)(a.ws + WS_REGB); float* REGC = (float*)(a.ws + WS_REGC); bf16* Y = (bf16*)(a.ws + WS_REGD);
        pg8::StaticOrder S; S.init(M, DM, G, (int)blockIdx.x);
        { pg8::Gemm g{Y, WBR + ((size_t)l * 3 + 0) * DM * BW, M, DM, BW}; EpiBranch<0> E{PROJ, REGC, REGB}; pg8::gemm_phase<EpiBranch<0>, pg8::StaticOrder, true, true>(lds3, g, S, E, wv); }
        { pg8::Gemm g{Y + (size_t)M * BW, WBR + ((size_t)l * 3 + 1) * DM * BW, M, DM, BW}; EpiBranch<1> E{PROJ, REGC, REGB}; pg8::gemm_phase<EpiBranch<1>, pg8::StaticOrder, true, true>(lds3, g, S, E, wv); }
        { pg8::Gemm g{Y + 2 * (size_t)M * BW, WBR + ((size_t)l * 3 + 2) * DM * BW, M, DM, BW}; EpiBranch<2> E{PROJ, REGC, REGB}; pg8::gemm_phase<EpiBranch<2>, pg8::StaticOrder, true, true>(lds3, g, S, E, wv); }
    }
    grid.sync();
    {
        Args a; load_args(a, lds); const int G = gridDim.x;
        bf16* WOUT = (bf16*)(a.ws + WS_WOUT); bf16* REGB = (bf16*)(a.ws + WS_REGB); float* REGC = (float*)(a.ws + WS_REGC);
        pg8::Gemm g{REGB, WOUT + (size_t)l * DM * DM, M, DM, DM}; pg8::StaticOrder S; S.init(M, DM, G, (int)blockIdx.x);
        EpiOutF32 E{REGC};
        pg8::gemm_phase<EpiOutF32, pg8::StaticOrder, true, true>(lds3, g, S, E, wv);
    }
    grid.sync();
    { Args a; load_args(a, lds); phase_postnorm(a, l, wv); }
    if (L + 1 < DEPTH) grid.sync();
}
__global__ void __launch_bounds__(NTHR, 2) fwd(Args a0) {
    extern __shared__ __attribute__((aligned(16))) unsigned char lds[];
    cg::grid_group grid = cg::this_grid();
    const int wv = __builtin_amdgcn_readfirstlane((int)threadIdx.x >> 6);
    if (threadIdx.x == 0) { unsigned w[ARGS_WORDS]; __builtin_memcpy(w, &a0, sizeof(Args));
#pragma unroll
        for (int i = 0; i < ARGS_WORDS; ++i) ((volatile LAS unsigned*)((LAS unsigned char*)lds + ARGS_OFF))[i] = w[i]; }
    __syncthreads();
    { Args a; load_args(a, lds); phase_prologue(a, lds, wv); }
    grid.sync();
    run_layer<0>(lds, grid, wv);
    run_layer<1>(lds, grid, wv);
    run_layer<2>(lds, grid, wv);
    run_layer<3>(lds, grid, wv);
}

extern "C" void kernel_launch(void* const* d_in, const int* in_sizes, int n_in, void* d_out, int out_size, void* d_ws, size_t ws_size, hipStream_t stream) {
    static int grid = 0;
    if (grid == 0) {
        if (n_in != 13 || ws_size < WS_END) { fprintf(stderr, "kernel_launch: unexpected n_in %d or ws %zu\n", n_in, ws_size); grid = -1; return; }
        int dev = 0, cus = 0, per_cu = 0;
        hipGetDevice(&dev); hipDeviceGetAttribute(&cus, hipDeviceAttributeMultiprocessorCount, dev);
        hipFuncSetAttribute((const void*)fwd, hipFuncAttributeMaxDynamicSharedMemorySize, LDS_BYTES);
        hipOccupancyMaxActiveBlocksPerMultiprocessor(&per_cu, (const void*)fwd, NTHR, LDS_BYTES);
        (void)hipGetLastError();
        if (per_cu < 1) { fprintf(stderr, "kernel_launch: occupancy query says %d\n", per_cu); per_cu = 1; }
        grid = cus;
    }
    if (grid < 0) return;
    Args a{};
    a.x = (const float*)d_in[0]; a.norm_pre = (const float*)d_in[1]; a.norm_post = (const float*)d_in[2]; a.w_in = (const float*)d_in[3]; a.gdn_conv_w = (const float*)d_in[4];
    a.gdn_a_log = (const float*)d_in[5]; a.gdn_dt_bias = (const float*)d_in[6]; a.gdn_norm_w = (const float*)d_in[7]; a.diff_lambda = (const float*)d_in[8]; a.diff_norm_w = (const float*)d_in[9];
    a.sc_conv_w = (const float*)d_in[10]; a.w_branch = (const float*)d_in[11]; a.w_out = (const float*)d_in[12];
    a.out = (float*)d_out; a.ws = (unsigned char*)d_ws; a.ph_lo = 0; a.ph_hi = 0; a.coop = 1; a.pad = 0;
    void* args[] = {&a};
    hipError_t e = hipLaunchCooperativeKernel((const void*)fwd, dim3(grid), dim3(NTHR), args, LDS_BYTES, stream);
    if (e != hipSuccess) fprintf(stderr, "cooperative launch failed: %s (grid %d)\n", hipGetErrorString(e), grid);
}
```

```cpp
#include <hip/hip_runtime.h>
#include <hip/hip_cooperative_groups.h>
#include <cstdio>
#include <cstdint>
namespace cg = cooperative_groups;
__device__ __forceinline__ int mk_lane() { int r; asm volatile("v_mbcnt_lo_u32_b32 %0, -1, 0\n\tv_mbcnt_hi_u32_b32 %0, -1, %0" : "=v"(r)); return r; }
namespace pg8 {
#define PG8_LAS __attribute__((address_space(3)))
typedef unsigned short bf16_t;
typedef short bf16x8 __attribute__((ext_vector_type(8)));
typedef float f32x4 __attribute__((ext_vector_type(4)));
typedef unsigned u32x4 __attribute__((ext_vector_type(4)));
constexpr int BM = 256, BK = 64, HALF = 128, HTB = HALF * BK * 2  , STAGE_BYTES = 8 * HTB, NXCD = 8, WGM = 8;

__host__ __device__ __forceinline__ int lds_byte(int r, int c) { const int st = (r >> 4) * 2 + (c >> 5), rr = r & 15, cc = c & 31, ob = rr * 64 + cc * 2; return st * 1024 + (ob ^ (((ob >> 9) & 1) << 5)); }
__host__ __device__ __forceinline__ void stage_rc(int b, int& R, int& C) { const int st = b / 1024, sb = b % 1024, swz = sb ^ (((sb >> 9) & 1) << 5); R = (st >> 1) * 16 + swz / 64; C = (st & 1) * 32 + (swz % 64) / 2; }
__host__ __device__ __forceinline__ int perm32(int rho) { const int n = rho >> 4, i = rho & 15; return 8 * (i >> 2) + 4 * n + (i & 3); }

struct Unit { int pm, pn; };
struct Gemm { const bf16_t* A; const bf16_t* Bt; int M, N, K; };

struct StaticOrder {
    int nM, nN, nwg, G, c;
    __host__ __device__ void init(int M, int N, int G_, int c_) { nM = M / BM; nN = N / BM; nwg = nM * nN; G = G_; c = c_; }
    __host__ __device__ bool next(int i, Unit& u) const {
        const long L = (long)i * G + c; if (L >= nwg) return false;
        int wgid = (int)L; { const int q = nwg / NXCD, r = nwg % NXCD, xcd = wgid % NXCD, off = wgid / NXCD; wgid = (xcd < r ? xcd * (q + 1) : r * (q + 1) + (xcd - r) * q) + off; }
        const int nig = WGM * nN, gid = wgid / nig, fm = gid * WGM, gsz = (nM - fm) < WGM ? (nM - fm) : WGM;
        u.pm = fm + ((wgid % nig) % gsz); u.pn = (wgid % nig) / gsz; return true;
    }
    __device__ __forceinline__ void a_ready(const Unit&) const {}
    __device__ __forceinline__ void done(const Unit&) const {}
};
__device__ __forceinline__ unsigned cvt_pk_bf16(float lo, float hi) { unsigned r; asm volatile("v_cvt_pk_bf16_f32 %0, %1, %2" : "=v"(r) : "v"(lo), "v"(hi)); return r; }
typedef float f32x2 __attribute__((ext_vector_type(2)));
template <class Epi, class Sched, bool ALIGN_EPI = false, bool SP2 = false>
__device__ __forceinline__ void gemm_phase(PG8_LAS unsigned char* lds, const Gemm g, const Sched& S, const Epi& E, int wv_) {
    int tid_ = wv_ * 64 + mk_lane(); asm volatile("" : "+v"(tid_)); const int tid = tid_, wid = __builtin_amdgcn_readfirstlane(tid >> 6), lane = tid & 63, wr = wid >> 2, wc = wid & 3, fr = lane & 15, fq = lane >> 4;
    const int K = g.K, nt = K / BK;
    unsigned voffA[2], voffB[2];
#pragma unroll
    for (int i = 0; i < 2; ++i) { int R, C; stage_rc(tid * 16 + i * 8192, R, C); const int Rb = Epi::PERM ? ((R & ~31) + perm32(R & 31)) : R;
        voffA[i] = (unsigned)(R * K + C) * 2u; voffB[i] = (unsigned)(Rb * K + C) * 2u; }
    const size_t kstep = (size_t)(BK * 2);
    const size_t hstep = (size_t)HALF * K * 2;
    const size_t tstep = 2 * hstep;
    const unsigned ldsw = (unsigned)wid * 1024u;
    const int aoff = lds_byte(wr * 64 + fr, fq * 8), boff = lds_byte(wc * 32 + fr, fq * 8);
#define PG8_SA(b, h) (((b) * 2 + (h)) * HTB)
#define PG8_SB(b, h) ((4 + (b) * 2 + (h)) * HTB)
#define PG8_STAGE(bufoff, gbase, voff) do { _Pragma("unroll") for (int _i = 0; _i < 2; ++_i) \
        __builtin_amdgcn_global_load_lds((const unsigned*)((const char*)(gbase) + (voff)[_i]), (PG8_LAS unsigned*)(lds + (bufoff) + ldsw + _i * 8192), 16, 0, 0); } while (0)
#define PG8_LDA(dst, b, h) do { _Pragma("unroll") for (int m = 0; m < 4; ++m) _Pragma("unroll") for (int k = 0; k < 2; ++k) dst[m][k] = *(const PG8_LAS bf16x8*)(lds + PG8_SA(b, h) + aoff + m * 2048 + k * 1024); } while (0)
#define PG8_LDB(dst, b, h) do { _Pragma("unroll") for (int n = 0; n < 2; ++n) _Pragma("unroll") for (int k = 0; k < 2; ++k) dst[n][k] = *(const PG8_LAS bf16x8*)(lds + PG8_SB(b, h) + boff + n * 2048 + k * 1024); } while (0)
#define PG8_MMA(ai, bj, At, Bt) do { __builtin_amdgcn_s_setprio(1); _Pragma("unroll") for (int m = 0; m < 4; ++m) _Pragma("unroll") for (int n = 0; n < 2; ++n) _Pragma("unroll") for (int k = 0; k < 2; ++k) \
        acc[ai][bj][m][n] = __builtin_amdgcn_mfma_f32_16x16x32_bf16(Bt[n][k], At[m][k], acc[ai][bj][m][n], 0, 0, 0); __builtin_amdgcn_s_setprio(0); } while (0)
#define PG8_WAIT_V(n) asm volatile("s_waitcnt vmcnt(" #n ")" ::: "memory")
#define PG8_WAIT_L(n) asm volatile("s_waitcnt lgkmcnt(" #n ")" ::: "memory")
#define PG8_BAR __builtin_amdgcn_s_barrier()
#define PG8_SCHED __builtin_amdgcn_sched_barrier(0)
    Unit cur, nxt; int ui = 0;
    if (!S.next(0, cur)) return;
    f32x4 acc[2][2][4][2];
#pragma unroll
    for (int a = 0; a < 2; ++a)
#pragma unroll
        for (int b = 0; b < 2; ++b)
#pragma unroll
            for (int m = 0; m < 4; ++m)
#pragma unroll
                for (int n = 0; n < 2; ++n) acc[a][b][m][n] = (f32x4){0.f, 0.f, 0.f, 0.f};
    bf16x8 At[4][2], B0[2][2], B1[2][2];
    const char* cA = (const char*)g.A + (size_t)cur.pm * tstep; const char* cB = (const char*)g.Bt + (size_t)cur.pn * tstep;
    S.a_ready(cur);
    if constexpr (SP2) {
        PG8_STAGE(PG8_SB(0, 0), cB, voffB); PG8_STAGE(PG8_SB(0, 1), cB + hstep, voffB); PG8_STAGE(PG8_SA(0, 0), cA, voffA); PG8_STAGE(PG8_SA(0, 1), cA + hstep, voffA);
        if (wr == 1) PG8_BAR;
        PG8_WAIT_V(2); PG8_BAR;
        PG8_STAGE(PG8_SB(1, 0), cB + kstep, voffB); PG8_STAGE(PG8_SA(1, 0), cA + kstep, voffA); PG8_STAGE(PG8_SB(1, 1), cB + hstep + kstep, voffB);
        PG8_WAIT_V(6); PG8_BAR;
    } else {
        PG8_STAGE(PG8_SB(0, 0), cB, voffB); PG8_STAGE(PG8_SA(0, 0), cA, voffA); PG8_STAGE(PG8_SB(0, 1), cB + hstep, voffB); PG8_STAGE(PG8_SA(0, 1), cA + hstep, voffA);
        if (wr == 1) PG8_BAR;
        PG8_WAIT_V(4); PG8_BAR;
        PG8_STAGE(PG8_SB(1, 0), cB + kstep, voffB); PG8_STAGE(PG8_SA(1, 0), cA + kstep, voffA); PG8_STAGE(PG8_SB(1, 1), cB + hstep + kstep, voffB);
        PG8_WAIT_V(6); PG8_BAR;
    }
    for (;;) {
        const bool has_next = S.next(ui + 1, nxt);
        const char* nA = has_next ? (const char*)g.A + (size_t)nxt.pm * tstep : cA; const char* nB = has_next ? (const char*)g.Bt + (size_t)nxt.pn * tstep : cB;
        for (int t = 0; t < nt; t += 2) {
            const bool last = (t == nt - 2);
            const char* a1 = cA + (size_t)(t + 1) * kstep;
            const char* a2 = last ? nA : cA + (size_t)(t + 2) * kstep; const char* b2 = last ? nB : cB + (size_t)(t + 2) * kstep;
            const char* a3 = a2 + kstep; const char* b3 = b2 + kstep;
            if (last && has_next) S.a_ready(nxt);
            if constexpr (SP2) {
            PG8_LDB(B0, 0, 0); PG8_LDB(B1, 0, 1); PG8_SCHED; PG8_LDA(At, 0, 0); PG8_STAGE(PG8_SA(1, 1), a1 + hstep, voffA);
            PG8_WAIT_V(8); PG8_WAIT_L(0); PG8_BAR; PG8_MMA(0, 0, At, B0); PG8_MMA(0, 1, At, B1); PG8_BAR; PG8_SCHED;
            PG8_LDA(At, 0, 1); PG8_STAGE(PG8_SB(0, 0), b2, voffB); PG8_STAGE(PG8_SB(0, 1), b2 + hstep, voffB); PG8_STAGE(PG8_SA(0, 0), a2, voffA);
            PG8_WAIT_V(8); PG8_WAIT_L(0); PG8_BAR; PG8_MMA(1, 0, At, B0); PG8_MMA(1, 1, At, B1); PG8_BAR; PG8_SCHED;
            PG8_LDB(B0, 1, 0); PG8_LDB(B1, 1, 1); PG8_SCHED; PG8_LDA(At, 1, 0); PG8_STAGE(PG8_SA(0, 1), a2 + hstep, voffA);
            PG8_WAIT_V(8); PG8_WAIT_L(0); PG8_BAR; PG8_MMA(0, 0, At, B0); PG8_MMA(0, 1, At, B1); PG8_BAR; PG8_SCHED;
            PG8_LDA(At, 1, 1); PG8_STAGE(PG8_SB(1, 0), b3, voffB); PG8_STAGE(PG8_SB(1, 1), b3 + hstep, voffB); PG8_STAGE(PG8_SA(1, 0), a3, voffA);
            PG8_WAIT_V(8); PG8_WAIT_L(0); PG8_BAR; PG8_MMA(1, 0, At, B0); PG8_MMA(1, 1, At, B1); PG8_BAR; PG8_SCHED;
            } else {
            PG8_LDB(B0, 0, 0); PG8_SCHED; PG8_LDA(At, 0, 0); PG8_STAGE(PG8_SA(1, 1), a1 + hstep, voffA);
            PG8_WAIT_L(8); PG8_BAR; PG8_WAIT_L(0); PG8_MMA(0, 0, At, B0); PG8_BAR; PG8_SCHED;
            PG8_LDB(B1, 0, 1); PG8_STAGE(PG8_SB(0, 0), b2, voffB);
            PG8_BAR; PG8_WAIT_L(0); PG8_MMA(0, 1, At, B1); PG8_BAR;
            PG8_LDA(At, 0, 1); PG8_STAGE(PG8_SA(0, 0), a2, voffA);
            PG8_BAR; PG8_WAIT_L(0); PG8_MMA(1, 0, At, B0); PG8_BAR; PG8_SCHED;
            PG8_STAGE(PG8_SB(0, 1), b2 + hstep, voffB);
            PG8_WAIT_V(6); PG8_BAR; PG8_MMA(1, 1, At, B1); PG8_BAR;
            PG8_LDB(B0, 1, 0); PG8_SCHED; PG8_LDA(At, 1, 0); PG8_STAGE(PG8_SA(0, 1), a2 + hstep, voffA);
            PG8_WAIT_L(8); PG8_BAR; PG8_WAIT_L(0); PG8_MMA(0, 0, At, B0); PG8_BAR; PG8_SCHED;
            PG8_LDB(B1, 1, 1); PG8_STAGE(PG8_SB(1, 0), b3, voffB);
            PG8_BAR; PG8_WAIT_L(0); PG8_MMA(0, 1, At, B1); PG8_BAR;
            PG8_LDA(At, 1, 1); PG8_STAGE(PG8_SA(1, 0), a3, voffA);
            PG8_BAR; PG8_WAIT_L(0); PG8_MMA(1, 0, At, B0); PG8_BAR; PG8_SCHED;
            PG8_STAGE(PG8_SB(1, 1), b3 + hstep, voffB);
            PG8_WAIT_V(6); PG8_BAR; PG8_MMA(1, 1, At, B1); PG8_BAR;
            }
        }
        if constexpr (ALIGN_EPI) { if (wr == 0) PG8_BAR; }
        if constexpr (!Epi::AFTER_DRAIN) { E(acc, cur, wr, wc, fr, fq); S.done(cur); }
        if (!has_next) break;
#pragma unroll
        for (int a = 0; a < 2; ++a)
#pragma unroll
            for (int b = 0; b < 2; ++b)
#pragma unroll
                for (int m = 0; m < 4; ++m)
#pragma unroll
                    for (int n = 0; n < 2; ++n) acc[a][b][m][n] = (f32x4){0.f, 0.f, 0.f, 0.f};
        cur = nxt; cA = nA; cB = nB; ++ui;
        if constexpr (ALIGN_EPI) { if (wr == 1) PG8_BAR; }
    }
    PG8_WAIT_V(0);
    if constexpr (!ALIGN_EPI) { if (wr == 0) PG8_BAR; }
    PG8_BAR;
    if constexpr (Epi::AFTER_DRAIN) { E.fused(acc, cur, wr, wc, fr, fq, lds, wid, lane); S.done(cur); }
#undef PG8_SA
#undef PG8_SB
#undef PG8_STAGE
#undef PG8_LDA
#undef PG8_LDB
#undef PG8_MMA
#undef PG8_WAIT_V
#undef PG8_WAIT_L
#undef PG8_BAR
#undef PG8_SCHED
}
}
constexpr int BATCH = 2, SEQ = 8192, DM = 1024, DEPTH = 4, M = BATCH * SEQ;
constexpr int NIN = 9224, NP = 9216, NPAD = 9472, BW = 512;
constexpr int C_GQ = 0, C_GK = 512, C_GV = 1024, C_GZ = 1536, C_DQ = 2048, C_DK = 2560, C_DV = 3072, C_DZ = 3584,
              C_SB = 4096, C_SC = 4608, C_SX = 5120, C_SZ = 5632, C_MG = 6144;
constexpr float EPS = 1e-6f;
constexpr int NWAVES = 8, NTHR = 512;
constexpr int LDS_BYTES = 147456;
constexpr size_t MiB = 1u << 20;
constexpr size_t WS_CTL = 0;
constexpr size_t WS_WIN = 2 * MiB;
constexpr size_t WIN_L = (size_t)NPAD * DM;
constexpr size_t WS_WBR = 76 * MiB;
constexpr size_t WS_WOUT = 88 * MiB;
constexpr size_t WS_PROJ = 96 * MiB;
constexpr size_t WS_BA = 384 * MiB;
constexpr size_t WS_REGB = 386 * MiB;
constexpr size_t WS_REGC = 418 * MiB;
constexpr size_t WS_REGD = 482 * MiB;
constexpr size_t WS_GL = 554 * MiB;
constexpr size_t WS_END = 555 * MiB;
constexpr int NUNIT = BATCH * 4 * 128;
constexpr size_t GD_U = 0, GD_W = (size_t)NUNIT * 8192, GD_QD = 2 * GD_W, GD_KD = 3 * GD_W, GD_QK = 4 * GD_W;

typedef unsigned short bf16;
typedef unsigned v4u __attribute__((ext_vector_type(4)));
typedef unsigned v2u __attribute__((ext_vector_type(2)));
typedef float f32x4 __attribute__((ext_vector_type(4)));
#define LAS __attribute__((address_space(3)))

__device__ __forceinline__ unsigned f2bf(float f) { unsigned u = __builtin_bit_cast(unsigned, f); return (u + 0x7fffu + ((u >> 16) & 1u)) >> 16; }
__device__ __forceinline__ unsigned pk2(float lo, float hi) { return f2bf(lo) | (f2bf(hi) << 16); }
__device__ __forceinline__ float bf2f(unsigned short b) { return __builtin_bit_cast(float, (unsigned)b << 16); }
__device__ __forceinline__ float bflo(unsigned w) { return __builtin_bit_cast(float, w << 16); }
__device__ __forceinline__ float bfhi(unsigned w) { return __builtin_bit_cast(float, w & 0xffff0000u); }
__device__ __forceinline__ void ld8(const bf16* p, float* f) { const v4u w = *(const v4u*)p; f[0] = bflo(w.x); f[1] = bfhi(w.x); f[2] = bflo(w.y); f[3] = bfhi(w.y); f[4] = bflo(w.z); f[5] = bfhi(w.z); f[6] = bflo(w.w); f[7] = bfhi(w.w); }
__device__ __forceinline__ void st8(bf16* p, const float* f) { v4u w; w.x = pk2(f[0], f[1]); w.y = pk2(f[2], f[3]); w.z = pk2(f[4], f[5]); w.w = pk2(f[6], f[7]); *(v4u*)p = w; }
__device__ __forceinline__ float wave_sum(float v) {
#pragma unroll
    for (int o = 1; o < 64; o <<= 1) v += __shfl_xor(v, o);
    return v;
}
__device__ __forceinline__ float sigmoidf_(float x) { return 1.f / (1.f + __expf(-x)); }
__device__ __forceinline__ float siluf_(float x) { return x / (1.f + __expf(-x)); }
__device__ __forceinline__ int srccol(int p) { return p < 2048 ? p : (p < 9216 ? p + 8 : (p < 9224 ? 2048 + (p - 9216) : -1)); }

struct Args {
    const float* x; const float* norm_pre; const float* norm_post; const float* w_in; const float* gdn_conv_w; const float* gdn_a_log; const float* gdn_dt_bias;
    const float* gdn_norm_w; const float* diff_lambda; const float* diff_norm_w; const float* sc_conv_w; const float* w_branch; const float* w_out;
    float* out; unsigned char* ws; int ph_lo, ph_hi, coop, pad;
};

struct EpiProj {
    static constexpr bool PERM = true, AFTER_DRAIN = false;
    bf16* P; float* BA;
    __device__ __forceinline__ void operator()(const pg8::f32x4 (&acc)[2][2][4][2], const pg8::Unit& u, int wr, int wc, int fr, int fq) const {
        const int row0 = u.pm * 256 + wr * 64 + fr;
        if (u.pn == 36) {
            if (wc == 0 && fq == 0) {
#pragma unroll
                for (int ai = 0; ai < 2; ++ai)
#pragma unroll
                    for (int m = 0; m < 4; ++m) { float* o = BA + (size_t)(row0 + ai * 128 + m * 16) * 8; *(pg8::f32x4*)o = acc[ai][0][m][0]; *(pg8::f32x4*)(o + 4) = acc[ai][0][m][1]; }
            }
            return;
        }
        const int colt = u.pn * 256; const float sc = (colt >= C_DQ && colt < C_DK) ? 0.18033688011112042f : 1.f;
        const int col0 = colt + wc * 32 + 8 * fq;
#pragma unroll
        for (int ai = 0; ai < 2; ++ai)
#pragma unroll
            for (int m = 0; m < 4; ++m) { bf16* rowp = P + (size_t)(row0 + ai * 128 + m * 16) * NP + col0;
#pragma unroll
                for (int bj = 0; bj < 2; ++bj) { const pg8::f32x4 v0 = acc[ai][bj][m][0] * sc, v1 = acc[ai][bj][m][1] * sc; v4u w;
                    w.x = pg8::cvt_pk_bf16(v0[0], v0[1]); w.y = pg8::cvt_pk_bf16(v0[2], v0[3]); w.z = pg8::cvt_pk_bf16(v1[0], v1[1]); w.w = pg8::cvt_pk_bf16(v1[2], v1[3]);
                    *(v4u*)(rowp + bj * 128) = w; } }
    }
};
template <int KB> struct EpiBranch {
    static constexpr bool PERM = true, AFTER_DRAIN = false;
    const bf16* P; float* MG; bf16* MB;
    __device__ __forceinline__ void operator()(const pg8::f32x4 (&acc)[2][2][4][2], const pg8::Unit& u, int wr, int wc, int fr, int fq) const {
        const int row0 = u.pm * 256 + wr * 64 + fr; const int col0 = u.pn * 256 + wc * 32 + 8 * fq;
#pragma unroll
        for (int ai = 0; ai < 2; ++ai)
#pragma unroll
            for (int m = 0; m < 4; ++m) { const size_t row = (size_t)(row0 + ai * 128 + m * 16);
#pragma unroll
                for (int bj = 0; bj < 2; ++bj) { const int col = col0 + bj * 128; float lg[8]; ld8(P + row * NP + C_MG + KB * 1024 + col, lg);
                    float v[8];
#pragma unroll
                    for (int j = 0; j < 4; ++j) { v[j] = acc[ai][bj][m][0][j] * sigmoidf_(lg[j]); v[4 + j] = acc[ai][bj][m][1][j] * sigmoidf_(lg[4 + j]); }
                    float* mp = MG + row * DM + col;
                    if (KB > 0) { const pg8::f32x4 a = *(const pg8::f32x4*)mp, b = *(const pg8::f32x4*)(mp + 4);
#pragma unroll
                        for (int j = 0; j < 4; ++j) { v[j] += a[j]; v[4 + j] += b[j]; } }
                    if (KB < 2) { *(pg8::f32x4*)mp = (pg8::f32x4){v[0], v[1], v[2], v[3]}; *(pg8::f32x4*)(mp + 4) = (pg8::f32x4){v[4], v[5], v[6], v[7]}; }
                    else st8(MB + row * DM + col, v); } }
    }
};
struct EpiOutF32 {
    static constexpr bool PERM = true, AFTER_DRAIN = false;
    float* O;
    __device__ __forceinline__ void operator()(const pg8::f32x4 (&acc)[2][2][4][2], const pg8::Unit& u, int wr, int wc, int fr, int fq) const {
        const int row0 = u.pm * 256 + wr * 64 + fr; const int col0 = u.pn * 256 + wc * 32 + 8 * fq;
#pragma unroll
        for (int ai = 0; ai < 2; ++ai)
#pragma unroll
            for (int m = 0; m < 4; ++m) { float* rowp = O + (size_t)(row0 + ai * 128 + m * 16) * DM + col0;
#pragma unroll
                for (int bj = 0; bj < 2; ++bj) { *(pg8::f32x4*)(rowp + bj * 128) = acc[ai][bj][m][0]; *(pg8::f32x4*)(rowp + bj * 128 + 4) = acc[ai][bj][m][1]; } }
    }
};

__device__ __forceinline__ void tr_item(const float* W, int ldw, int K, bf16* WT, int k0, int p0, int mode, float* scr, int lane) {
    const int n = lane & 31; const int p = p0 + n; const int sc = mode ? srccol(p) : p;
#pragma unroll 8
    for (int i = 0; i < 32; ++i) { const int kk = 2 * i + (lane >> 5); scr[kk * 33 + n] = sc >= 0 ? W[(size_t)(k0 + kk) * ldw + sc] : 0.f; }
    asm volatile("s_waitcnt lgkmcnt(0)" ::: "memory");
    const int c = lane & 7;
#pragma unroll
    for (int j = 0; j < 4; ++j) { const int nn = (lane >> 3) + 8 * j; const float* s = scr + (8 * c) * 33 + nn;
        v4u o; o.x = pk2(s[0 * 33], s[1 * 33]); o.y = pk2(s[2 * 33], s[3 * 33]); o.z = pk2(s[4 * 33], s[5 * 33]); o.w = pk2(s[6 * 33], s[7 * 33]);
        *(v4u*)(WT + (size_t)(p0 + nn) * K + k0 + 8 * c) = o; }
    asm volatile("s_waitcnt lgkmcnt(0)" ::: "memory");
}
__device__ __forceinline__ void norm_row_to_h(const float* xrow, const float* wpre, bf16* hrow, int lane) {
    f32x4 v[4]; float s = 0.f;
#pragma unroll
    for (int j = 0; j < 4; ++j) { v[j] = *(const f32x4*)(xrow + 4 * lane + 256 * j); s += (v[j].x * v[j].x + v[j].y * v[j].y) + (v[j].z * v[j].z + v[j].w * v[j].w); }
    const float rs = rsqrtf(wave_sum(s) * (1.f / DM) + EPS);
#pragma unroll
    for (int j = 0; j < 4; ++j) { const f32x4 w = *(const f32x4*)(wpre + 4 * lane + 256 * j); v2u o; o.x = pk2(v[j].x * rs * w.x, v[j].y * rs * w.y); o.y = pk2(v[j].z * rs * w.z, v[j].w * rs * w.w);
        *(v2u*)(hrow + 4 * lane + 256 * j) = o; }
}
__device__ __forceinline__ void phase_prologue(const Args& a, unsigned char* lds, int wv_) {
    int tid_ = wv_ * 64 + mk_lane(); asm volatile("" : "+v"(tid_)); const int tid = tid_, lane = tid & 63, wave = tid >> 6;
    float* scr = (float*)(lds + wave * 16384);
    const int gw = blockIdx.x * NWAVES + wave, NGW = gridDim.x * NWAVES;
    constexpr int I_IN = (DM / 64) * (NPAD / 32), I_BR = (BW / 64) * (DM / 32), I_OUT = (DM / 64) * (DM / 32);
    constexpr int NITEMS = DEPTH * I_IN + DEPTH * 3 * I_BR + DEPTH * I_OUT;
    bf16* win = (bf16*)(a.ws + WS_WIN); bf16* wbr = (bf16*)(a.ws + WS_WBR); bf16* wout = (bf16*)(a.ws + WS_WOUT);
    for (int it = gw; it < NITEMS; it += NGW) {
        int r = it;
        if (r < DEPTH * I_IN) { const int l = r / I_IN; r %= I_IN; const int nb = NPAD / 32, kb = r / nb, pb = r % nb;
            tr_item(a.w_in + (size_t)l * DM * NIN, NIN, DM, win + (size_t)l * WIN_L, kb * 64, pb * 32, 1, scr, lane); continue; }
        r -= DEPTH * I_IN;
        if (r < DEPTH * 3 * I_BR) { const int lk = r / I_BR; r %= I_BR; const int nb = DM / 32, kb = r / nb, pb = r % nb;
            tr_item(a.w_branch + (size_t)lk * BW * DM, DM, BW, wbr + (size_t)lk * DM * BW, kb * 64, pb * 32, 0, scr, lane); continue; }
        r -= DEPTH * 3 * I_BR;
        { const int l = r / I_OUT; r %= I_OUT; const int nb = DM / 32, kb = r / nb, pb = r % nb;
            tr_item(a.w_out + (size_t)l * DM * DM, DM, DM, wout + (size_t)l * DM * DM, kb * 64, pb * 32, 0, scr, lane); }
    }
    bf16* H = (bf16*)(a.ws + WS_REGB);
    for (int m = gw; m < M; m += NGW) norm_row_to_h(a.x + (size_t)m * DM, a.norm_pre, H + (size_t)m * DM, lane);
}

typedef short bf16x8 __attribute__((ext_vector_type(8)));
typedef float f32x16 __attribute__((ext_vector_type(16)));
typedef float f32x2_t __attribute__((ext_vector_type(2))); typedef __bf16 bf16x2_t __attribute__((ext_vector_type(2)));
__device__ __forceinline__ unsigned cvtpk(float lo, float hi) { f32x2_t v = {lo, hi}; bf16x2_t bb = __builtin_convertvector(v, bf16x2_t); return __builtin_bit_cast(unsigned, bb); }
__device__ __forceinline__ int crow(int r, int hi) { return (r & 3) + 8 * (r >> 2) + 4 * hi; }
#define MFMA32(a, b, c) __builtin_amdgcn_mfma_f32_32x32x16_bf16((a), (b), (c), 0, 0, 0)
constexpr int AT_KS = 0, AT_VT = 64 * 144, AT_FS = AT_VT + 128 * 144;
__device__ __forceinline__ void phase_attn(const Args& a, unsigned char* lds, int l, int wv_) {
    const bf16* P = (const bf16*)(a.ws + WS_PROJ); float* OATT = (float*)(a.ws + WS_REGC);
    int tid_ = wv_ * 64 + mk_lane(); asm volatile("" : "+v"(tid_)); const int tid = tid_, lane = tid & 63, r32 = lane & 31, hi = lane >> 5, wave = tid >> 6;
    float* fs = (float*)(lds + AT_FS) + wave * 32;
#pragma unroll 1
    for (int it = blockIdx.x; it < 256; it += gridDim.x) {
        const int stream = it >> 4, pp = it & 15;
        const int bb = stream >> 3, h = (stream >> 1) & 3, mp = stream & 1;
        const float slope2 = exp2f(-2.f * (float)(h + 1)) * 1.4426950408889634f;
        const bf16* Kg = P + (size_t)bb * SEQ * NP + C_DK + h * 128 + mp * 64 + (size_t)(tid >> 3) * NP + (tid & 7) * 8;
        const bf16* Vg = P + (size_t)bb * SEQ * NP + C_DV + h * 128 + (size_t)lane * NP + wave * 8;
#pragma unroll 1
        for (int uu = 0; uu < 2; ++uu) {
            const int qb = uu == 0 ? pp : 31 - pp;
            const int q0 = qb * 256 + wave * 32, t = q0 + r32;
            bf16x8 qr[4];
            { const bf16* qp = P + ((size_t)bb * SEQ + t) * NP + C_DQ + h * 128 + mp * 64 + hi * 8;
#pragma unroll
              for (int d0 = 0; d0 < 4; ++d0) qr[d0] = *(const bf16x8*)(qp + d0 * 16); }
            float cb[16];
#pragma unroll
            for (int r = 0; r < 16; ++r) cb[r] = slope2 * (float)crow(r, hi);
            f32x16 o[4];
#pragma unroll
            for (int db = 0; db < 4; ++db)
#pragma unroll
                for (int r = 0; r < 16; ++r) o[db][r] = 0.f;
            float m_ref = -1e30f, lsum = 0.f;
            const int ntile = 4 * qb + 4;
            v4u kreg, vreg0, vreg1;
            { const size_t jo = (size_t)(ntile - 1) * 64 * NP; kreg = *(const v4u*)(Kg + jo); vreg0 = *(const v4u*)(Vg + jo); vreg1 = *(const v4u*)(Vg + jo + 64); }
#pragma unroll 1
            for (int tt = ntile - 1; tt >= 0; --tt) {
                __syncthreads();
                *(v4u*)(lds + AT_KS + (tid >> 3) * 144 + (tid & 7) * 16) = kreg;
                { unsigned short* vt = (unsigned short*)(lds + AT_VT) + lane;
                  const unsigned w0[4] = {vreg0.x, vreg0.y, vreg0.z, vreg0.w}, w1[4] = {vreg1.x, vreg1.y, vreg1.z, vreg1.w};
#pragma unroll
                  for (int x = 0; x < 4; ++x) { vt[(wave * 8 + 2 * x) * 72] = (unsigned short)(w0[x] & 0xffffu); vt[(wave * 8 + 2 * x + 1) * 72] = (unsigned short)(w0[x] >> 16);
                      vt[(64 + wave * 8 + 2 * x) * 72] = (unsigned short)(w1[x] & 0xffffu); vt[(64 + wave * 8 + 2 * x + 1) * 72] = (unsigned short)(w1[x] >> 16); } }
                __syncthreads();
                if (tt > 0) { const size_t jo = (size_t)(tt - 1) * 64 * NP; kreg = *(const v4u*)(Kg + jo); vreg0 = *(const v4u*)(Vg + jo); vreg1 = *(const v4u*)(Vg + jo + 64); }
                const int j0 = tt * 64;
                if (j0 <= q0 + 31) {
                    const float base = slope2 * (float)(j0 - t), base1 = base + 32.f * slope2;
                    f32x16 p0, p1;
#pragma unroll
                    for (int r = 0; r < 16; ++r) { p0[r] = cb[r] + base; p1[r] = cb[r] + base1; }
                    { const unsigned char* kb = lds + AT_KS + r32 * 144 + hi * 16;
#pragma unroll
                      for (int d0 = 0; d0 < 4; ++d0) { const bf16x8 a0 = *(const bf16x8*)(kb + d0 * 32), a1 = *(const bf16x8*)(kb + 32 * 144 + d0 * 32);
                          p0 = MFMA32(a0, qr[d0], p0); p1 = MFMA32(a1, qr[d0], p1); } }
                    if (j0 + 63 > q0) {
#pragma unroll
                        for (int r = 0; r < 16; ++r) { const int kv = j0 + crow(r, hi); if (kv > t) p0[r] = -1e30f; if (kv + 32 > t) p1[r] = -1e30f; }
                    }
                    float mx = fmaxf(p0[0], p1[0]);
#pragma unroll
                    for (int r = 1; r < 16; ++r) mx = fmaxf(mx, fmaxf(p0[r], p1[r]));
                    mx = fmaxf(mx, __shfl_xor(mx, 32));
                    if (__any(mx > m_ref + 8.f)) {
                        const float m_new = fmaxf(m_ref, mx), f = __builtin_amdgcn_exp2f(m_ref - m_new); m_ref = m_new; lsum *= f;
                        if (hi == 0) fs[r32] = f;
                        __builtin_amdgcn_wave_barrier();
#pragma unroll
                        for (int g = 0; g < 4; ++g) { const f32x4 ff = *(const f32x4*)(fs + 8 * g + 4 * hi);
#pragma unroll
                            for (int db = 0; db < 4; ++db) { o[db][4 * g] *= ff.x; o[db][4 * g + 1] *= ff.y; o[db][4 * g + 2] *= ff.z; o[db][4 * g + 3] *= ff.w; } }
                        __builtin_amdgcn_wave_barrier();
                    }
                    float sacc = 0.f;
#pragma unroll
                    for (int r = 0; r < 16; ++r) { p0[r] = __builtin_amdgcn_exp2f(p0[r] - m_ref); p1[r] = __builtin_amdgcn_exp2f(p1[r] - m_ref); sacc += p0[r] + p1[r]; }
                    lsum += sacc;
                    bf16x8 pk[4];
#pragma unroll
                    for (int s = 0; s < 2; ++s) { v4u w0, w1;
                        w0.x = cvtpk(p0[8 * s], p0[8 * s + 1]); w0.y = cvtpk(p0[8 * s + 2], p0[8 * s + 3]); w0.z = cvtpk(p0[8 * s + 4], p0[8 * s + 5]); w0.w = cvtpk(p0[8 * s + 6], p0[8 * s + 7]);
                        w1.x = cvtpk(p1[8 * s], p1[8 * s + 1]); w1.y = cvtpk(p1[8 * s + 2], p1[8 * s + 3]); w1.z = cvtpk(p1[8 * s + 4], p1[8 * s + 5]); w1.w = cvtpk(p1[8 * s + 6], p1[8 * s + 7]);
                        pk[s] = __builtin_bit_cast(bf16x8, w0); pk[2 + s] = __builtin_bit_cast(bf16x8, w1); }
                    const unsigned char* vb = lds + AT_VT + r32 * 144 + hi * 8;
#pragma unroll
                    for (int s = 0; s < 4; ++s)
#pragma unroll
                        for (int db = 0; db < 4; ++db) { const v2u lo = *(const v2u*)(vb + db * 32 * 144 + s * 32), hi8 = *(const v2u*)(vb + db * 32 * 144 + s * 32 + 16);
                            v4u w; w.x = lo.x; w.y = lo.y; w.z = hi8.x; w.w = hi8.y;
                            o[db] = MFMA32(pk[s], __builtin_bit_cast(bf16x8, w), o[db]); }
                }
            }
            lsum += __shfl_xor(lsum, 32);
            __builtin_amdgcn_wave_barrier();
            if (hi == 0) fs[r32] = 1.f / lsum;
            __builtin_amdgcn_wave_barrier();
#pragma unroll
            for (int g = 0; g < 4; ++g) { const f32x4 ff = *(const f32x4*)(fs + 8 * g + 4 * hi); const float fv[4] = {ff.x, ff.y, ff.z, ff.w};
#pragma unroll
                for (int x = 0; x < 4; ++x) { const size_t row = (size_t)bb * SEQ + q0 + 8 * g + 4 * hi + x; float* dst = OATT + ((row * 4 + h) * 2 + mp) * 128 + r32;
#pragma unroll
                    for (int db = 0; db < 4; ++db) dst[db * 32] = o[db][4 * g + x] * fv[x]; } }
            __builtin_amdgcn_wave_barrier();
        }
    }
    __syncthreads();
}

__device__ __forceinline__ void phase_gdn_local_v1(const Args& a, unsigned char* lds, int l, int wv_) {
    const bf16* P = (const bf16*)(a.ws + WS_PROJ); const float* BA = (const float*)(a.ws + WS_BA);
    bf16* GD = (bf16*)(a.ws + WS_REGD); float* GL = (float*)(a.ws + WS_GL);
    float* qs = (float*)lds; float* ks = qs + 64 * 129; float* vs = ks + 64 * 129; float* KKs = vs + 64 * 129; float* QKs = KKs + 64 * 65;
    float* beta = QKs + 64 * 65; float* gc = beta + 64;
    int tid_ = wv_ * 64 + mk_lane(); asm volatile("" : "+v"(tid_)); const int tid = tid_, lane = tid & 63, wave = tid >> 6;
    const float* cw = a.gdn_conv_w + (size_t)l * 4 * 1536;
    for (int unit = blockIdx.x; unit < NUNIT; unit += gridDim.x) {
        const int bb = unit >> 9, h = (unit >> 7) & 3, n = unit & 127;
        __syncthreads();
#pragma unroll 1
        for (int idx = tid; idx < 3 * 64 * 128; idx += NTHR) {
            const int mat = idx >> 13, rem = idx & 8191, t = rem >> 7, c = rem & 127, col = mat * 512 + h * 128 + c;
            float acc = 0.f;
#pragma unroll
            for (int j = 0; j < 4; ++j) { const int tt = n * 64 + t - 3 + j; if (tt >= 0) acc += cw[j * 1536 + col] * bf2f(P[((size_t)bb * SEQ + tt) * NP + col]); }
            (mat == 0 ? qs : mat == 1 ? ks : vs)[t * 129 + c] = siluf_(acc);
        }
        if (tid < 64) {
            const size_t row = (size_t)bb * SEQ + n * 64 + tid;
            beta[tid] = sigmoidf_(BA[row * 8 + h]);
            const float xx = BA[row * 8 + 4 + h] + a.gdn_dt_bias[l * 4 + h];
            const float sp = xx > 20.f ? xx : log1pf(__expf(xx));
            gc[tid] = -__expf(a.gdn_a_log[l * 4 + h]) * sp;
        }
        __syncthreads();
        if (tid == 0) { float run = 0.f;
#pragma unroll 1
            for (int c = 0; c < 64; ++c) { run += gc[c]; gc[c] = run; } }
        __syncthreads();
#pragma unroll 1
        for (int r = wave * 8; r < wave * 8 + 8; ++r) {
            { float x0 = qs[r * 129 + lane], x1 = qs[r * 129 + 64 + lane]; const float sc = rsqrtf(wave_sum(x0 * x0 + x1 * x1) + 1e-6f) * 0.08838834764831845f; qs[r * 129 + lane] = x0 * sc; qs[r * 129 + 64 + lane] = x1 * sc; }
            { float x0 = ks[r * 129 + lane], x1 = ks[r * 129 + 64 + lane]; const float sc = rsqrtf(wave_sum(x0 * x0 + x1 * x1) + 1e-6f); ks[r * 129 + lane] = x0 * sc; ks[r * 129 + 64 + lane] = x1 * sc; }
        }
        __syncthreads();
#pragma unroll 1
        for (int i = 0; i < 8; ++i) { const int idx = tid + NTHR * i, c = idx >> 6, s = idx & 63; float kk = 0.f, qk = 0.f;
#pragma unroll 4
            for (int d = 0; d < 128; ++d) { const float kv = ks[s * 129 + d]; kk += ks[c * 129 + d] * kv; qk += qs[c * 129 + d] * kv; }
            const float dec = (s <= c) ? __expf(gc[c] - gc[s]) : 0.f;
            KKs[c * 65 + s] = (s < c) ? kk * beta[c] * dec : 0.f; QKs[c * 65 + s] = qk * dec; }
        __syncthreads();
        const size_t ub = (size_t)unit * 8192;
        { const float gl = gc[63];
          for (int idx = tid; idx < 8192; idx += NTHR) { const int c = idx >> 7, d = idx & 127;
              GD[GD_QD + ub + idx] = (bf16)f2bf(qs[c * 129 + d] * __expf(gc[c])); GD[GD_KD + ub + idx] = (bf16)f2bf(ks[c * 129 + d] * __expf(gl - gc[c])); }
          for (int idx = tid; idx < 4096; idx += NTHR) { const int c = idx >> 6, s = idx & 63; GD[GD_QK + (size_t)unit * 4096 + idx] = (bf16)f2bf(QKs[c * 65 + s]); }
          if (tid == 0) GL[unit] = __expf(gl); }
        __syncthreads();
        for (int idx = tid; idx < 8192; idx += NTHR) { const int c = idx >> 7, d = idx & 127; vs[c * 129 + d] *= beta[c]; ks[c * 129 + d] *= beta[c] * __expf(gc[c]); }
        __syncthreads();
        if (tid < 256) {
            float* X = (tid < 128 ? vs : ks) + (tid & 127);
#pragma unroll 1
            for (int c = 1; c < 64; ++c) { float acc = X[c * 129]; const float* Ar = KKs + c * 65;
#pragma unroll 4
                for (int s = 0; s < c; ++s) acc -= Ar[s] * X[s * 129];
                X[c * 129] = acc; }
            bf16* dst = GD + (tid < 128 ? GD_U : GD_W) + ub + (tid & 127);
            for (int c = 0; c < 64; ++c) dst[c * 128] = (bf16)f2bf(X[c * 129]);
        }
    }
    __syncthreads();
}

__device__ __forceinline__ void phase_gdn_scan_v1(const Args& a, unsigned char* lds, int l, int wv_) {
    const bf16* GD = (const bf16*)(a.ws + WS_REGD); const float* GL = (const float*)(a.ws + WS_GL); float* OG = (float*)(a.ws + WS_REGB);
    float* Ws = (float*)lds; float* QDs = Ws + 64 * 129; float* KDs = QDs + 64 * 129; float* QKs = KDs + 64 * 129; float* Us = QKs + 64 * 65; float* Vn = Us + 64 * 16; float* S = Vn + 64 * 17;
    int tid_ = wv_ * 64 + mk_lane(); asm volatile("" : "+v"(tid_)); const int tid = tid_;
    for (int item = blockIdx.x; item < 64; item += gridDim.x) {
        const int bh = item >> 3, sl = item & 7, bb = bh >> 2, h = bh & 3;
        __syncthreads();
        for (int i = tid; i < 128 * 17; i += NTHR) S[i] = 0.f;
#pragma unroll 1
        for (int n = 0; n < 128; ++n) {
            const int unit = bh * 128 + n; const size_t ub = (size_t)unit * 8192;
            __syncthreads();
            for (int idx = tid; idx < 8192; idx += NTHR) { const int c = idx >> 7, d = idx & 127;
                Ws[c * 129 + d] = bf2f(GD[GD_W + ub + idx]); QDs[c * 129 + d] = bf2f(GD[GD_QD + ub + idx]); KDs[c * 129 + d] = bf2f(GD[GD_KD + ub + idx]); }
            for (int idx = tid; idx < 4096; idx += NTHR) QKs[(idx >> 6) * 65 + (idx & 63)] = bf2f(GD[GD_QK + (size_t)unit * 4096 + idx]);
            for (int idx = tid; idx < 1024; idx += NTHR) { const int c = idx >> 4, j = idx & 15; Us[idx] = bf2f(GD[GD_U + ub + c * 128 + sl * 16 + j]); }
            const float glast = GL[unit];
            __syncthreads();
#pragma unroll 1
            for (int i = 0; i < 2; ++i) { const int idx = tid + NTHR * i, c = idx >> 4, j = idx & 15; float acc = Us[idx];
#pragma unroll 4
                for (int d = 0; d < 128; ++d) acc -= Ws[c * 129 + d] * S[d * 17 + j];
                Vn[c * 17 + j] = acc; }
            __syncthreads();
#pragma unroll 1
            for (int i = 0; i < 2; ++i) { const int idx = tid + NTHR * i, c = idx >> 4, j = idx & 15; float acc = 0.f;
#pragma unroll 4
                for (int d = 0; d < 128; ++d) acc += QDs[c * 129 + d] * S[d * 17 + j];
#pragma unroll 4
                for (int s = 0; s < 64; ++s) acc += QKs[c * 65 + s] * Vn[s * 17 + j];
                OG[((size_t)bb * SEQ + n * 64 + c) * BW + h * 128 + sl * 16 + j] = acc; }
            float sn[4];
#pragma unroll
            for (int i = 0; i < 4; ++i) { const int idx = tid + NTHR * i, d = idx >> 4, j = idx & 15; float acc = S[d * 17 + j] * glast;
#pragma unroll 4
                for (int c = 0; c < 64; ++c) acc += KDs[c * 129 + d] * Vn[c * 17 + j];
                sn[i] = acc; }
            __syncthreads();
#pragma unroll
            for (int i = 0; i < 4; ++i) { const int idx = tid + NTHR * i; S[(idx >> 4) * 17 + (idx & 15)] = sn[i]; }
        }
    }
    __syncthreads();
}

__device__ __forceinline__ void phase_finalize(const Args& a, int l, int wv_) {
    const bf16* P = (const bf16*)(a.ws + WS_PROJ); const float* OG = (const float*)(a.ws + WS_REGB); const float* OATT = (const float*)(a.ws + WS_REGC);
    bf16* Y = (bf16*)(a.ws + WS_REGD);
    int tid_ = wv_ * 64 + mk_lane(); asm volatile("" : "+v"(tid_)); const int tid = tid_, lane = tid & 63, wave = tid >> 6;
    const int gw = blockIdx.x * NWAVES + wave, NGW = gridDim.x * NWAVES;
    const float lam_init = 0.8f - 0.6f * expf(-0.3f * (float)l);
    const float* lv = a.diff_lambda + (size_t)l * 256;
    const float lam = expf(wave_sum(lv[lane] * lv[64 + lane])) - expf(wave_sum(lv[128 + lane] * lv[192 + lane])) + lam_init;
    const int e0 = (lane & 15) * 8, hh = lane >> 4, c0 = lane * 8;
    float gnw[8], dnw[8], scw[3][8];
#pragma unroll
    for (int j = 0; j < 8; ++j) { gnw[j] = a.gdn_norm_w[l * 128 + e0 + j]; dnw[j] = a.diff_norm_w[l * 128 + e0 + j] * (1.f - lam_init);
#pragma unroll
        for (int k = 0; k < 3; ++k) scw[k][j] = a.sc_conv_w[((size_t)l * 3 + k) * BW + c0 + j]; }
    for (int row = gw; row < M; row += NGW) {
        const int t = row & (SEQ - 1);
        const bf16* pr = P + (size_t)row * NP;
        float y[8], z[8];
        { const f32x4 o0 = *(const f32x4*)(OG + (size_t)row * BW + c0), o1 = *(const f32x4*)(OG + (size_t)row * BW + c0 + 4);
          float o[8] = {o0.x, o0.y, o0.z, o0.w, o1.x, o1.y, o1.z, o1.w}; float ss = 0.f;
#pragma unroll
          for (int j = 0; j < 8; ++j) ss += o[j] * o[j];
          ss += __shfl_xor(ss, 1); ss += __shfl_xor(ss, 2); ss += __shfl_xor(ss, 4); ss += __shfl_xor(ss, 8);
          const float rs = rsqrtf(ss * (1.f / 128.f) + EPS); ld8(pr + C_GZ + c0, z);
#pragma unroll
          for (int j = 0; j < 8; ++j) y[j] = o[j] * rs * gnw[j] * siluf_(z[j]);
          st8(Y + (size_t)row * BW + c0, y); }
        { const float* op = OATT + (((size_t)row * 4 + hh) * 2) * 128 + e0;
          const f32x4 a0 = *(const f32x4*)op, a1 = *(const f32x4*)(op + 4), b0 = *(const f32x4*)(op + 128), b1 = *(const f32x4*)(op + 132);
          float d[8] = {a0.x - lam * b0.x, a0.y - lam * b0.y, a0.z - lam * b0.z, a0.w - lam * b0.w, a1.x - lam * b1.x, a1.y - lam * b1.y, a1.z - lam * b1.z, a1.w - lam * b1.w}; float ss = 0.f;
#pragma unroll
          for (int j = 0; j < 8; ++j) ss += d[j] * d[j];
          ss += __shfl_xor(ss, 1); ss += __shfl_xor(ss, 2); ss += __shfl_xor(ss, 4); ss += __shfl_xor(ss, 8);
          const float rs = rsqrtf(ss * (1.f / 128.f) + EPS); ld8(pr + C_DZ + c0, z);
#pragma unroll
          for (int j = 0; j < 8; ++j) y[j] = d[j] * rs * dnw[j] * siluf_(z[j]);
          st8(Y + (size_t)M * BW + (size_t)row * BW + c0, y); }
        { float acc[8];
#pragma unroll
          for (int j = 0; j < 8; ++j) acc[j] = 0.f;
#pragma unroll
          for (int k = 0; k < 3; ++k) { const int tt = t - 2 + k; if (tt >= 0) { float cc[8], xx[8]; const bf16* p2 = P + (size_t)(row - 2 + k) * NP; ld8(p2 + C_SC + c0, cc); ld8(p2 + C_SX + c0, xx);
#pragma unroll
              for (int j = 0; j < 8; ++j) acc[j] += scw[k][j] * (cc[j] * xx[j]); } }
          float sb[8]; ld8(pr + C_SB + c0, sb); ld8(pr + C_SZ + c0, z);
#pragma unroll
          for (int j = 0; j < 8; ++j) y[j] = sb[j] * acc[j] * siluf_(z[j]);
          st8(Y + 2 * (size_t)M * BW + (size_t)row * BW + c0, y); }
    }
}

__device__ __forceinline__ void phase_postnorm(const Args& a, int l, int wv_) {
    const float* OUT = (const float*)(a.ws + WS_REGC); bf16* H = (bf16*)(a.ws + WS_REGB);
    const float* xin = (l == 0) ? a.x : a.out;
    int tid_ = wv_ * 64 + mk_lane(); asm volatile("" : "+v"(tid_)); const int tid = tid_, lane = tid & 63, wave = tid >> 6;
    const int gw = blockIdx.x * NWAVES + wave, NGW = gridDim.x * NWAVES;
    const float* wpost = a.norm_post + (size_t)l * DM; const float* wpre = a.norm_pre + (size_t)(l + 1 < DEPTH ? l + 1 : l) * DM;
    for (int row = gw; row < M; row += NGW) {
        f32x4 o[4], x[4]; float s = 0.f;
#pragma unroll
        for (int j = 0; j < 4; ++j) { o[j] = *(const f32x4*)(OUT + (size_t)row * DM + 4 * lane + 256 * j); x[j] = *(const f32x4*)(xin + (size_t)row * DM + 4 * lane + 256 * j);
            s += (o[j].x * o[j].x + o[j].y * o[j].y) + (o[j].z * o[j].z + o[j].w * o[j].w); }
        const float rs = rsqrtf(wave_sum(s) * (1.f / DM) + EPS); float s2 = 0.f;
#pragma unroll
        for (int j = 0; j < 4; ++j) { const f32x4 w = *(const f32x4*)(wpost + 4 * lane + 256 * j); x[j] = x[j] + o[j] * rs * w; *(f32x4*)(a.out + (size_t)row * DM + 4 * lane + 256 * j) = x[j];
            s2 += (x[j].x * x[j].x + x[j].y * x[j].y) + (x[j].z * x[j].z + x[j].w * x[j].w); }
        if (l + 1 < DEPTH) { const float rs2 = rsqrtf(wave_sum(s2) * (1.f / DM) + EPS);
#pragma unroll
            for (int j = 0; j < 4; ++j) { const f32x4 w = *(const f32x4*)(wpre + 4 * lane + 256 * j); v2u ob; ob.x = pk2(x[j].x * rs2 * w.x, x[j].y * rs2 * w.y); ob.y = pk2(x[j].z * rs2 * w.z, x[j].w * rs2 * w.w);
                *(v2u*)(H + (size_t)row * DM + 4 * lane + 256 * j) = ob; } }
    }
}

constexpr int ARGS_OFF = 143360;
constexpr int ARGS_WORDS = (int)(sizeof(Args) / 4);
__device__ __forceinline__ void load_args(Args& b, unsigned char* lds) {
    volatile LAS unsigned* s = (volatile LAS unsigned*)((LAS unsigned char*)lds + ARGS_OFF); unsigned w[ARGS_WORDS];
#pragma unroll
    for (int i = 0; i < ARGS_WORDS; ++i) w[i] = (unsigned)__builtin_amdgcn_readfirstlane((int)s[i]);
    __builtin_memcpy(&b, w, sizeof(Args));
}
template <int L> __device__ __forceinline__ void run_layer(unsigned char* lds, cg::grid_group& grid, int wv) {
    PG8_LAS unsigned char* lds3 = (PG8_LAS unsigned char*)lds;
    constexpr int l = L;
    {
        Args a; load_args(a, lds); const int G = gridDim.x;
        bf16* WIN = (bf16*)(a.ws + WS_WIN); bf16* PROJ = (bf16*)(a.ws + WS_PROJ); float* BA = (float*)(a.ws + WS_BA); bf16* REGB = (bf16*)(a.ws + WS_REGB);
        pg8::Gemm g{REGB, WIN + (size_t)l * WIN_L, M, NPAD, DM}; pg8::StaticOrder S; S.init(M, NPAD, G, (int)blockIdx.x);
        EpiProj E{PROJ, BA};
        pg8::gemm_phase<EpiProj, pg8::StaticOrder, true, true>(lds3, g, S, E, wv);
    }
    grid.sync();
    { Args a; load_args(a, lds); phase_gdn_local_v1(a, lds, l, wv); }
    { Args a; load_args(a, lds); phase_attn(a, lds, l, wv); }
    grid.sync();
    { Args a; load_args(a, lds); phase_gdn_scan_v1(a, lds, l, wv); }
    grid.sync();
    { Args a; load_args(a, lds); phase_finalize(a, l, wv); }
    grid.sync();
    {
        Args a; load_args(a, lds); const int G = gridDim.x;
        bf16* WBR = (bf16*)(a.ws + WS_WBR); bf16* PROJ = (bf16*)(a.ws + WS_PROJ); bf16* REGB = (bf16*)(a.ws + WS_REGB); float* REGC = (float*)(a.ws + WS_REGC); bf16* Y = (bf16*)(a.ws + WS_REGD);
        pg8::StaticOrder S; S.init(M, DM, G, (int)blockIdx.x);
        { pg8::Gemm g{Y, WBR + ((size_t)l * 3 + 0) * DM * BW, M, DM, BW}; EpiBranch<0> E{PROJ, REGC, REGB}; pg8::gemm_phase<EpiBranch<0>, pg8::StaticOrder, true, true>(lds3, g, S, E, wv); }
        { pg8::Gemm g{Y + (size_t)M * BW, WBR + ((size_t)l * 3 + 1) * DM * BW, M, DM, BW}; EpiBranch<1> E{PROJ, REGC, REGB}; pg8::gemm_phase<EpiBranch<1>, pg8::StaticOrder, true, true>(lds3, g, S, E, wv); }
        { pg8::Gemm g{Y + 2 * (size_t)M * BW, WBR + ((size_t)l * 3 + 2) * DM * BW, M, DM, BW}; EpiBranch<2> E{PROJ, REGC, REGB}; pg8::gemm_phase<EpiBranch<2>, pg8::StaticOrder, true, true>(lds3, g, S, E, wv); }
    }
    grid.sync();
    {
        Args a; load_args(a, lds); const int G = gridDim.x;
        bf16* WOUT = (bf16*)(a.ws + WS_WOUT); bf16* REGB = (bf16*)(a.ws + WS_REGB); float* REGC = (float*)(a.ws + WS_REGC);
        pg8::Gemm g{REGB, WOUT + (size_t)l * DM * DM, M, DM, DM}; pg8::StaticOrder S; S.init(M, DM, G, (int)blockIdx.x);
        EpiOutF32 E{REGC};
        pg8::gemm_phase<EpiOutF32, pg8::StaticOrder, true, true>(lds3, g, S, E, wv);
    }
    grid.sync();
    { Args a; load_args(a, lds); phase_postnorm(a, l, wv); }
    if (L + 1 < DEPTH) grid.sync();
}
__global__ void __launch_bounds__(NTHR, 2) fwd(Args a0) {
    extern __shared__ __attribute__((aligned(16))) unsigned char lds[];
    cg::grid_group grid = cg::this_grid();
    const int wv = __builtin_amdgcn_readfirstlane((int)threadIdx.x >> 6);
    if (threadIdx.x == 0) { unsigned w[ARGS_WORDS]; __builtin_memcpy(w, &a0, sizeof(Args));
#pragma unroll
        for (int i = 0; i < ARGS_WORDS; ++i) ((volatile LAS unsigned*)((LAS unsigned char*)lds + ARGS_OFF))[i] = w[i]; }
    __syncthreads();
    { Args a; load_args(a, lds); phase_prologue(a, lds, wv); }
    grid.sync();
    run_layer<0>(lds, grid, wv);
    run_layer<1>(lds, grid, wv);
    run_layer<2>(lds, grid, wv);
    run_layer<3>(lds, grid, wv);
}

extern "C" void kernel_launch(void* const* d_in, const int* in_sizes, int n_in, void* d_out, int out_size, void* d_ws, size_t ws_size, hipStream_t stream) {
    static int grid = 0;
    if (grid == 0) {
        if (n_in != 13 || ws_size < WS_END) { fprintf(stderr, "kernel_launch: unexpected n_in %d or ws %zu\n", n_in, ws_size); grid = -1; return; }
        int dev = 0, cus = 0, per_cu = 0;
        hipGetDevice(&dev); hipDeviceGetAttribute(&cus, hipDeviceAttributeMultiprocessorCount, dev);
        hipFuncSetAttribute((const void*)fwd, hipFuncAttributeMaxDynamicSharedMemorySize, LDS_BYTES);
        hipOccupancyMaxActiveBlocksPerMultiprocessor(&per_cu, (const void*)fwd, NTHR, LDS_BYTES);
        (void)hipGetLastError();
        if (per_cu < 1) { fprintf(stderr, "kernel_launch: occupancy query says %d\n", per_cu); per_cu = 1; }
        grid = cus;
    }
    if (grid < 0) return;
    Args a{};
    a.x = (const float*)d_in[0]; a.norm_pre = (const float*)d_in[1]; a.norm_post = (const float*)d_in[2]; a.w_in = (const float*)d_in[3]; a.gdn_conv_w = (const float*)d_in[4];
    a.gdn_a_log = (const float*)d_in[5]; a.gdn_dt_bias = (const float*)d_in[6]; a.gdn_norm_w = (const float*)d_in[7]; a.diff_lambda = (const float*)d_in[8]; a.diff_norm_w = (const float*)d_in[9];
    a.sc_conv_w = (const float*)d_in[10]; a.w_branch = (const float*)d_in[11]; a.w_out = (const float*)d_in[12];
    a.out = (float*)d_out; a.ws = (unsigned char*)d_ws; a.ph_lo = 0; a.ph_hi = 0; a.coop = 1; a.pad = 0;
    void* args[] = {&a};
    hipError_t e = hipLaunchCooperativeKernel((const void*)fwd, dim3(grid), dim3(NTHR), args, LDS_BYTES, stream);
    if (e != hipSuccess) fprintf(stderr, "cooperative launch failed: %s (grid %d)\n", hipGetErrorString(e), grid);
}
```

```cpp
#include <hip/hip_runtime.h>
#include <hip/hip_cooperative_groups.h>
#include <cstdio>
#include <cstdint>
namespace cg = cooperative_groups;
__device__ __forceinline__ int mk_lane() { int r; asm volatile("v_mbcnt_lo_u32_b32 %0, -1, 0\n\tv_mbcnt_hi_u32_b32 %0, -1, %0" : "=v"(r)); return r; }
namespace pg8 {
#define PG8_LAS __attribute__((address_space(3)))
typedef unsigned short bf16_t;
typedef short bf16x8 __attribute__((ext_vector_type(8)));
typedef float f32x4 __attribute__((ext_vector_type(4)));
typedef unsigned u32x4 __attribute__((ext_vector_type(4)));
constexpr int BM = 256, BK = 64, HALF = 128, HTB = HALF * BK * 2  , STAGE_BYTES = 8 * HTB, NXCD = 8, WGM = 8;

__host__ __device__ __forceinline__ int lds_byte(int r, int c) { const int st = (r >> 4) * 2 + (c >> 5), rr = r & 15, cc = c & 31, ob = rr * 64 + cc * 2; return st * 1024 + (ob ^ (((ob >> 9) & 1) << 5)); }
__host__ __device__ __forceinline__ void stage_rc(int b, int& R, int& C) { const int st = b / 1024, sb = b % 1024, swz = sb ^ (((sb >> 9) & 1) << 5); R = (st >> 1) * 16 + swz / 64; C = (st & 1) * 32 + (swz % 64) / 2; }
__host__ __device__ __forceinline__ int perm32(int rho) { const int n = rho >> 4, i = rho & 15; return 8 * (i >> 2) + 4 * n + (i & 3); }

struct Unit { int pm, pn; };
struct Gemm { const bf16_t* A; const bf16_t* Bt; int M, N, K; };

struct StaticOrder {
    int nM, nN, nwg, G, c;
    __host__ __device__ void init(int M, int N, int G_, int c_) { nM = M / BM; nN = N / BM; nwg = nM * nN; G = G_; c = c_; }
    __host__ __device__ bool next(int i, Unit& u) const {
        const long L = (long)i * G + c; if (L >= nwg) return false;
        int wgid = (int)L; { const int q = nwg / NXCD, r = nwg % NXCD, xcd = wgid % NXCD, off = wgid / NXCD; wgid = (xcd < r ? xcd * (q + 1) : r * (q + 1) + (xcd - r) * q) + off; }
        const int nig = WGM * nN, gid = wgid / nig, fm = gid * WGM, gsz = (nM - fm) < WGM ? (nM - fm) : WGM;
        u.pm = fm + ((wgid % nig) % gsz); u.pn = (wgid % nig) / gsz; return true;
    }
    __device__ __forceinline__ void a_ready(const Unit&) const {}
    __device__ __forceinline__ void done(const Unit&) const {}
};
__device__ __forceinline__ unsigned cvt_pk_bf16(float lo, float hi) { unsigned r; asm volatile("v_cvt_pk_bf16_f32 %0, %1, %2" : "=v"(r) : "v"(lo), "v"(hi)); return r; }
typedef float f32x2 __attribute__((ext_vector_type(2)));
template <class Epi, class Sched, bool ALIGN_EPI = false, bool SP2 = false>
__device__ __forceinline__ void gemm_phase(PG8_LAS unsigned char* lds, const Gemm g, const Sched& S, const Epi& E, int wv_) {
    int tid_ = wv_ * 64 + mk_lane(); asm volatile("" : "+v"(tid_)); const int tid = tid_, wid = __builtin_amdgcn_readfirstlane(tid >> 6), lane = tid & 63, wr = wid >> 2, wc = wid & 3, fr = lane & 15, fq = lane >> 4;
    const int K = g.K, nt = K / BK;
    unsigned voffA[2], voffB[2];
#pragma unroll
    for (int i = 0; i < 2; ++i) { int R, C; stage_rc(tid * 16 + i * 8192, R, C); const int Rb = Epi::PERM ? ((R & ~31) + perm32(R & 31)) : R;
        voffA[i] = (unsigned)(R * K + C) * 2u; voffB[i] = (unsigned)(Rb * K + C) * 2u; }
    const size_t kstep = (size_t)(BK * 2);
    const size_t hstep = (size_t)HALF * K * 2;
    const size_t tstep = 2 * hstep;
    const unsigned ldsw = (unsigned)wid * 1024u;
    const int aoff = lds_byte(wr * 64 + fr, fq * 8), boff = lds_byte(wc * 32 + fr, fq * 8);
#define PG8_SA(b, h) (((b) * 2 + (h)) * HTB)
#define PG8_SB(b, h) ((4 + (b) * 2 + (h)) * HTB)
#define PG8_STAGE(bufoff, gbase, voff) do { _Pragma("unroll") for (int _i = 0; _i < 2; ++_i) \
        __builtin_amdgcn_global_load_lds((const unsigned*)((const char*)(gbase) + (voff)[_i]), (PG8_LAS unsigned*)(lds + (bufoff) + ldsw + _i * 8192), 16, 0, 0); } while (0)
#define PG8_LDA(dst, b, h) do { _Pragma("unroll") for (int m = 0; m < 4; ++m) _Pragma("unroll") for (int k = 0; k < 2; ++k) dst[m][k] = *(const PG8_LAS bf16x8*)(lds + PG8_SA(b, h) + aoff + m * 2048 + k * 1024); } while (0)
#define PG8_LDB(dst, b, h) do { _Pragma("unroll") for (int n = 0; n < 2; ++n) _Pragma("unroll") for (int k = 0; k < 2; ++k) dst[n][k] = *(const PG8_LAS bf16x8*)(lds + PG8_SB(b, h) + boff + n * 2048 + k * 1024); } while (0)
#define PG8_MMA(ai, bj, At, Bt) do { __builtin_amdgcn_s_setprio(1); _Pragma("unroll") for (int m = 0; m < 4; ++m) _Pragma("unroll") for (int n = 0; n < 2; ++n) _Pragma("unroll") for (int k = 0; k < 2; ++k) \
        acc[ai][bj][m][n] = __builtin_amdgcn_mfma_f32_16x16x32_bf16(Bt[n][k], At[m][k], acc[ai][bj][m][n], 0, 0, 0); __builtin_amdgcn_s_setprio(0); } while (0)
#define PG8_WAIT_V(n) asm volatile("s_waitcnt vmcnt(" #n ")" ::: "memory")
#define PG8_WAIT_L(n) asm volatile("s_waitcnt lgkmcnt(" #n ")" ::: "memory")
#define PG8_BAR __builtin_amdgcn_s_barrier()
#define PG8_SCHED __builtin_amdgcn_sched_barrier(0)
    Unit cur, nxt; int ui = 0;
    if (!S.next(0, cur)) return;
    f32x4 acc[2][2][4][2];
#pragma unroll
    for (int a = 0; a < 2; ++a)
#pragma unroll
        for (int b = 0; b < 2; ++b)
#pragma unroll
            for (int m = 0; m < 4; ++m)
#pragma unroll
                for (int n = 0; n < 2; ++n) acc[a][b][m][n] = (f32x4){0.f, 0.f, 0.f, 0.f};
    bf16x8 At[4][2], B0[2][2], B1[2][2];
    const char* cA = (const char*)g.A + (size_t)cur.pm * tstep; const char* cB = (const char*)g.Bt + (size_t)cur.pn * tstep;
    S.a_ready(cur);
    if constexpr (SP2) {
        PG8_STAGE(PG8_SB(0, 0), cB, voffB); PG8_STAGE(PG8_SB(0, 1), cB + hstep, voffB); PG8_STAGE(PG8_SA(0, 0), cA, voffA); PG8_STAGE(PG8_SA(0, 1), cA + hstep, voffA);
        if (wr == 1) PG8_BAR;
        PG8_WAIT_V(2); PG8_BAR;
        PG8_STAGE(PG8_SB(1, 0), cB + kstep, voffB); PG8_STAGE(PG8_SA(1, 0), cA + kstep, voffA); PG8_STAGE(PG8_SB(1, 1), cB + hstep + kstep, voffB);
        PG8_WAIT_V(6); PG8_BAR;
    } else {
        PG8_STAGE(PG8_SB(0, 0), cB, voffB); PG8_STAGE(PG8_SA(0, 0), cA, voffA); PG8_STAGE(PG8_SB(0, 1), cB + hstep, voffB); PG8_STAGE(PG8_SA(0, 1), cA + hstep, voffA);
        if (wr == 1) PG8_BAR;
        PG8_WAIT_V(4); PG8_BAR;
        PG8_STAGE(PG8_SB(1, 0), cB + kstep, voffB); PG8_STAGE(PG8_SA(1, 0), cA + kstep, voffA); PG8_STAGE(PG8_SB(1, 1), cB + hstep + kstep, voffB);
        PG8_WAIT_V(6); PG8_BAR;
    }
    for (;;) {
        const bool has_next = S.next(ui + 1, nxt);
        const char* nA = has_next ? (const char*)g.A + (size_t)nxt.pm * tstep : cA; const char* nB = has_next ? (const char*)g.Bt + (size_t)nxt.pn * tstep : cB;
        for (int t = 0; t < nt; t += 2) {
            const bool last = (t == nt - 2);
            const char* a1 = cA + (size_t)(t + 1) * kstep;
            const char* a2 = last ? nA : cA + (size_t)(t + 2) * kstep; const char* b2 = last ? nB : cB + (size_t)(t + 2) * kstep;
            const char* a3 = a2 + kstep; const char* b3 = b2 + kstep;
            if (last && has_next) S.a_ready(nxt);
            if constexpr (SP2) {
            PG8_LDB(B0, 0, 0); PG8_LDB(B1, 0, 1); PG8_SCHED; PG8_LDA(At, 0, 0); PG8_STAGE(PG8_SA(1, 1), a1 + hstep, voffA);
            PG8_WAIT_V(8); PG8_WAIT_L(0); PG8_BAR; PG8_MMA(0, 0, At, B0); PG8_MMA(0, 1, At, B1); PG8_BAR; PG8_SCHED;
            PG8_LDA(At, 0, 1); PG8_STAGE(PG8_SB(0, 0), b2, voffB); PG8_STAGE(PG8_SB(0, 1), b2 + hstep, voffB); PG8_STAGE(PG8_SA(0, 0), a2, voffA);
            PG8_WAIT_V(8); PG8_WAIT_L(0); PG8_BAR; PG8_MMA(1, 0, At, B0); PG8_MMA(1, 1, At, B1); PG8_BAR; PG8_SCHED;
            PG8_LDB(B0, 1, 0); PG8_LDB(B1, 1, 1); PG8_SCHED; PG8_LDA(At, 1, 0); PG8_STAGE(PG8_SA(0, 1), a2 + hstep, voffA);
            PG8_WAIT_V(8); PG8_WAIT_L(0); PG8_BAR; PG8_MMA(0, 0, At, B0); PG8_MMA(0, 1, At, B1); PG8_BAR; PG8_SCHED;
            PG8_LDA(At, 1, 1); PG8_STAGE(PG8_SB(1, 0), b3, voffB); PG8_STAGE(PG8_SB(1, 1), b3 + hstep, voffB); PG8_STAGE(PG8_SA(1, 0), a3, voffA);
            PG8_WAIT_V(8); PG8_WAIT_L(0); PG8_BAR; PG8_MMA(1, 0, At, B0); PG8_MMA(1, 1, At, B1); PG8_BAR; PG8_SCHED;
            } else {
            PG8_LDB(B0, 0, 0); PG8_SCHED; PG8_LDA(At, 0, 0); PG8_STAGE(PG8_SA(1, 1), a1 + hstep, voffA);
            PG8_WAIT_L(8); PG8_BAR; PG8_WAIT_L(0); PG8_MMA(0, 0, At, B0); PG8_BAR; PG8_SCHED;
            PG8_LDB(B1, 0, 1); PG8_STAGE(PG8_SB(0, 0), b2, voffB);
            PG8_BAR; PG8_WAIT_L(0); PG8_MMA(0, 1, At, B1); PG8_BAR;
            PG8_LDA(At, 0, 1); PG8_STAGE(PG8_SA(0, 0), a2, voffA);
            PG8_BAR; PG8_WAIT_L(0); PG8_MMA(1, 0, At, B0); PG8_BAR; PG8_SCHED;
            PG8_STAGE(PG8_SB(0, 1), b2 + hstep, voffB);
            PG8_WAIT_V(6); PG8_BAR; PG8_MMA(1, 1, At, B1); PG8_BAR;
            PG8_LDB(B0, 1, 0); PG8_SCHED; PG8_LDA(At, 1, 0); PG8_STAGE(PG8_SA(0, 1), a2 + hstep, voffA);
            PG8_WAIT_L(8); PG8_BAR; PG8_WAIT_L(0); PG8_MMA(0, 0, At, B0); PG8_BAR; PG8_SCHED;
            PG8_LDB(B1, 1, 1); PG8_STAGE(PG8_SB(1, 0), b3, voffB);
            PG8_BAR; PG8_WAIT_L(0); PG8_MMA(0, 1, At, B1); PG8_BAR;
            PG8_LDA(At, 1, 1); PG8_STAGE(PG8_SA(1, 0), a3, voffA);
            PG8_BAR; PG8_WAIT_L(0); PG8_MMA(1, 0, At, B0); PG8_BAR; PG8_SCHED;
            PG8_STAGE(PG8_SB(1, 1), b3 + hstep, voffB);
            PG8_WAIT_V(6); PG8_BAR; PG8_MMA(1, 1, At, B1); PG8_BAR;
            }
        }
        if constexpr (ALIGN_EPI) { if (wr == 0) PG8_BAR; }
        if constexpr (!Epi::AFTER_DRAIN) { E(acc, cur, wr, wc, fr, fq); S.done(cur); }
        if (!has_next) break;
#pragma unroll
        for (int a = 0; a < 2; ++a)
#pragma unroll
            for (int b = 0; b < 2; ++b)
#pragma unroll
                for (int m = 0; m < 4; ++m)
#pragma unroll
                    for (int n = 0; n < 2; ++n) acc[a][b][m][n] = (f32x4){0.f, 0.f, 0.f, 0.f};
        cur = nxt; cA = nA; cB = nB; ++ui;
        if constexpr (ALIGN_EPI) { if (wr == 1) PG8_BAR; }
    }
    PG8_WAIT_V(0);
    if constexpr (!ALIGN_EPI) { if (wr == 0) PG8_BAR; }
    PG8_BAR;
    if constexpr (Epi::AFTER_DRAIN) { E.fused(acc, cur, wr, wc, fr, fq, lds, wid, lane); S.done(cur); }
#undef PG8_SA
#undef PG8_SB
#undef PG8_STAGE
#undef PG8_LDA
#undef PG8_LDB
#undef PG8_MMA
#undef PG8_WAIT_V
#undef PG8_WAIT_L
#undef PG8_BAR
#undef PG8_SCHED
}
}
constexpr int BATCH = 2, SEQ = 8192, DM = 1024, DEPTH = 4, M = BATCH * SEQ;
constexpr int NIN = 9224, NP = 9216, NPAD = 9472, BW = 512;
constexpr int C_GQ = 0, C_GK = 512, C_GV = 1024, C_GZ = 1536, C_DQ = 2048, C_DK = 2560, C_DV = 3072, C_DZ = 3584,
              C_SB = 4096, C_SC = 4608, C_SX = 5120, C_SZ = 5632, C_MG = 6144;
constexpr float EPS = 1e-6f;
constexpr int NWAVES = 8, NTHR = 512;
constexpr int LDS_BYTES = 147456;
constexpr size_t MiB = 1u << 20;
constexpr size_t WS_CTL = 0;
constexpr size_t WS_WIN = 2 * MiB;
constexpr size_t WIN_L = (size_t)NPAD * DM;
constexpr size_t WS_WBR = 76 * MiB;
constexpr size_t WS_WOUT = 88 * MiB;
constexpr size_t WS_PROJ = 96 * MiB;
constexpr size_t WS_BA = 384 * MiB;
constexpr size_t WS_REGB = 386 * MiB;
constexpr size_t WS_REGC = 418 * MiB;
constexpr size_t WS_REGD = 482 * MiB;
constexpr size_t WS_GL = 554 * MiB;
constexpr size_t WS_END = 555 * MiB;
constexpr int NUNIT = BATCH * 4 * 128;
constexpr size_t GD_U = 0, GD_W = (size_t)NUNIT * 8192, GD_QD = 2 * GD_W, GD_KD = 3 * GD_W, GD_QK = 4 * GD_W;

typedef unsigned short bf16;
typedef unsigned v4u __attribute__((ext_vector_type(4)));
typedef unsigned v2u __attribute__((ext_vector_type(2)));
typedef float f32x4 __attribute__((ext_vector_type(4)));
#define LAS __attribute__((address_space(3)))

__device__ __forceinline__ unsigned f2bf(float f) { unsigned u = __builtin_bit_cast(unsigned, f); return (u + 0x7fffu + ((u >> 16) & 1u)) >> 16; }
__device__ __forceinline__ unsigned pk2(float lo, float hi) { return f2bf(lo) | (f2bf(hi) << 16); }
__device__ __forceinline__ float bf2f(unsigned short b) { return __builtin_bit_cast(float, (unsigned)b << 16); }
__device__ __forceinline__ float bflo(unsigned w) { return __builtin_bit_cast(float, w << 16); }
__device__ __forceinline__ float bfhi(unsigned w) { return __builtin_bit_cast(float, w & 0xffff0000u); }
__device__ __forceinline__ void ld8(const bf16* p, float* f) { const v4u w = *(const v4u*)p; f[0] = bflo(w.x); f[1] = bfhi(w.x); f[2] = bflo(w.y); f[3] = bfhi(w.y); f[4] = bflo(w.z); f[5] = bfhi(w.z); f[6] = bflo(w.w); f[7] = bfhi(w.w); }
__device__ __forceinline__ void st8(bf16* p, const float* f) { v4u w; w.x = pk2(f[0], f[1]); w.y = pk2(f[2], f[3]); w.z = pk2(f[4], f[5]); w.w = pk2(f[6], f[7]); *(v4u*)p = w; }
__device__ __forceinline__ float wave_sum(float v) {
#pragma unroll
    for (int o = 1; o < 64; o <<= 1) v += __shfl_xor(v, o);
    return v;
}
__device__ __forceinline__ float sigmoidf_(float x) { return 1.f / (1.f + __expf(-x)); }
__device__ __forceinline__ float siluf_(float x) { return x / (1.f + __expf(-x)); }
__device__ __forceinline__ int srccol(int p) { return p < 2048 ? p : (p < 9216 ? p + 8 : (p < 9224 ? 2048 + (p - 9216) : -1)); }

struct Args {
    const float* x; const float* norm_pre; const float* norm_post; const float* w_in; const float* gdn_conv_w; const float* gdn_a_log; const float* gdn_dt_bias;
    const float* gdn_norm_w; const float* diff_lambda; const float* diff_norm_w; const float* sc_conv_w; const float* w_branch; const float* w_out;
    float* out; unsigned char* ws; int ph_lo, ph_hi, coop, pad;
};

struct EpiProj {
    static constexpr bool PERM = true, AFTER_DRAIN = false;
    bf16* P; float* BA;
    __device__ __forceinline__ void operator()(const pg8::f32x4 (&acc)[2][2][4][2], const pg8::Unit& u, int wr, int wc, int fr, int fq) const {
        const int row0 = u.pm * 256 + wr * 64 + fr;
        if (u.pn == 36) {
            if (wc == 0 && fq == 0) {
#pragma unroll
                for (int ai = 0; ai < 2; ++ai)
#pragma unroll
                    for (int m = 0; m < 4; ++m) { float* o = BA + (size_t)(row0 + ai * 128 + m * 16) * 8; *(pg8::f32x4*)o = acc[ai][0][m][0]; *(pg8::f32x4*)(o + 4) = acc[ai][0][m][1]; }
            }
            return;
        }
        const int colt = u.pn * 256; const float sc = (colt >= C_DQ && colt < C_DK) ? 0.18033688011112042f : 1.f;
        const int col0 = colt + wc * 32 + 8 * fq;
#pragma unroll
        for (int ai = 0; ai < 2; ++ai)
#pragma unroll
            for (int m = 0; m < 4; ++m) { bf16* rowp = P + (size_t)(row0 + ai * 128 + m * 16) * NP + col0;
#pragma unroll
                for (int bj = 0; bj < 2; ++bj) { const pg8::f32x4 v0 = acc[ai][bj][m][0] * sc, v1 = acc[ai][bj][m][1] * sc; v4u w;
                    w.x = pg8::cvt_pk_bf16(v0[0], v0[1]); w.y = pg8::cvt_pk_bf16(v0[2], v0[3]); w.z = pg8::cvt_pk_bf16(v1[0], v1[1]); w.w = pg8::cvt_pk_bf16(v1[2], v1[3]);
                    *(v4u*)(rowp + bj * 128) = w; } }
    }
};
template <int KB> struct EpiBranch {
    static constexpr bool PERM = true, AFTER_DRAIN = false;
    const bf16* P; float* MG; bf16* MB;
    __device__ __forceinline__ void operator()(const pg8::f32x4 (&acc)[2][2][4][2], const pg8::Unit& u, int wr, int wc, int fr, int fq) const {
        const int row0 = u.pm * 256 + wr * 64 + fr; const int col0 = u.pn * 256 + wc * 32 + 8 * fq;
#pragma unroll
        for (int ai = 0; ai < 2; ++ai)
#pragma unroll
            for (int m = 0; m < 4; ++m) { const size_t row = (size_t)(row0 + ai * 128 + m * 16);
#pragma unroll
                for (int bj = 0; bj < 2; ++bj) { const int col = col0 + bj * 128; float lg[8]; ld8(P + row * NP + C_MG + KB * 1024 + col, lg);
                    float v[8];
#pragma unroll
                    for (int j = 0; j < 4; ++j) { v[j] = acc[ai][bj][m][0][j] * sigmoidf_(lg[j]); v[4 + j] = acc[ai][bj][m][1][j] * sigmoidf_(lg[4 + j]); }
                    float* mp = MG + row * DM + col;
                    if (KB > 0) { const pg8::f32x4 a = *(const pg8::f32x4*)mp, b = *(const pg8::f32x4*)(mp + 4);
#pragma unroll
                        for (int j = 0; j < 4; ++j) { v[j] += a[j]; v[4 + j] += b[j]; } }
                    if (KB < 2) { *(pg8::f32x4*)mp = (pg8::f32x4){v[0], v[1], v[2], v[3]}; *(pg8::f32x4*)(mp + 4) = (pg8::f32x4){v[4], v[5], v[6], v[7]}; }
                    else st8(MB + row * DM + col, v); } }
    }
};
struct EpiOutF32 {
    static constexpr bool PERM = true, AFTER_DRAIN = false;
    float* O;
    __device__ __forceinline__ void operator()(const pg8::f32x4 (&acc)[2][2][4][2], const pg8::Unit& u, int wr, int wc, int fr, int fq) const {
        const int row0 = u.pm * 256 + wr * 64 + fr; const int col0 = u.pn * 256 + wc * 32 + 8 * fq;
#pragma unroll
        for (int ai = 0; ai < 2; ++ai)
#pragma unroll
            for (int m = 0; m < 4; ++m) { float* rowp = O + (size_t)(row0 + ai * 128 + m * 16) * DM + col0;
#pragma unroll
                for (int bj = 0; bj < 2; ++bj) { *(pg8::f32x4*)(rowp + bj * 128) = acc[ai][bj][m][0]; *(pg8::f32x4*)(rowp + bj * 128 + 4) = acc[ai][bj][m][1]; } }
    }
};

__device__ __forceinline__ void tr_item(const float* W, int ldw, int K, bf16* WT, int k0, int p0, int mode, float* scr, int lane) {
    const int n = lane & 31; const int p = p0 + n; const int sc = mode ? srccol(p) : p;
#pragma unroll 8
    for (int i = 0; i < 32; ++i) { const int kk = 2 * i + (lane >> 5); scr[kk * 33 + n] = sc >= 0 ? W[(size_t)(k0 + kk) * ldw + sc] : 0.f; }
    asm volatile("s_waitcnt lgkmcnt(0)" ::: "memory");
    const int c = lane & 7;
#pragma unroll
    for (int j = 0; j < 4; ++j) { const int nn = (lane >> 3) + 8 * j; const float* s = scr + (8 * c) * 33 + nn;
        v4u o; o.x = pk2(s[0 * 33], s[1 * 33]); o.y = pk2(s[2 * 33], s[3 * 33]); o.z = pk2(s[4 * 33], s[5 * 33]); o.w = pk2(s[6 * 33], s[7 * 33]);
        *(v4u*)(WT + (size_t)(p0 + nn) * K + k0 + 8 * c) = o; }
    asm volatile("s_waitcnt lgkmcnt(0)" ::: "memory");
}
__device__ __forceinline__ void norm_row_to_h(const float* xrow, const float* wpre, bf16* hrow, int lane) {
    f32x4 v[4]; float s = 0.f;
#pragma unroll
    for (int j = 0; j < 4; ++j) { v[j] = *(const f32x4*)(xrow + 4 * lane + 256 * j); s += (v[j].x * v[j].x + v[j].y * v[j].y) + (v[j].z * v[j].z + v[j].w * v[j].w); }
    const float rs = rsqrtf(wave_sum(s) * (1.f / DM) + EPS);
#pragma unroll
    for (int j = 0; j < 4; ++j) { const f32x4 w = *(const f32x4*)(wpre + 4 * lane + 256 * j); v2u o; o.x = pk2(v[j].x * rs * w.x, v[j].y * rs * w.y); o.y = pk2(v[j].z * rs * w.z, v[j].w * rs * w.w);
        *(v2u*)(hrow + 4 * lane + 256 * j) = o; }
}
__device__ __forceinline__ void phase_prologue(const Args& a, unsigned char* lds, int wv_) {
    int tid_ = wv_ * 64 + mk_lane(); asm volatile("" : "+v"(tid_)); const int tid = tid_, lane = tid & 63, wave = tid >> 6;
    float* scr = (float*)(lds + wave * 16384);
    const int gw = blockIdx.x * NWAVES + wave, NGW = gridDim.x * NWAVES;
    constexpr int I_IN = (DM / 64) * (NPAD / 32), I_BR = (BW / 64) * (DM / 32), I_OUT = (DM / 64) * (DM / 32);
    constexpr int NITEMS = DEPTH * I_IN + DEPTH * 3 * I_BR + DEPTH * I_OUT;
    bf16* win = (bf16*)(a.ws + WS_WIN); bf16* wbr = (bf16*)(a.ws + WS_WBR); bf16* wout = (bf16*)(a.ws + WS_WOUT);
    for (int it = gw; it < NITEMS; it += NGW) {
        int r = it;
        if (r < DEPTH * I_IN) { const int l = r / I_IN; r %= I_IN; const int nb = NPAD / 32, kb = r / nb, pb = r % nb;
            tr_item(a.w_in + (size_t)l * DM * NIN, NIN, DM, win + (size_t)l * WIN_L, kb * 64, pb * 32, 1, scr, lane); continue; }
        r -= DEPTH * I_IN;
        if (r < DEPTH * 3 * I_BR) { const int lk = r / I_BR; r %= I_BR; const int nb = DM / 32, kb = r / nb, pb = r % nb;
            tr_item(a.w_branch + (size_t)lk * BW * DM, DM, BW, wbr + (size_t)lk * DM * BW, kb * 64, pb * 32, 0, scr, lane); continue; }
        r -= DEPTH * 3 * I_BR;
        { const int l = r / I_OUT; r %= I_OUT; const int nb = DM / 32, kb = r / nb, pb = r % nb;
            tr_item(a.w_out + (size_t)l * DM * DM, DM, DM, wout + (size_t)l * DM * DM, kb * 64, pb * 32, 0, scr, lane); }
    }
    bf16* H = (bf16*)(a.ws + WS_REGB);
    for (int m = gw; m < M; m += NGW) norm_row_to_h(a.x + (size_t)m * DM, a.norm_pre, H + (size_t)m * DM, lane);
}

typedef short bf16x8 __attribute__((ext_vector_type(8)));
typedef float f32x16 __attribute__((ext_vector_type(16)));
typedef float f32x2_t __attribute__((ext_vector_type(2))); typedef __bf16 bf16x2_t __attribute__((ext_vector_type(2)));
__device__ __forceinline__ unsigned cvtpk(float lo, float hi) { f32x2_t v = {lo, hi}; bf16x2_t bb = __builtin_convertvector(v, bf16x2_t); return __builtin_bit_cast(unsigned, bb); }
__device__ __forceinline__ int crow(int r, int hi) { return (r & 3) + 8 * (r >> 2) + 4 * hi; }
#define MFMA32(a, b, c) __builtin_amdgcn_mfma_f32_32x32x16_bf16((a), (b), (c), 0, 0, 0)
constexpr int AT_KS = 0, AT_VT = 64 * 144, AT_FS = AT_VT + 128 * 144;
__device__ __forceinline__ void phase_attn(const Args& a, unsigned char* lds, int l, int wv_) {
    const bf16* P = (const bf16*)(a.ws + WS_PROJ); float* OATT = (float*)(a.ws + WS_REGC);
    int tid_ = wv_ * 64 + mk_lane(); asm volatile("" : "+v"(tid_)); const int tid = tid_, lane = tid & 63, r32 = lane & 31, hi = lane >> 5, wave = tid >> 6;
    float* fs = (float*)(lds + AT_FS) + wave * 32;
#pragma unroll 1
    for (int it = blockIdx.x; it < 256; it += gridDim.x) {
        const int stream = it >> 4, pp = it & 15;
        const int bb = stream >> 3, h = (stream >> 1) & 3, mp = stream & 1;
        const float slope2 = exp2f(-2.f * (float)(h + 1)) * 1.4426950408889634f;
        const bf16* Kg = P + (size_t)bb * SEQ * NP + C_DK + h * 128 + mp * 64 + (size_t)(tid >> 3) * NP + (tid & 7) * 8;
        const bf16* Vg = P + (size_t)bb * SEQ * NP + C_DV + h * 128 + (size_t)lane * NP + wave * 8;
#pragma unroll 1
        for (int uu = 0; uu < 2; ++uu) {
            const int qb = uu == 0 ? pp : 31 - pp;
            const int q0 = qb * 256 + wave * 32, t = q0 + r32;
            bf16x8 qr[4];
            { const bf16* qp = P + ((size_t)bb * SEQ + t) * NP + C_DQ + h * 128 + mp * 64 + hi * 8;
#pragma unroll
              for (int d0 = 0; d0 < 4; ++d0) qr[d0] = *(const bf16x8*)(qp + d0 * 16); }
            float cb[16];
#pragma unroll
            for (int r = 0; r < 16; ++r) cb[r] = slope2 * (float)crow(r, hi);
            f32x16 o[4];
#pragma unroll
            for (int db = 0; db < 4; ++db)
#pragma unroll
                for (int r = 0; r < 16; ++r) o[db][r] = 0.f;
            float m_ref = -1e30f, lsum = 0.f;
            const int ntile = 4 * qb + 4;
            v4u kreg, vreg0, vreg1;
            { const size_t jo = (size_t)(ntile - 1) * 64 * NP; kreg = *(const v4u*)(Kg + jo); vreg0 = *(const v4u*)(Vg + jo); vreg1 = *(const v4u*)(Vg + jo + 64); }
#pragma unroll 1
            for (int tt = ntile - 1; tt >= 0; --tt) {
                __syncthreads();
                *(v4u*)(lds + AT_KS + (tid >> 3) * 144 + (tid & 7) * 16) = kreg;
                { unsigned short* vt = (unsigned short*)(lds + AT_VT) + lane;
                  const unsigned w0[4] = {vreg0.x, vreg0.y, vreg0.z, vreg0.w}, w1[4] = {vreg1.x, vreg1.y, vreg1.z, vreg1.w};
#pragma unroll
                  for (int x = 0; x < 4; ++x) { vt[(wave * 8 + 2 * x) * 72] = (unsigned short)(w0[x] & 0xffffu); vt[(wave * 8 + 2 * x + 1) * 72] = (unsigned short)(w0[x] >> 16);
                      vt[(64 + wave * 8 + 2 * x) * 72] = (unsigned short)(w1[x] & 0xffffu); vt[(64 + wave * 8 + 2 * x + 1) * 72] = (unsigned short)(w1[x] >> 16); } }
                __syncthreads();
                if (tt > 0) { const size_t jo = (size_t)(tt - 1) * 64 * NP; kreg = *(const v4u*)(Kg + jo); vreg0 = *(const v4u*)(Vg + jo); vreg1 = *(const v4u*)(Vg + jo + 64); }
                const int j0 = tt * 64;
                if (j0 <= q0 + 31) {
                    const float base = slope2 * (float)(j0 - t), base1 = base + 32.f * slope2;
                    f32x16 p0, p1;
#pragma unroll
                    for (int r = 0; r < 16; ++r) { p0[r] = cb[r] + base; p1[r] = cb[r] + base1; }
                    { const unsigned char* kb = lds + AT_KS + r32 * 144 + hi * 16;
#pragma unroll
                      for (int d0 = 0; d0 < 4; ++d0) { const bf16x8 a0 = *(const bf16x8*)(kb + d0 * 32), a1 = *(const bf16x8*)(kb + 32 * 144 + d0 * 32);
                          p0 = MFMA32(a0, qr[d0], p0); p1 = MFMA32(a1, qr[d0], p1); } }
                    if (j0 + 63 > q0) {
#pragma unroll
                        for (int r = 0; r < 16; ++r) { const int kv = j0 + crow(r, hi); if (kv > t) p0[r] = -1e30f; if (kv + 32 > t) p1[r] = -1e30f; }
                    }
                    float mx = fmaxf(p0[0], p1[0]);
#pragma unroll
                    for (int r = 1; r < 16; ++r) mx = fmaxf(mx, fmaxf(p0[r], p1[r]));
                    mx = fmaxf(mx, __shfl_xor(mx, 32));
                    if (__any(mx > m_ref + 8.f)) {
                        const float m_new = fmaxf(m_ref, mx), f = __builtin_amdgcn_exp2f(m_ref - m_new); m_ref = m_new; lsum *= f;
                        if (hi == 0) fs[r32] = f;
                        __builtin_amdgcn_wave_barrier();
#pragma unroll
                        for (int g = 0; g < 4; ++g) { const f32x4 ff = *(const f32x4*)(fs + 8 * g + 4 * hi);
#pragma unroll
                            for (int db = 0; db < 4; ++db) { o[db][4 * g] *= ff.x; o[db][4 * g + 1] *= ff.y; o[db][4 * g + 2] *= ff.z; o[db][4 * g + 3] *= ff.w; } }
                        __builtin_amdgcn_wave_barrier();
                    }
                    float sacc = 0.f;
#pragma unroll
                    for (int r = 0; r < 16; ++r) { p0[r] = __builtin_amdgcn_exp2f(p0[r] - m_ref); p1[r] = __builtin_amdgcn_exp2f(p1[r] - m_ref); sacc += p0[r] + p1[r]; }
                    lsum += sacc;
                    bf16x8 pk[4];
#pragma unroll
                    for (int s = 0; s < 2; ++s) { v4u w0, w1;
                        w0.x = cvtpk(p0[8 * s], p0[8 * s + 1]); w0.y = cvtpk(p0[8 * s + 2], p0[8 * s + 3]); w0.z = cvtpk(p0[8 * s + 4], p0[8 * s + 5]); w0.w = cvtpk(p0[8 * s + 6], p0[8 * s + 7]);
                        w1.x = cvtpk(p1[8 * s], p1[8 * s + 1]); w1.y = cvtpk(p1[8 * s + 2], p1[8 * s + 3]); w1.z = cvtpk(p1[8 * s + 4], p1[8 * s + 5]); w1.w = cvtpk(p1[8 * s + 6], p1[8 * s + 7]);
                        pk[s] = __builtin_bit_cast(bf16x8, w0); pk[2 + s] = __builtin_bit_cast(bf16x8, w1); }
                    const unsigned char* vb = lds + AT_VT + r32 * 144 + hi * 8;
#pragma unroll
                    for (int s = 0; s < 4; ++s)
#pragma unroll
                        for (int db = 0; db < 4; ++db) { const v2u lo = *(const v2u*)(vb + db * 32 * 144 + s * 32), hi8 = *(const v2u*)(vb + db * 32 * 144 + s * 32 + 16);
                            v4u w; w.x = lo.x; w.y = lo.y; w.z = hi8.x; w.w = hi8.y;
                            o[db] = MFMA32(pk[s], __builtin_bit_cast(bf16x8, w), o[db]); }
                }
            }
            lsum += __shfl_xor(lsum, 32);
            __builtin_amdgcn_wave_barrier();
            if (hi == 0) fs[r32] = 1.f / lsum;
            __builtin_amdgcn_wave_barrier();
#pragma unroll
            for (int g = 0; g < 4; ++g) { const f32x4 ff = *(const f32x4*)(fs + 8 * g + 4 * hi); const float fv[4] = {ff.x, ff.y, ff.z, ff.w};
#pragma unroll
                for (int x = 0; x < 4; ++x) { const size_t row = (size_t)bb * SEQ + q0 + 8 * g + 4 * hi + x; float* dst = OATT + ((row * 4 + h) * 2 + mp) * 128 + r32;
#pragma unroll
                    for (int db = 0; db < 4; ++db) dst[db * 32] = o[db][4 * g + x] * fv[x]; } }
            __builtin_amdgcn_wave_barrier();
        }
    }
    __syncthreads();
}

__device__ __forceinline__ int afrag_off(int row, int k, int nks) { const int rt = row >> 5, r = row & 31, ks = k >> 4, kk = k & 15, h = (kk >> 2) & 1, j = ((kk >> 3) << 2) | (kk & 3); return ((rt * nks + ks) * 64 + r + 32 * h) * 8 + j; }
__device__ __forceinline__ int clay_off(int c, int dv) { const int rt = c >> 5, cc = c & 31, hi = (cc >> 2) & 1, i = ((cc >> 3) << 2) | (cc & 3), sl = dv >> 5, r32 = dv & 31; return ((rt * 4 + sl) * 64 + r32 + 32 * hi) * 16 + i; }
__device__ __forceinline__ void phase_gdn_local_v1(const Args& a, unsigned char* lds, int l, int wv_) {
    const bf16* P = (const bf16*)(a.ws + WS_PROJ); const float* BA = (const float*)(a.ws + WS_BA);
    bf16* GD = (bf16*)(a.ws + WS_REGD); float* GL = (float*)(a.ws + WS_GL);
    float* qs = (float*)lds; float* ks = qs + 64 * 129; float* vs = ks + 64 * 129; float* KKs = vs + 64 * 129; float* QKs = KKs + 64 * 65;
    float* beta = QKs + 64 * 65; float* gc = beta + 64;
    int tid_ = wv_ * 64 + mk_lane(); asm volatile("" : "+v"(tid_)); const int tid = tid_, lane = tid & 63, wave = tid >> 6;
    const float* cw = a.gdn_conv_w + (size_t)l * 4 * 1536;
    for (int unit = blockIdx.x; unit < NUNIT; unit += gridDim.x) {
        const int bb = unit >> 9, h = (unit >> 7) & 3, n = unit & 127;
        __syncthreads();
#pragma unroll 1
        for (int idx = tid; idx < 3 * 64 * 128; idx += NTHR) {
            const int mat = idx >> 13, rem = idx & 8191, t = rem >> 7, c = rem & 127, col = mat * 512 + h * 128 + c;
            float acc = 0.f;
#pragma unroll
            for (int j = 0; j < 4; ++j) { const int tt = n * 64 + t - 3 + j; if (tt >= 0) acc += cw[j * 1536 + col] * bf2f(P[((size_t)bb * SEQ + tt) * NP + col]); }
            (mat == 0 ? qs : mat == 1 ? ks : vs)[t * 129 + c] = siluf_(acc);
        }
        if (tid < 64) {
            const size_t row = (size_t)bb * SEQ + n * 64 + tid;
            beta[tid] = sigmoidf_(BA[row * 8 + h]);
            const float xx = BA[row * 8 + 4 + h] + a.gdn_dt_bias[l * 4 + h];
            const float sp = xx > 20.f ? xx : log1pf(__expf(xx));
            gc[tid] = -__expf(a.gdn_a_log[l * 4 + h]) * sp;
        }
        __syncthreads();
        if (tid == 0) { float run = 0.f;
#pragma unroll 1
            for (int c = 0; c < 64; ++c) { run += gc[c]; gc[c] = run; } }
        __syncthreads();
#pragma unroll 1
        for (int r = wave * 8; r < wave * 8 + 8; ++r) {
            { float x0 = qs[r * 129 + lane], x1 = qs[r * 129 + 64 + lane]; const float sc = rsqrtf(wave_sum(x0 * x0 + x1 * x1) + 1e-6f) * 0.08838834764831845f; qs[r * 129 + lane] = x0 * sc; qs[r * 129 + 64 + lane] = x1 * sc; }
            { float x0 = ks[r * 129 + lane], x1 = ks[r * 129 + 64 + lane]; const float sc = rsqrtf(wave_sum(x0 * x0 + x1 * x1) + 1e-6f); ks[r * 129 + lane] = x0 * sc; ks[r * 129 + 64 + lane] = x1 * sc; }
        }
        __syncthreads();
#pragma unroll 1
        for (int i = 0; i < 8; ++i) { const int idx = tid + NTHR * i, c = idx >> 6, s = idx & 63; float kk = 0.f, qk = 0.f;
#pragma unroll 4
            for (int d = 0; d < 128; ++d) { const float kv = ks[s * 129 + d]; kk += ks[c * 129 + d] * kv; qk += qs[c * 129 + d] * kv; }
            const float dec = (s <= c) ? __expf(gc[c] - gc[s]) : 0.f;
            KKs[c * 65 + s] = (s < c) ? kk * beta[c] * dec : 0.f; QKs[c * 65 + s] = qk * dec; }
        __syncthreads();
        const size_t ub = (size_t)unit * 8192;
        { const float gl = gc[63];
          for (int idx = tid; idx < 8192; idx += NTHR) { const int c = idx >> 7, d = idx & 127;
              GD[GD_QD + ub + afrag_off(c, d, 8)] = (bf16)f2bf(qs[c * 129 + d] * __expf(gc[c])); GD[GD_KD + ub + afrag_off(d, c, 4)] = (bf16)f2bf(ks[c * 129 + d] * __expf(gl - gc[c])); }
          for (int idx = tid; idx < 4096; idx += NTHR) { const int c = idx >> 6, s = idx & 63; GD[GD_QK + (size_t)unit * 4096 + afrag_off(c, s, 4)] = (bf16)f2bf(QKs[c * 65 + s]); }
          if (tid == 0) GL[unit] = __expf(gl); }
        __syncthreads();
        for (int idx = tid; idx < 8192; idx += NTHR) { const int c = idx >> 7, d = idx & 127; vs[c * 129 + d] *= beta[c]; ks[c * 129 + d] *= beta[c] * __expf(gc[c]); }
        __syncthreads();
        if (tid < 256) {
            float* X = (tid < 128 ? vs : ks) + (tid & 127);
#pragma unroll 1
            for (int c = 1; c < 64; ++c) { float acc = X[c * 129]; const float* Ar = KKs + c * 65;
#pragma unroll 4
                for (int s = 0; s < c; ++s) acc -= Ar[s] * X[s * 129];
                X[c * 129] = acc; }
            if (tid < 128) { for (int c = 0; c < 64; ++c) GD[GD_U + ub + clay_off(c, tid)] = (bf16)f2bf(X[c * 129]); }
            else { for (int c = 0; c < 64; ++c) GD[GD_W + ub + afrag_off(c, tid - 128, 8)] = (bf16)f2bf(-X[c * 129]); }
        }
    }
    __syncthreads();
}

constexpr int SC_WN = 0, SC_QD = 16384, SC_KDT = 32768, SC_QK = 49152, SC_U = 57344, SC_GL = 61440, SC_BUF = 61504;
__device__ __forceinline__ bf16x8 pack8(const f32x16& x, int s) { v4u w; w.x = cvtpk(x[8 * s], x[8 * s + 1]); w.y = cvtpk(x[8 * s + 2], x[8 * s + 3]); w.z = cvtpk(x[8 * s + 4], x[8 * s + 5]); w.w = cvtpk(x[8 * s + 6], x[8 * s + 7]); return __builtin_bit_cast(bf16x8, w); }
__device__ __forceinline__ void phase_gdn_scan(const Args& a, unsigned char* lds, int l, int wv_) {
    const bf16* GD = (const bf16*)(a.ws + WS_REGD); const float* GL = (const float*)(a.ws + WS_GL); float* OG = (float*)(a.ws + WS_REGB);
    int tid_ = wv_ * 64 + mk_lane(); asm volatile("" : "+v"(tid_)); const int tid = tid_, lane = tid & 63, r32 = lane & 31, hi = lane >> 5, wave = tid >> 6;
#pragma unroll 1
    for (int job = blockIdx.x; job < 32; job += gridDim.x) {
        const int bh = job >> 2, sl = job & 3, bb = bh >> 2, h = bh & 3;
        f32x16 S[4];
#pragma unroll
        for (int b4 = 0; b4 < 4; ++b4)
#pragma unroll
            for (int r = 0; r < 16; ++r) S[b4][r] = 0.f;
        __syncthreads();
#pragma unroll 1
        for (int n = -1; n < 128; ++n) {
            if (wave != 0 && n + 1 < 128) {
                const int unit = bh * 128 + n + 1; const size_t ub = (size_t)unit * 8192; unsigned char* dstb = lds + ((n + 1) & 1) * SC_BUF;
#pragma unroll 1
                for (int cidx = tid - 64; cidx < 3840; cidx += 448) {
                    const bf16* srcp;
                    if (cidx < 1024) srcp = GD + GD_W + ub + cidx * 8;
                    else if (cidx < 2048) srcp = GD + GD_QD + ub + (cidx - 1024) * 8;
                    else if (cidx < 3072) srcp = GD + GD_KD + ub + (cidx - 2048) * 8;
                    else if (cidx < 3584) srcp = GD + GD_QK + (size_t)unit * 4096 + (cidx - 3072) * 8;
                    else { const int uc = cidx - 3584, rt = uc >> 7, rem = uc & 127; srcp = GD + GD_U + ub + ((rt * 4 + sl) * 64) * 16 + rem * 8; }
                    *(v4u*)(dstb + cidx * 16) = *(const v4u*)srcp;
                }
                if (tid == 64) *(float*)(dstb + SC_GL) = GL[unit];
            }
            if (wave == 0 && n >= 0) {
                const unsigned char* base = lds + (n & 1) * SC_BUF;
#define SFRAG(off, f) (*(const bf16x8*)(base + (off) + (f) * 1024 + lane * 16))
                bf16x8 Spk[8];
#pragma unroll
                for (int ks = 0; ks < 8; ++ks) Spk[ks] = pack8(S[ks >> 1], ks & 1);
                f32x16 Vn[2];
#pragma unroll
                for (int rt = 0; rt < 2; ++rt) { const v4u u0 = *(const v4u*)(base + SC_U + (rt * 64 + lane) * 32), u1 = *(const v4u*)(base + SC_U + (rt * 64 + lane) * 32 + 16);
                    const unsigned uw[8] = {u0.x, u0.y, u0.z, u0.w, u1.x, u1.y, u1.z, u1.w};
#pragma unroll
                    for (int x = 0; x < 8; ++x) { Vn[rt][2 * x] = bflo(uw[x]); Vn[rt][2 * x + 1] = bfhi(uw[x]); }
#pragma unroll
                    for (int ks = 0; ks < 8; ++ks) Vn[rt] = MFMA32(SFRAG(SC_WN, rt * 8 + ks), Spk[ks], Vn[rt]); }
                bf16x8 Vpk[4];
#pragma unroll
                for (int ks = 0; ks < 4; ++ks) Vpk[ks] = pack8(Vn[ks >> 1], ks & 1);
#pragma unroll
                for (int rt = 0; rt < 2; ++rt) { f32x16 O;
#pragma unroll
                    for (int r = 0; r < 16; ++r) O[r] = 0.f;
#pragma unroll
                    for (int ks = 0; ks < 8; ++ks) O = MFMA32(SFRAG(SC_QD, rt * 8 + ks), Spk[ks], O);
#pragma unroll
                    for (int ks = 0; ks < 4; ++ks) O = MFMA32(SFRAG(SC_QK, rt * 4 + ks), Vpk[ks], O);
                    float* op = OG + ((size_t)bb * SEQ + n * 64 + rt * 32) * BW + h * 128 + sl * 32 + r32;
#pragma unroll
                    for (int i = 0; i < 16; ++i) op[(size_t)crow(i, hi) * BW] = O[i]; }
                const float g = *(const float*)(base + SC_GL);
#pragma unroll
                for (int b4 = 0; b4 < 4; ++b4) {
#pragma unroll
                    for (int r = 0; r < 16; ++r) S[b4][r] *= g;
#pragma unroll
                    for (int ks = 0; ks < 4; ++ks) S[b4] = MFMA32(SFRAG(SC_KDT, b4 * 4 + ks), Vpk[ks], S[b4]); }
#undef SFRAG
            }
            __syncthreads();
        }
    }
    __syncthreads();
}

__device__ __forceinline__ void phase_finalize(const Args& a, int l, int wv_) {
    const bf16* P = (const bf16*)(a.ws + WS_PROJ); const float* OG = (const float*)(a.ws + WS_REGB); const float* OATT = (const float*)(a.ws + WS_REGC);
    bf16* Y = (bf16*)(a.ws + WS_REGD);
    int tid_ = wv_ * 64 + mk_lane(); asm volatile("" : "+v"(tid_)); const int tid = tid_, lane = tid & 63, wave = tid >> 6;
    const int gw = blockIdx.x * NWAVES + wave, NGW = gridDim.x * NWAVES;
    const float lam_init = 0.8f - 0.6f * expf(-0.3f * (float)l);
    const float* lv = a.diff_lambda + (size_t)l * 256;
    const float lam = expf(wave_sum(lv[lane] * lv[64 + lane])) - expf(wave_sum(lv[128 + lane] * lv[192 + lane])) + lam_init;
    const int e0 = (lane & 15) * 8, hh = lane >> 4, c0 = lane * 8;
    float gnw[8], dnw[8], scw[3][8];
#pragma unroll
    for (int j = 0; j < 8; ++j) { gnw[j] = a.gdn_norm_w[l * 128 + e0 + j]; dnw[j] = a.diff_norm_w[l * 128 + e0 + j] * (1.f - lam_init);
#pragma unroll
        for (int k = 0; k < 3; ++k) scw[k][j] = a.sc_conv_w[((size_t)l * 3 + k) * BW + c0 + j]; }
    for (int row = gw; row < M; row += NGW) {
        const int t = row & (SEQ - 1);
        const bf16* pr = P + (size_t)row * NP;
        float y[8], z[8];
        { const f32x4 o0 = *(const f32x4*)(OG + (size_t)row * BW + c0), o1 = *(const f32x4*)(OG + (size_t)row * BW + c0 + 4);
          float o[8] = {o0.x, o0.y, o0.z, o0.w, o1.x, o1.y, o1.z, o1.w}; float ss = 0.f;
#pragma unroll
          for (int j = 0; j < 8; ++j) ss += o[j] * o[j];
          ss += __shfl_xor(ss, 1); ss += __shfl_xor(ss, 2); ss += __shfl_xor(ss, 4); ss += __shfl_xor(ss, 8);
          const float rs = rsqrtf(ss * (1.f / 128.f) + EPS); ld8(pr + C_GZ + c0, z);
#pragma unroll
          for (int j = 0; j < 8; ++j) y[j] = o[j] * rs * gnw[j] * siluf_(z[j]);
          st8(Y + (size_t)row * BW + c0, y); }
        { const float* op = OATT + (((size_t)row * 4 + hh) * 2) * 128 + e0;
          const f32x4 a0 = *(const f32x4*)op, a1 = *(const f32x4*)(op + 4), b0 = *(const f32x4*)(op + 128), b1 = *(const f32x4*)(op + 132);
          float d[8] = {a0.x - lam * b0.x, a0.y - lam * b0.y, a0.z - lam * b0.z, a0.w - lam * b0.w, a1.x - lam * b1.x, a1.y - lam * b1.y, a1.z - lam * b1.z, a1.w - lam * b1.w}; float ss = 0.f;
#pragma unroll
          for (int j = 0; j < 8; ++j) ss += d[j] * d[j];
          ss += __shfl_xor(ss, 1); ss += __shfl_xor(ss, 2); ss += __shfl_xor(ss, 4); ss += __shfl_xor(ss, 8);
          const float rs = rsqrtf(ss * (1.f / 128.f) + EPS); ld8(pr + C_DZ + c0, z);
#pragma unroll
          for (int j = 0; j < 8; ++j) y[j] = d[j] * rs * dnw[j] * siluf_(z[j]);
          st8(Y + (size_t)M * BW + (size_t)row * BW + c0, y); }
        { float acc[8];
#pragma unroll
          for (int j = 0; j < 8; ++j) acc[j] = 0.f;
#pragma unroll
          for (int k = 0; k < 3; ++k) { const int tt = t - 2 + k; if (tt >= 0) { float cc[8], xx[8]; const bf16* p2 = P + (size_t)(row - 2 + k) * NP; ld8(p2 + C_SC + c0, cc); ld8(p2 + C_SX + c0, xx);
#pragma unroll
              for (int j = 0; j < 8; ++j) acc[j] += scw[k][j] * (cc[j] * xx[j]); } }
          float sb[8]; ld8(pr + C_SB + c0, sb); ld8(pr + C_SZ + c0, z);
#pragma unroll
          for (int j = 0; j < 8; ++j) y[j] = sb[j] * acc[j] * siluf_(z[j]);
          st8(Y + 2 * (size_t)M * BW + (size_t)row * BW + c0, y); }
    }
}

__device__ __forceinline__ void phase_postnorm(const Args& a, int l, int wv_) {
    const float* OUT = (const float*)(a.ws + WS_REGC); bf16* H = (bf16*)(a.ws + WS_REGB);
    const float* xin = (l == 0) ? a.x : a.out;
    int tid_ = wv_ * 64 + mk_lane(); asm volatile("" : "+v"(tid_)); const int tid = tid_, lane = tid & 63, wave = tid >> 6;
    const int gw = blockIdx.x * NWAVES + wave, NGW = gridDim.x * NWAVES;
    const float* wpost = a.norm_post + (size_t)l * DM; const float* wpre = a.norm_pre + (size_t)(l + 1 < DEPTH ? l + 1 : l) * DM;
    for (int row = gw; row < M; row += NGW) {
        f32x4 o[4], x[4]; float s = 0.f;
#pragma unroll
        for (int j = 0; j < 4; ++j) { o[j] = *(const f32x4*)(OUT + (size_t)row * DM + 4 * lane + 256 * j); x[j] = *(const f32x4*)(xin + (size_t)row * DM + 4 * lane + 256 * j);
            s += (o[j].x * o[j].x + o[j].y * o[j].y) + (o[j].z * o[j].z + o[j].w * o[j].w); }
        const float rs = rsqrtf(wave_sum(s) * (1.f / DM) + EPS); float s2 = 0.f;
#pragma unroll
        for (int j = 0; j < 4; ++j) { const f32x4 w = *(const f32x4*)(wpost + 4 * lane + 256 * j); x[j] = x[j] + o[j] * rs * w; *(f32x4*)(a.out + (size_t)row * DM + 4 * lane + 256 * j) = x[j];
            s2 += (x[j].x * x[j].x + x[j].y * x[j].y) + (x[j].z * x[j].z + x[j].w * x[j].w); }
        if (l + 1 < DEPTH) { const float rs2 = rsqrtf(wave_sum(s2) * (1.f / DM) + EPS);
#pragma unroll
            for (int j = 0; j < 4; ++j) { const f32x4 w = *(const f32x4*)(wpre + 4 * lane + 256 * j); v2u ob; ob.x = pk2(x[j].x * rs2 * w.x, x[j].y * rs2 * w.y); ob.y = pk2(x[j].z * rs2 * w.z, x[j].w * rs2 * w.w);
                *(v2u*)(H + (size_t)row * DM + 4 * lane + 256 * j) = ob; } }
    }
}

constexpr int ARGS_OFF = 143360;
constexpr int ARGS_WORDS = (int)(sizeof(Args) / 4);
__device__ __forceinline__ void load_args(Args& b, unsigned char* lds) {
    volatile LAS unsigned* s = (volatile LAS unsigned*)((LAS unsigned char*)lds + ARGS_OFF); unsigned w[ARGS_WORDS];
#pragma unroll
    for (int i = 0; i < ARGS_WORDS; ++i) w[i] = (unsigned)__builtin_amdgcn_readfirstlane((int)s[i]);
    __builtin_memcpy(&b, w, sizeof(Args));
}
template <int L> __device__ __forceinline__ void run_layer(unsigned char* lds, cg::grid_group& grid, int wv) {
    PG8_LAS unsigned char* lds3 = (PG8_LAS unsigned char*)lds;
    constexpr int l = L;
    {
        Args a; load_args(a, lds); const int G = gridDim.x;
        bf16* WIN = (bf16*)(a.ws + WS_WIN); bf16* PROJ = (bf16*)(a.ws + WS_PROJ); float* BA = (float*)(a.ws + WS_BA); bf16* REGB = (bf16*)(a.ws + WS_REGB);
        pg8::Gemm g{REGB, WIN + (size_t)l * WIN_L, M, NPAD, DM}; pg8::StaticOrder S; S.init(M, NPAD, G, (int)blockIdx.x);
        EpiProj E{PROJ, BA};
        pg8::gemm_phase<EpiProj, pg8::StaticOrder, true, true>(lds3, g, S, E, wv);
    }
    grid.sync();
    { Args a; load_args(a, lds); phase_gdn_local_v1(a, lds, l, wv); }
    { Args a; load_args(a, lds); phase_attn(a, lds, l, wv); }
    grid.sync();
    { Args a; load_args(a, lds); phase_gdn_scan(a, lds, l, wv); }
    grid.sync();
    { Args a; load_args(a, lds); phase_finalize(a, l, wv); }
    grid.sync();
    {
        Args a; load_args(a, lds); const int G = gridDim.x;
        bf16* WBR = (bf16*)(a.ws + WS_WBR); bf16* PROJ = (bf16*)(a.ws + WS_PROJ); bf16* REGB = (bf16*)(a.ws + WS_REGB); float* REGC = (float*)(a.ws + WS_REGC); bf16* Y = (bf16*)(a.ws + WS_REGD);
        pg8::StaticOrder S; S.init(M, DM, G, (int)blockIdx.x);
        { pg8::Gemm g{Y, WBR + ((size_t)l * 3 + 0) * DM * BW, M, DM, BW}; EpiBranch<0> E{PROJ, REGC, REGB}; pg8::gemm_phase<EpiBranch<0>, pg8::StaticOrder, true, true>(lds3, g, S, E, wv); }
        { pg8::Gemm g{Y + (size_t)M * BW, WBR + ((size_t)l * 3 + 1) * DM * BW, M, DM, BW}; EpiBranch<1> E{PROJ, REGC, REGB}; pg8::gemm_phase<EpiBranch<1>, pg8::StaticOrder, true, true>(lds3, g, S, E, wv); }
        { pg8::Gemm g{Y + 2 * (size_t)M * BW, WBR + ((size_t)l * 3 + 2) * DM * BW, M, DM, BW}; EpiBranch<2> E{PROJ, REGC, REGB}; pg8::gemm_phase<EpiBranch<2>, pg8::StaticOrder, true, true>(lds3, g, S, E, wv); }
    }
    grid.sync();
    {
        Args a; load_args(a, lds); const int G = gridDim.x;
        bf16* WOUT = (bf16*)(a.ws + WS_WOUT); bf16* REGB = (bf16*)(a.ws + WS_REGB); float* REGC = (float*)(a.ws + WS_REGC);
        pg8::Gemm g{REGB, WOUT + (size_t)l * DM * DM, M, DM, DM}; pg8::StaticOrder S; S.init(M, DM, G, (int)blockIdx.x);
        EpiOutF32 E{REGC};
        pg8::gemm_phase<EpiOutF32, pg8::StaticOrder, true, true>(lds3, g, S, E, wv);
    }
    grid.sync();
    { Args a; load_args(a, lds); phase_postnorm(a, l, wv); }
    if (L + 1 < DEPTH) grid.sync();
}
__global__ void __launch_bounds__(NTHR, 2) fwd(Args a0) {
    extern __shared__ __attribute__((aligned(16))) unsigned char lds[];
    cg::grid_group grid = cg::this_grid();
    const int wv = __builtin_amdgcn_readfirstlane((int)threadIdx.x >> 6);
    if (threadIdx.x == 0) { unsigned w[ARGS_WORDS]; __builtin_memcpy(w, &a0, sizeof(Args));
#pragma unroll
        for (int i = 0; i < ARGS_WORDS; ++i) ((volatile LAS unsigned*)((LAS unsigned char*)lds + ARGS_OFF))[i] = w[i]; }
    __syncthreads();
    { Args a; load_args(a, lds); phase_prologue(a, lds, wv); }
    grid.sync();
    run_layer<0>(lds, grid, wv);
    run_layer<1>(lds, grid, wv);
    run_layer<2>(lds, grid, wv);
    run_layer<3>(lds, grid, wv);
}

extern "C" void kernel_launch(void* const* d_in, const int* in_sizes, int n_in, void* d_out, int out_size, void* d_ws, size_t ws_size, hipStream_t stream) {
    static int grid = 0;
    if (grid == 0) {
        if (n_in != 13 || ws_size < WS_END) { fprintf(stderr, "kernel_launch: unexpected n_in %d or ws %zu\n", n_in, ws_size); grid = -1; return; }
        int dev = 0, cus = 0, per_cu = 0;
        hipGetDevice(&dev); hipDeviceGetAttribute(&cus, hipDeviceAttributeMultiprocessorCount, dev);
        hipFuncSetAttribute((const void*)fwd, hipFuncAttributeMaxDynamicSharedMemorySize, LDS_BYTES);
        hipOccupancyMaxActiveBlocksPerMultiprocessor(&per_cu, (const void*)fwd, NTHR, LDS_BYTES);
        (void)hipGetLastError();
        if (per_cu < 1) { fprintf(stderr, "kernel_launch: occupancy query says %d\n", per_cu); per_cu = 1; }
        grid = cus;
    }
    if (grid < 0) return;
    Args a{};
    a.x = (const float*)d_in[0]; a.norm_pre = (const float*)d_in[1]; a.norm_post = (const float*)d_in[2]; a.w_in = (const float*)d_in[3]; a.gdn_conv_w = (const float*)d_in[4];
    a.gdn_a_log = (const float*)d_in[5]; a.gdn_dt_bias = (const float*)d_in[6]; a.gdn_norm_w = (const float*)d_in[7]; a.diff_lambda = (const float*)d_in[8]; a.diff_norm_w = (const float*)d_in[9];
    a.sc_conv_w = (const float*)d_in[10]; a.w_branch = (const float*)d_in[11]; a.w_out = (const float*)d_in[12];
    a.out = (float*)d_out; a.ws = (unsigned char*)d_ws; a.ph_lo = 0; a.ph_hi = 0; a.coop = 1; a.pad = 0;
    void* args[] = {&a};
    hipError_t e = hipLaunchCooperativeKernel((const void*)fwd, dim3(grid), dim3(NTHR), args, LDS_BYTES, stream);
    if (e != hipSuccess) fprintf(stderr, "cooperative launch failed: %s (grid %d)\n", hipGetErrorString(e), grid);
}
```

```cpp
#include <hip/hip_runtime.h>
#include <hip/hip_cooperative_groups.h>
#include <cstdio>
#include <cstdint>
namespace cg = cooperative_groups;
__device__ __forceinline__ int mk_lane() { int r; asm volatile("v_mbcnt_lo_u32_b32 %0, -1, 0\n\tv_mbcnt_hi_u32_b32 %0, -1, %0" : "=v"(r)); return r; }
namespace pg8 {
#define PG8_LAS __attribute__((address_space(3)))
typedef unsigned short bf16_t;
typedef short bf16x8 __attribute__((ext_vector_type(8)));
typedef float f32x4 __attribute__((ext_vector_type(4)));
typedef unsigned u32x4 __attribute__((ext_vector_type(4)));
constexpr int BM = 256, BK = 64, HALF = 128, HTB = HALF * BK * 2  , STAGE_BYTES = 8 * HTB, NXCD = 8, WGM = 8;

__host__ __device__ __forceinline__ int lds_byte(int r, int c) { const int st = (r >> 4) * 2 + (c >> 5), rr = r & 15, cc = c & 31, ob = rr * 64 + cc * 2; return st * 1024 + (ob ^ (((ob >> 9) & 1) << 5)); }
__host__ __device__ __forceinline__ void stage_rc(int b, int& R, int& C) { const int st = b / 1024, sb = b % 1024, swz = sb ^ (((sb >> 9) & 1) << 5); R = (st >> 1) * 16 + swz / 64; C = (st & 1) * 32 + (swz % 64) / 2; }
__host__ __device__ __forceinline__ int perm32(int rho) { const int n = rho >> 4, i = rho & 15; return 8 * (i >> 2) + 4 * n + (i & 3); }

struct Unit { int pm, pn; };
struct Gemm { const bf16_t* A; const bf16_t* Bt; int M, N, K; };

struct StaticOrder {
    int nM, nN, nwg, G, c;
    __host__ __device__ void init(int M, int N, int G_, int c_) { nM = M / BM; nN = N / BM; nwg = nM * nN; G = G_; c = c_; }
    __host__ __device__ bool next(int i, Unit& u) const {
        const long L = (long)i * G + c; if (L >= nwg) return false;
        int wgid = (int)L; { const int q = nwg / NXCD, r = nwg % NXCD, xcd = wgid % NXCD, off = wgid / NXCD; wgid = (xcd < r ? xcd * (q + 1) : r * (q + 1) + (xcd - r) * q) + off; }
        const int nig = WGM * nN, gid = wgid / nig, fm = gid * WGM, gsz = (nM - fm) < WGM ? (nM - fm) : WGM;
        u.pm = fm + ((wgid % nig) % gsz); u.pn = (wgid % nig) / gsz; return true;
    }
    __device__ __forceinline__ void a_ready(const Unit&) const {}
    __device__ __forceinline__ void done(const Unit&) const {}
};
__device__ __forceinline__ unsigned cvt_pk_bf16(float lo, float hi) { unsigned r; asm volatile("v_cvt_pk_bf16_f32 %0, %1, %2" : "=v"(r) : "v"(lo), "v"(hi)); return r; }
typedef float f32x2 __attribute__((ext_vector_type(2)));
template <class Epi, class Sched, bool ALIGN_EPI = false, bool SP2 = false>
__device__ __forceinline__ void gemm_phase(PG8_LAS unsigned char* lds, const Gemm g, const Sched& S, const Epi& E, int wv_) {
    int tid_ = wv_ * 64 + mk_lane(); asm volatile("" : "+v"(tid_)); const int tid = tid_, wid = __builtin_amdgcn_readfirstlane(tid >> 6), lane = tid & 63, wr = wid >> 2, wc = wid & 3, fr = lane & 15, fq = lane >> 4;
    const int K = g.K, nt = K / BK;
    unsigned voffA[2], voffB[2];
#pragma unroll
    for (int i = 0; i < 2; ++i) { int R, C; stage_rc(tid * 16 + i * 8192, R, C); const int Rb = Epi::PERM ? ((R & ~31) + perm32(R & 31)) : R;
        voffA[i] = (unsigned)(R * K + C) * 2u; voffB[i] = (unsigned)(Rb * K + C) * 2u; }
    const size_t kstep = (size_t)(BK * 2);
    const size_t hstep = (size_t)HALF * K * 2;
    const size_t tstep = 2 * hstep;
    const unsigned ldsw = (unsigned)wid * 1024u;
    const int aoff = lds_byte(wr * 64 + fr, fq * 8), boff = lds_byte(wc * 32 + fr, fq * 8);
#define PG8_SA(b, h) (((b) * 2 + (h)) * HTB)
#define PG8_SB(b, h) ((4 + (b) * 2 + (h)) * HTB)
#define PG8_STAGE(bufoff, gbase, voff) do { _Pragma("unroll") for (int _i = 0; _i < 2; ++_i) \
        __builtin_amdgcn_global_load_lds((const unsigned*)((const char*)(gbase) + (voff)[_i]), (PG8_LAS unsigned*)(lds + (bufoff) + ldsw + _i * 8192), 16, 0, 0); } while (0)
#define PG8_LDA(dst, b, h) do { _Pragma("unroll") for (int m = 0; m < 4; ++m) _Pragma("unroll") for (int k = 0; k < 2; ++k) dst[m][k] = *(const PG8_LAS bf16x8*)(lds + PG8_SA(b, h) + aoff + m * 2048 + k * 1024); } while (0)
#define PG8_LDB(dst, b, h) do { _Pragma("unroll") for (int n = 0; n < 2; ++n) _Pragma("unroll") for (int k = 0; k < 2; ++k) dst[n][k] = *(const PG8_LAS bf16x8*)(lds + PG8_SB(b, h) + boff + n * 2048 + k * 1024); } while (0)
#define PG8_MMA(ai, bj, At, Bt) do { __builtin_amdgcn_s_setprio(1); _Pragma("unroll") for (int m = 0; m < 4; ++m) _Pragma("unroll") for (int n = 0; n < 2; ++n) _Pragma("unroll") for (int k = 0; k < 2; ++k) \
        acc[ai][bj][m][n] = __builtin_amdgcn_mfma_f32_16x16x32_bf16(Bt[n][k], At[m][k], acc[ai][bj][m][n], 0, 0, 0); __builtin_amdgcn_s_setprio(0); } while (0)
#define PG8_WAIT_V(n) asm volatile("s_waitcnt vmcnt(" #n ")" ::: "memory")
#define PG8_WAIT_L(n) asm volatile("s_waitcnt lgkmcnt(" #n ")" ::: "memory")
#define PG8_BAR __builtin_amdgcn_s_barrier()
#define PG8_SCHED __builtin_amdgcn_sched_barrier(0)
    Unit cur, nxt; int ui = 0;
    if (!S.next(0, cur)) return;
    f32x4 acc[2][2][4][2];
#pragma unroll
    for (int a = 0; a < 2; ++a)
#pragma unroll
        for (int b = 0; b < 2; ++b)
#pragma unroll
            for (int m = 0; m < 4; ++m)
#pragma unroll
                for (int n = 0; n < 2; ++n) acc[a][b][m][n] = (f32x4){0.f, 0.f, 0.f, 0.f};
    bf16x8 At[4][2], B0[2][2], B1[2][2];
    const char* cA = (const char*)g.A + (size_t)cur.pm * tstep; const char* cB = (const char*)g.Bt + (size_t)cur.pn * tstep;
    S.a_ready(cur);
    if constexpr (SP2) {
        PG8_STAGE(PG8_SB(0, 0), cB, voffB); PG8_STAGE(PG8_SB(0, 1), cB + hstep, voffB); PG8_STAGE(PG8_SA(0, 0), cA, voffA); PG8_STAGE(PG8_SA(0, 1), cA + hstep, voffA);
        if (wr == 1) PG8_BAR;
        PG8_WAIT_V(2); PG8_BAR;
        PG8_STAGE(PG8_SB(1, 0), cB + kstep, voffB); PG8_STAGE(PG8_SA(1, 0), cA + kstep, voffA); PG8_STAGE(PG8_SB(1, 1), cB + hstep + kstep, voffB);
        PG8_WAIT_V(6); PG8_BAR;
    } else {
        PG8_STAGE(PG8_SB(0, 0), cB, voffB); PG8_STAGE(PG8_SA(0, 0), cA, voffA); PG8_STAGE(PG8_SB(0, 1), cB + hstep, voffB); PG8_STAGE(PG8_SA(0, 1), cA + hstep, voffA);
        if (wr == 1) PG8_BAR;
        PG8_WAIT_V(4); PG8_BAR;
        PG8_STAGE(PG8_SB(1, 0), cB + kstep, voffB); PG8_STAGE(PG8_SA(1, 0), cA + kstep, voffA); PG8_STAGE(PG8_SB(1, 1), cB + hstep + kstep, voffB);
        PG8_WAIT_V(6); PG8_BAR;
    }
    for (;;) {
        const bool has_next = S.next(ui + 1, nxt);
        const char* nA = has_next ? (const char*)g.A + (size_t)nxt.pm * tstep : cA; const char* nB = has_next ? (const char*)g.Bt + (size_t)nxt.pn * tstep : cB;
        for (int t = 0; t < nt; t += 2) {
            const bool last = (t == nt - 2);
            const char* a1 = cA + (size_t)(t + 1) * kstep;
            const char* a2 = last ? nA : cA + (size_t)(t + 2) * kstep; const char* b2 = last ? nB : cB + (size_t)(t + 2) * kstep;
            const char* a3 = a2 + kstep; const char* b3 = b2 + kstep;
            if (last && has_next) S.a_ready(nxt);
            if constexpr (SP2) {
            PG8_LDB(B0, 0, 0); PG8_LDB(B1, 0, 1); PG8_SCHED; PG8_LDA(At, 0, 0); PG8_STAGE(PG8_SA(1, 1), a1 + hstep, voffA);
            PG8_WAIT_V(8); PG8_WAIT_L(0); PG8_BAR; PG8_MMA(0, 0, At, B0); PG8_MMA(0, 1, At, B1); PG8_BAR; PG8_SCHED;
            PG8_LDA(At, 0, 1); PG8_STAGE(PG8_SB(0, 0), b2, voffB); PG8_STAGE(PG8_SB(0, 1), b2 + hstep, voffB); PG8_STAGE(PG8_SA(0, 0), a2, voffA);
            PG8_WAIT_V(8); PG8_WAIT_L(0); PG8_BAR; PG8_MMA(1, 0, At, B0); PG8_MMA(1, 1, At, B1); PG8_BAR; PG8_SCHED;
            PG8_LDB(B0, 1, 0); PG8_LDB(B1, 1, 1); PG8_SCHED; PG8_LDA(At, 1, 0); PG8_STAGE(PG8_SA(0, 1), a2 + hstep, voffA);
            PG8_WAIT_V(8); PG8_WAIT_L(0); PG8_BAR; PG8_MMA(0, 0, At, B0); PG8_MMA(0, 1, At, B1); PG8_BAR; PG8_SCHED;
            PG8_LDA(At, 1, 1); PG8_STAGE(PG8_SB(1, 0), b3, voffB); PG8_STAGE(PG8_SB(1, 1), b3 + hstep, voffB); PG8_STAGE(PG8_SA(1, 0), a3, voffA);
            PG8_WAIT_V(8); PG8_WAIT_L(0); PG8_BAR; PG8_MMA(1, 0, At, B0); PG8_MMA(1, 1, At, B1); PG8_BAR; PG8_SCHED;
            } else {
            PG8_LDB(B0, 0, 0); PG8_SCHED; PG8_LDA(At, 0, 0); PG8_STAGE(PG8_SA(1, 1), a1 + hstep, voffA);
            PG8_WAIT_L(8); PG8_BAR; PG8_WAIT_L(0); PG8_MMA(0, 0, At, B0); PG8_BAR; PG8_SCHED;
            PG8_LDB(B1, 0, 1); PG8_STAGE(PG8_SB(0, 0), b2, voffB);
            PG8_BAR; PG8_WAIT_L(0); PG8_MMA(0, 1, At, B1); PG8_BAR;
            PG8_LDA(At, 0, 1); PG8_STAGE(PG8_SA(0, 0), a2, voffA);
            PG8_BAR; PG8_WAIT_L(0); PG8_MMA(1, 0, At, B0); PG8_BAR; PG8_SCHED;
            PG8_STAGE(PG8_SB(0, 1), b2 + hstep, voffB);
            PG8_WAIT_V(6); PG8_BAR; PG8_MMA(1, 1, At, B1); PG8_BAR;
            PG8_LDB(B0, 1, 0); PG8_SCHED; PG8_LDA(At, 1, 0); PG8_STAGE(PG8_SA(0, 1), a2 + hstep, voffA);
            PG8_WAIT_L(8); PG8_BAR; PG8_WAIT_L(0); PG8_MMA(0, 0, At, B0); PG8_BAR; PG8_SCHED;
            PG8_LDB(B1, 1, 1); PG8_STAGE(PG8_SB(1, 0), b3, voffB);
            PG8_BAR; PG8_WAIT_L(0); PG8_MMA(0, 1, At, B1); PG8_BAR;
            PG8_LDA(At, 1, 1); PG8_STAGE(PG8_SA(1, 0), a3, voffA);
            PG8_BAR; PG8_WAIT_L(0); PG8_MMA(1, 0, At, B0); PG8_BAR; PG8_SCHED;
            PG8_STAGE(PG8_SB(1, 1), b3 + hstep, voffB);
            PG8_WAIT_V(6); PG8_BAR; PG8_MMA(1, 1, At, B1); PG8_BAR;
            }
        }
        if constexpr (ALIGN_EPI) { if (wr == 0) PG8_BAR; }
        if constexpr (!Epi::AFTER_DRAIN) { E(acc, cur, wr, wc, fr, fq); S.done(cur); }
        if (!has_next) break;
#pragma unroll
        for (int a = 0; a < 2; ++a)
#pragma unroll
            for (int b = 0; b < 2; ++b)
#pragma unroll
                for (int m = 0; m < 4; ++m)
#pragma unroll
                    for (int n = 0; n < 2; ++n) acc[a][b][m][n] = (f32x4){0.f, 0.f, 0.f, 0.f};
        cur = nxt; cA = nA; cB = nB; ++ui;
        if constexpr (ALIGN_EPI) { if (wr == 1) PG8_BAR; }
    }
    PG8_WAIT_V(0);
    if constexpr (!ALIGN_EPI) { if (wr == 0) PG8_BAR; }
    PG8_BAR;
    if constexpr (Epi::AFTER_DRAIN) { E.fused(acc, cur, wr, wc, fr, fq, lds, wid, lane); S.done(cur); }
#undef PG8_SA
#undef PG8_SB
#undef PG8_STAGE
#undef PG8_LDA
#undef PG8_LDB
#undef PG8_MMA
#undef PG8_WAIT_V
#undef PG8_WAIT_L
#undef PG8_BAR
#undef PG8_SCHED
}
}
constexpr int BATCH = 2, SEQ = 8192, DM = 1024, DEPTH = 4, M = BATCH * SEQ;
constexpr int NIN = 9224, NP = 9216, NPAD = 9472, BW = 512;
constexpr int C_GQ = 0, C_GK = 512, C_GV = 1024, C_GZ = 1536, C_DQ = 2048, C_DK = 2560, C_DV = 3072, C_DZ = 3584,
              C_SB = 4096, C_SC = 4608, C_SX = 5120, C_SZ = 5632, C_MG = 6144;
constexpr float EPS = 1e-6f;
constexpr int NWAVES = 8, NTHR = 512;
constexpr int LDS_BYTES = 147456;
constexpr size_t MiB = 1u << 20;
constexpr size_t WS_CTL = 0;
constexpr size_t WS_WIN = 2 * MiB;
constexpr size_t WIN_L = (size_t)NPAD * DM;
constexpr size_t WS_WBR = 76 * MiB;
constexpr size_t WS_WOUT = 88 * MiB;
constexpr size_t WS_PROJ = 96 * MiB;
constexpr size_t WS_BA = 384 * MiB;
constexpr size_t WS_REGB = 386 * MiB;
constexpr size_t WS_REGC = 418 * MiB;
constexpr size_t WS_REGD = 482 * MiB;
constexpr size_t WS_GL = 554 * MiB;
constexpr size_t WS_END = 555 * MiB;
constexpr int NUNIT = BATCH * 4 * 128;
constexpr size_t UREC = 36864, R_W = 0, R_QD = 8192, R_KD = 16384, R_QK = 24576, R_U = 28672;

typedef unsigned short bf16;
typedef unsigned v4u __attribute__((ext_vector_type(4)));
typedef unsigned v2u __attribute__((ext_vector_type(2)));
typedef float f32x4 __attribute__((ext_vector_type(4)));
#define LAS __attribute__((address_space(3)))

__device__ __forceinline__ unsigned f2bf(float f) { unsigned u = __builtin_bit_cast(unsigned, f); return (u + 0x7fffu + ((u >> 16) & 1u)) >> 16; }
__device__ __forceinline__ unsigned pk2(float lo, float hi) { return f2bf(lo) | (f2bf(hi) << 16); }
__device__ __forceinline__ float bf2f(unsigned short b) { return __builtin_bit_cast(float, (unsigned)b << 16); }
__device__ __forceinline__ float bflo(unsigned w) { return __builtin_bit_cast(float, w << 16); }
__device__ __forceinline__ float bfhi(unsigned w) { return __builtin_bit_cast(float, w & 0xffff0000u); }
__device__ __forceinline__ void ld8(const bf16* p, float* f) { const v4u w = *(const v4u*)p; f[0] = bflo(w.x); f[1] = bfhi(w.x); f[2] = bflo(w.y); f[3] = bfhi(w.y); f[4] = bflo(w.z); f[5] = bfhi(w.z); f[6] = bflo(w.w); f[7] = bfhi(w.w); }
__device__ __forceinline__ void st8(bf16* p, const float* f) { v4u w; w.x = pk2(f[0], f[1]); w.y = pk2(f[2], f[3]); w.z = pk2(f[4], f[5]); w.w = pk2(f[6], f[7]); *(v4u*)p = w; }
__device__ __forceinline__ float wave_sum(float v) {
#pragma unroll
    for (int o = 1; o < 64; o <<= 1) v += __shfl_xor(v, o);
    return v;
}
__device__ __forceinline__ float sigmoidf_(float x) { return 1.f / (1.f + __expf(-x)); }
__device__ __forceinline__ float siluf_(float x) { return x / (1.f + __expf(-x)); }
__device__ __forceinline__ int srccol(int p) { return p < 2048 ? p : (p < 9216 ? p + 8 : (p < 9224 ? 2048 + (p - 9216) : -1)); }

struct Args {
    const float* x; const float* norm_pre; const float* norm_post; const float* w_in; const float* gdn_conv_w; const float* gdn_a_log; const float* gdn_dt_bias;
    const float* gdn_norm_w; const float* diff_lambda; const float* diff_norm_w; const float* sc_conv_w; const float* w_branch; const float* w_out;
    float* out; unsigned char* ws; int ph_lo, ph_hi, coop, pad;
};

struct EpiProj {
    static constexpr bool PERM = true, AFTER_DRAIN = false;
    bf16* P; float* BA;
    __device__ __forceinline__ void operator()(const pg8::f32x4 (&acc)[2][2][4][2], const pg8::Unit& u, int wr, int wc, int fr, int fq) const {
        const int row0 = u.pm * 256 + wr * 64 + fr;
        if (u.pn == 36) {
            if (wc == 0 && fq == 0) {
#pragma unroll
                for (int ai = 0; ai < 2; ++ai)
#pragma unroll
                    for (int m = 0; m < 4; ++m) { float* o = BA + (size_t)(row0 + ai * 128 + m * 16) * 8; *(pg8::f32x4*)o = acc[ai][0][m][0]; *(pg8::f32x4*)(o + 4) = acc[ai][0][m][1]; }
            }
            return;
        }
        const int colt = u.pn * 256; const float sc = (colt >= C_DQ && colt < C_DK) ? 0.18033688011112042f : 1.f;
        const int col0 = colt + wc * 32 + 8 * fq;
#pragma unroll
        for (int ai = 0; ai < 2; ++ai)
#pragma unroll
            for (int m = 0; m < 4; ++m) { bf16* rowp = P + (size_t)(row0 + ai * 128 + m * 16) * NP + col0;
#pragma unroll
                for (int bj = 0; bj < 2; ++bj) { const pg8::f32x4 v0 = acc[ai][bj][m][0] * sc, v1 = acc[ai][bj][m][1] * sc; v4u w;
                    w.x = pg8::cvt_pk_bf16(v0[0], v0[1]); w.y = pg8::cvt_pk_bf16(v0[2], v0[3]); w.z = pg8::cvt_pk_bf16(v1[0], v1[1]); w.w = pg8::cvt_pk_bf16(v1[2], v1[3]);
                    *(v4u*)(rowp + bj * 128) = w; } }
    }
};
template <int KB> struct EpiBranch {
    static constexpr bool PERM = true, AFTER_DRAIN = false;
    const bf16* P; float* MG; bf16* MB;
    __device__ __forceinline__ void operator()(const pg8::f32x4 (&acc)[2][2][4][2], const pg8::Unit& u, int wr, int wc, int fr, int fq) const {
        const int row0 = u.pm * 256 + wr * 64 + fr; const int col0 = u.pn * 256 + wc * 32 + 8 * fq;
#pragma unroll
        for (int ai = 0; ai < 2; ++ai)
#pragma unroll
            for (int m = 0; m < 4; ++m) { const size_t row = (size_t)(row0 + ai * 128 + m * 16);
#pragma unroll
                for (int bj = 0; bj < 2; ++bj) { const int col = col0 + bj * 128; float lg[8]; ld8(P + row * NP + C_MG + KB * 1024 + col, lg);
                    float v[8];
#pragma unroll
                    for (int j = 0; j < 4; ++j) { v[j] = acc[ai][bj][m][0][j] * sigmoidf_(lg[j]); v[4 + j] = acc[ai][bj][m][1][j] * sigmoidf_(lg[4 + j]); }
                    float* mp = MG + row * DM + col;
                    if (KB > 0) { const pg8::f32x4 a = *(const pg8::f32x4*)mp, b = *(const pg8::f32x4*)(mp + 4);
#pragma unroll
                        for (int j = 0; j < 4; ++j) { v[j] += a[j]; v[4 + j] += b[j]; } }
                    if (KB < 2) { *(pg8::f32x4*)mp = (pg8::f32x4){v[0], v[1], v[2], v[3]}; *(pg8::f32x4*)(mp + 4) = (pg8::f32x4){v[4], v[5], v[6], v[7]}; }
                    else st8(MB + row * DM + col, v); } }
    }
};
struct EpiOutF32 {
    static constexpr bool PERM = true, AFTER_DRAIN = false;
    float* O;
    __device__ __forceinline__ void operator()(const pg8::f32x4 (&acc)[2][2][4][2], const pg8::Unit& u, int wr, int wc, int fr, int fq) const {
        const int row0 = u.pm * 256 + wr * 64 + fr; const int col0 = u.pn * 256 + wc * 32 + 8 * fq;
#pragma unroll
        for (int ai = 0; ai < 2; ++ai)
#pragma unroll
            for (int m = 0; m < 4; ++m) { float* rowp = O + (size_t)(row0 + ai * 128 + m * 16) * DM + col0;
#pragma unroll
                for (int bj = 0; bj < 2; ++bj) { *(pg8::f32x4*)(rowp + bj * 128) = acc[ai][bj][m][0]; *(pg8::f32x4*)(rowp + bj * 128 + 4) = acc[ai][bj][m][1]; } }
    }
};

__device__ __forceinline__ void tr_item(const float* W, int ldw, int K, bf16* WT, int k0, int p0, int mode, float* scr, int lane) {
    const int n = lane & 31; const int p = p0 + n; const int sc = mode ? srccol(p) : p;
#pragma unroll 8
    for (int i = 0; i < 32; ++i) { const int kk = 2 * i + (lane >> 5); scr[kk * 33 + n] = sc >= 0 ? W[(size_t)(k0 + kk) * ldw + sc] : 0.f; }
    asm volatile("s_waitcnt lgkmcnt(0)" ::: "memory");
    const int c = lane & 7;
#pragma unroll
    for (int j = 0; j < 4; ++j) { const int nn = (lane >> 3) + 8 * j; const float* s = scr + (8 * c) * 33 + nn;
        v4u o; o.x = pk2(s[0 * 33], s[1 * 33]); o.y = pk2(s[2 * 33], s[3 * 33]); o.z = pk2(s[4 * 33], s[5 * 33]); o.w = pk2(s[6 * 33], s[7 * 33]);
        *(v4u*)(WT + (size_t)(p0 + nn) * K + k0 + 8 * c) = o; }
    asm volatile("s_waitcnt lgkmcnt(0)" ::: "memory");
}
__device__ __forceinline__ void norm_row_to_h(const float* xrow, const float* wpre, bf16* hrow, int lane) {
    f32x4 v[4]; float s = 0.f;
#pragma unroll
    for (int j = 0; j < 4; ++j) { v[j] = *(const f32x4*)(xrow + 4 * lane + 256 * j); s += (v[j].x * v[j].x + v[j].y * v[j].y) + (v[j].z * v[j].z + v[j].w * v[j].w); }
    const float rs = rsqrtf(wave_sum(s) * (1.f / DM) + EPS);
#pragma unroll
    for (int j = 0; j < 4; ++j) { const f32x4 w = *(const f32x4*)(wpre + 4 * lane + 256 * j); v2u o; o.x = pk2(v[j].x * rs * w.x, v[j].y * rs * w.y); o.y = pk2(v[j].z * rs * w.z, v[j].w * rs * w.w);
        *(v2u*)(hrow + 4 * lane + 256 * j) = o; }
}
__device__ __forceinline__ void phase_prologue(const Args& a, unsigned char* lds, int wv_) {
    int tid_ = wv_ * 64 + mk_lane(); asm volatile("" : "+v"(tid_)); const int tid = tid_, lane = tid & 63, wave = tid >> 6;
    float* scr = (float*)(lds + wave * 16384);
    const int gw = blockIdx.x * NWAVES + wave, NGW = gridDim.x * NWAVES;
    constexpr int I_IN = (DM / 64) * (NPAD / 32), I_BR = (BW / 64) * (DM / 32), I_OUT = (DM / 64) * (DM / 32);
    constexpr int NITEMS = DEPTH * I_IN + DEPTH * 3 * I_BR + DEPTH * I_OUT;
    bf16* win = (bf16*)(a.ws + WS_WIN); bf16* wbr = (bf16*)(a.ws + WS_WBR); bf16* wout = (bf16*)(a.ws + WS_WOUT);
    for (int it = gw; it < NITEMS; it += NGW) {
        int r = it;
        if (r < DEPTH * I_IN) { const int l = r / I_IN; r %= I_IN; const int nb = NPAD / 32, kb = r / nb, pb = r % nb;
            tr_item(a.w_in + (size_t)l * DM * NIN, NIN, DM, win + (size_t)l * WIN_L, kb * 64, pb * 32, 1, scr, lane); continue; }
        r -= DEPTH * I_IN;
        if (r < DEPTH * 3 * I_BR) { const int lk = r / I_BR; r %= I_BR; const int nb = DM / 32, kb = r / nb, pb = r % nb;
            tr_item(a.w_branch + (size_t)lk * BW * DM, DM, BW, wbr + (size_t)lk * DM * BW, kb * 64, pb * 32, 0, scr, lane); continue; }
        r -= DEPTH * 3 * I_BR;
        { const int l = r / I_OUT; r %= I_OUT; const int nb = DM / 32, kb = r / nb, pb = r % nb;
            tr_item(a.w_out + (size_t)l * DM * DM, DM, DM, wout + (size_t)l * DM * DM, kb * 64, pb * 32, 0, scr, lane); }
    }
    if (blockIdx.x == 0 && tid < DEPTH) ((unsigned*)(a.ws + WS_CTL))[64 * tid] = 0u;
    bf16* H = (bf16*)(a.ws + WS_REGB);
    for (int m = gw; m < M; m += NGW) norm_row_to_h(a.x + (size_t)m * DM, a.norm_pre, H + (size_t)m * DM, lane);
}

typedef short bf16x8 __attribute__((ext_vector_type(8)));
typedef float f32x16 __attribute__((ext_vector_type(16)));
typedef float f32x2_t __attribute__((ext_vector_type(2))); typedef __bf16 bf16x2_t __attribute__((ext_vector_type(2)));
__device__ __forceinline__ unsigned cvtpk(float lo, float hi) { f32x2_t v = {lo, hi}; bf16x2_t bb = __builtin_convertvector(v, bf16x2_t); return __builtin_bit_cast(unsigned, bb); }
__device__ __forceinline__ int crow(int r, int hi) { return (r & 3) + 8 * (r >> 2) + 4 * hi; }
#define MFMA32(a, b, c) __builtin_amdgcn_mfma_f32_32x32x16_bf16((a), (b), (c), 0, 0, 0)
constexpr int AT_KS = 0, AT_VT = 64 * 144, AT_FS = AT_VT + 128 * 144, AT_CTR = AT_FS + 1024;
__device__ __forceinline__ void phase_attn(const Args& a, unsigned char* lds, int l, int wv_) {
    const bf16* P = (const bf16*)(a.ws + WS_PROJ); float* OATT = (float*)(a.ws + WS_REGC);
    int tid_ = wv_ * 64 + mk_lane(); asm volatile("" : "+v"(tid_)); const int tid = tid_, lane = tid & 63, r32 = lane & 31, hi = lane >> 5, wave = tid >> 6;
    float* fs = (float*)(lds + AT_FS) + wave * 32;
    unsigned* ctr = (unsigned*)(a.ws + WS_CTL) + 64 * l;
#pragma unroll 1
    for (;;) {
        __syncthreads();
        if (tid == 0) *(volatile unsigned*)(lds + AT_CTR) = atomicAdd(ctr, 1u);
        __syncthreads();
        const unsigned uidx = *(volatile unsigned*)(lds + AT_CTR);
        if (uidx >= 512u) break;
        const int stream = (int)(uidx & 15u), qb = 31 - (int)(uidx >> 4);
        const int bb = stream >> 3, h = (stream >> 1) & 3, mp = stream & 1;
        const float slope2 = exp2f(-2.f * (float)(h + 1)) * 1.4426950408889634f;
        const bf16* Kg = P + (size_t)bb * SEQ * NP + C_DK + h * 128 + mp * 64 + (size_t)(tid >> 3) * NP + (tid & 7) * 8;
        const bf16* Vg = P + (size_t)bb * SEQ * NP + C_DV + h * 128 + (size_t)lane * NP + wave * 8;
        {
            const int q0 = qb * 256 + wave * 32, t = q0 + r32;
            bf16x8 qr[4];
            { const bf16* qp = P + ((size_t)bb * SEQ + t) * NP + C_DQ + h * 128 + mp * 64 + hi * 8;
#pragma unroll
              for (int d0 = 0; d0 < 4; ++d0) qr[d0] = *(const bf16x8*)(qp + d0 * 16); }
            float cb[16];
#pragma unroll
            for (int r = 0; r < 16; ++r) cb[r] = slope2 * (float)crow(r, hi);
            f32x16 o[4];
#pragma unroll
            for (int db = 0; db < 4; ++db)
#pragma unroll
                for (int r = 0; r < 16; ++r) o[db][r] = 0.f;
            float m_ref = -1e30f, lsum = 0.f;
            const int ntile = 4 * qb + 4;
            v4u kreg, vreg0, vreg1;
            { const size_t jo = (size_t)(ntile - 1) * 64 * NP; kreg = *(const v4u*)(Kg + jo); vreg0 = *(const v4u*)(Vg + jo); vreg1 = *(const v4u*)(Vg + jo + 64); }
#pragma unroll 1
            for (int tt = ntile - 1; tt >= 0; --tt) {
                __syncthreads();
                *(v4u*)(lds + AT_KS + (tid >> 3) * 144 + (tid & 7) * 16) = kreg;
                { unsigned short* vt = (unsigned short*)(lds + AT_VT) + lane;
                  const unsigned w0[4] = {vreg0.x, vreg0.y, vreg0.z, vreg0.w}, w1[4] = {vreg1.x, vreg1.y, vreg1.z, vreg1.w};
#pragma unroll
                  for (int x = 0; x < 4; ++x) { vt[(wave * 8 + 2 * x) * 72] = (unsigned short)(w0[x] & 0xffffu); vt[(wave * 8 + 2 * x + 1) * 72] = (unsigned short)(w0[x] >> 16);
                      vt[(64 + wave * 8 + 2 * x) * 72] = (unsigned short)(w1[x] & 0xffffu); vt[(64 + wave * 8 + 2 * x + 1) * 72] = (unsigned short)(w1[x] >> 16); } }
                __syncthreads();
                if (tt > 0) { const size_t jo = (size_t)(tt - 1) * 64 * NP; kreg = *(const v4u*)(Kg + jo); vreg0 = *(const v4u*)(Vg + jo); vreg1 = *(const v4u*)(Vg + jo + 64); }
                const int j0 = tt * 64;
                if (j0 <= q0 + 31) {
                    const float base = slope2 * (float)(j0 - t), base1 = base + 32.f * slope2;
                    f32x16 p0, p1;
#pragma unroll
                    for (int r = 0; r < 16; ++r) { p0[r] = cb[r] + base; p1[r] = cb[r] + base1; }
                    { const unsigned char* kb = lds + AT_KS + r32 * 144 + hi * 16;
#pragma unroll
                      for (int d0 = 0; d0 < 4; ++d0) { const bf16x8 a0 = *(const bf16x8*)(kb + d0 * 32), a1 = *(const bf16x8*)(kb + 32 * 144 + d0 * 32);
                          p0 = MFMA32(a0, qr[d0], p0); p1 = MFMA32(a1, qr[d0], p1); } }
                    if (j0 + 63 > q0) {
#pragma unroll
                        for (int r = 0; r < 16; ++r) { const int kv = j0 + crow(r, hi); if (kv > t) p0[r] = -1e30f; if (kv + 32 > t) p1[r] = -1e30f; }
                    }
                    float mx = fmaxf(p0[0], p1[0]);
#pragma unroll
                    for (int r = 1; r < 16; ++r) mx = fmaxf(mx, fmaxf(p0[r], p1[r]));
                    mx = fmaxf(mx, __shfl_xor(mx, 32));
                    if (__any(mx > m_ref + 8.f)) {
                        const float m_new = fmaxf(m_ref, mx), f = __builtin_amdgcn_exp2f(m_ref - m_new); m_ref = m_new; lsum *= f;
                        if (hi == 0) fs[r32] = f;
                        __builtin_amdgcn_wave_barrier();
#pragma unroll
                        for (int g = 0; g < 4; ++g) { const f32x4 ff = *(const f32x4*)(fs + 8 * g + 4 * hi);
#pragma unroll
                            for (int db = 0; db < 4; ++db) { o[db][4 * g] *= ff.x; o[db][4 * g + 1] *= ff.y; o[db][4 * g + 2] *= ff.z; o[db][4 * g + 3] *= ff.w; } }
                        __builtin_amdgcn_wave_barrier();
                    }
                    float sacc = 0.f;
#pragma unroll
                    for (int r = 0; r < 16; ++r) { p0[r] = __builtin_amdgcn_exp2f(p0[r] - m_ref); p1[r] = __builtin_amdgcn_exp2f(p1[r] - m_ref); sacc += p0[r] + p1[r]; }
                    lsum += sacc;
                    bf16x8 pk[4];
#pragma unroll
                    for (int s = 0; s < 2; ++s) { v4u w0, w1;
                        w0.x = cvtpk(p0[8 * s], p0[8 * s + 1]); w0.y = cvtpk(p0[8 * s + 2], p0[8 * s + 3]); w0.z = cvtpk(p0[8 * s + 4], p0[8 * s + 5]); w0.w = cvtpk(p0[8 * s + 6], p0[8 * s + 7]);
                        w1.x = cvtpk(p1[8 * s], p1[8 * s + 1]); w1.y = cvtpk(p1[8 * s + 2], p1[8 * s + 3]); w1.z = cvtpk(p1[8 * s + 4], p1[8 * s + 5]); w1.w = cvtpk(p1[8 * s + 6], p1[8 * s + 7]);
                        pk[s] = __builtin_bit_cast(bf16x8, w0); pk[2 + s] = __builtin_bit_cast(bf16x8, w1); }
                    const unsigned char* vb = lds + AT_VT + r32 * 144 + hi * 8;
#pragma unroll
                    for (int s = 0; s < 4; ++s)
#pragma unroll
                        for (int db = 0; db < 4; ++db) { const v2u lo = *(const v2u*)(vb + db * 32 * 144 + s * 32), hi8 = *(const v2u*)(vb + db * 32 * 144 + s * 32 + 16);
                            v4u w; w.x = lo.x; w.y = lo.y; w.z = hi8.x; w.w = hi8.y;
                            o[db] = MFMA32(pk[s], __builtin_bit_cast(bf16x8, w), o[db]); }
                }
            }
            lsum += __shfl_xor(lsum, 32);
            __builtin_amdgcn_wave_barrier();
            if (hi == 0) fs[r32] = 1.f / lsum;
            __builtin_amdgcn_wave_barrier();
#pragma unroll
            for (int g = 0; g < 4; ++g) { const f32x4 ff = *(const f32x4*)(fs + 8 * g + 4 * hi); const float fv[4] = {ff.x, ff.y, ff.z, ff.w};
#pragma unroll
                for (int x = 0; x < 4; ++x) { const size_t row = (size_t)bb * SEQ + q0 + 8 * g + 4 * hi + x; float* dst = OATT + ((row * 4 + h) * 2 + mp) * 128 + r32;
#pragma unroll
                    for (int db = 0; db < 4; ++db) dst[db * 32] = o[db][4 * g + x] * fv[x]; } }
            __builtin_amdgcn_wave_barrier();
        }
    }
    __syncthreads();
}

__device__ __forceinline__ int afrag_off(int row, int k, int nks) { const int rt = row >> 5, r = row & 31, ks = k >> 4, kk = k & 15, h = (kk >> 2) & 1, j = ((kk >> 3) << 2) | (kk & 3); return ((rt * nks + ks) * 64 + r + 32 * h) * 8 + j; }
__device__ __forceinline__ int clay_off(int c, int dv) { const int rt = c >> 5, cc = c & 31, hi = (cc >> 2) & 1, i = ((cc >> 3) << 2) | (cc & 3), sl = dv >> 5, r32 = dv & 31; return ((rt * 4 + sl) * 64 + r32 + 32 * hi) * 16 + i; }
__device__ __forceinline__ void phase_gdn_local_v1(const Args& a, unsigned char* lds, int l, int wv_) {
    const bf16* P = (const bf16*)(a.ws + WS_PROJ); const float* BA = (const float*)(a.ws + WS_BA);
    bf16* GD = (bf16*)(a.ws + WS_REGD); float* GL = (float*)(a.ws + WS_GL);
    float* qs = (float*)lds; float* ks = qs + 64 * 129; float* vs = ks + 64 * 129; float* KKs = vs + 64 * 129; float* QKs = KKs + 64 * 65;
    float* beta = QKs + 64 * 65; float* gc = beta + 64;
    int tid_ = wv_ * 64 + mk_lane(); asm volatile("" : "+v"(tid_)); const int tid = tid_, lane = tid & 63, wave = tid >> 6;
    const float* cw = a.gdn_conv_w + (size_t)l * 4 * 1536;
    for (int unit = blockIdx.x; unit < NUNIT; unit += gridDim.x) {
        const int bb = unit >> 9, h = (unit >> 7) & 3, n = unit & 127;
        __syncthreads();
#pragma unroll 1
        for (int idx = tid; idx < 3 * 64 * 128; idx += NTHR) {
            const int mat = idx >> 13, rem = idx & 8191, t = rem >> 7, c = rem & 127, col = mat * 512 + h * 128 + c;
            float acc = 0.f;
#pragma unroll
            for (int j = 0; j < 4; ++j) { const int tt = n * 64 + t - 3 + j; if (tt >= 0) acc += cw[j * 1536 + col] * bf2f(P[((size_t)bb * SEQ + tt) * NP + col]); }
            (mat == 0 ? qs : mat == 1 ? ks : vs)[t * 129 + c] = siluf_(acc);
        }
        if (tid < 64) {
            const size_t row = (size_t)bb * SEQ + n * 64 + tid;
            beta[tid] = sigmoidf_(BA[row * 8 + h]);
            const float xx = BA[row * 8 + 4 + h] + a.gdn_dt_bias[l * 4 + h];
            const float sp = xx > 20.f ? xx : log1pf(__expf(xx));
            gc[tid] = -__expf(a.gdn_a_log[l * 4 + h]) * sp;
        }
        __syncthreads();
        if (tid == 0) { float run = 0.f;
#pragma unroll 1
            for (int c = 0; c < 64; ++c) { run += gc[c]; gc[c] = run; } }
        __syncthreads();
#pragma unroll 1
        for (int r = wave * 8; r < wave * 8 + 8; ++r) {
            { float x0 = qs[r * 129 + lane], x1 = qs[r * 129 + 64 + lane]; const float sc = rsqrtf(wave_sum(x0 * x0 + x1 * x1) + 1e-6f) * 0.08838834764831845f; qs[r * 129 + lane] = x0 * sc; qs[r * 129 + 64 + lane] = x1 * sc; }
            { float x0 = ks[r * 129 + lane], x1 = ks[r * 129 + 64 + lane]; const float sc = rsqrtf(wave_sum(x0 * x0 + x1 * x1) + 1e-6f); ks[r * 129 + lane] = x0 * sc; ks[r * 129 + 64 + lane] = x1 * sc; }
        }
        __syncthreads();
#pragma unroll 1
        for (int i = 0; i < 8; ++i) { const int idx = tid + NTHR * i, c = idx >> 6, s = idx & 63; float kk = 0.f, qk = 0.f;
#pragma unroll 4
            for (int d = 0; d < 128; ++d) { const float kv = ks[s * 129 + d]; kk += ks[c * 129 + d] * kv; qk += qs[c * 129 + d] * kv; }
            const float dec = (s <= c) ? __expf(gc[c] - gc[s]) : 0.f;
            KKs[c * 65 + s] = (s < c) ? kk * beta[c] * dec : 0.f; QKs[c * 65 + s] = qk * dec; }
        __syncthreads();
        const size_t ub = (size_t)unit * UREC;
        { const float gl = gc[63];
          for (int idx = tid; idx < 8192; idx += NTHR) { const int c = idx >> 7, d = idx & 127;
              GD[ub + R_QD + afrag_off(c, d, 8)] = (bf16)f2bf(qs[c * 129 + d] * __expf(gc[c])); GD[ub + R_KD + afrag_off(d, c, 4)] = (bf16)f2bf(ks[c * 129 + d] * __expf(gl - gc[c])); }
          for (int idx = tid; idx < 4096; idx += NTHR) { const int c = idx >> 6, s = idx & 63; GD[ub + R_QK + afrag_off(c, s, 4)] = (bf16)f2bf(QKs[c * 65 + s]); }
          if (tid == 0) GL[unit] = __expf(gl); }
        __syncthreads();
        for (int idx = tid; idx < 8192; idx += NTHR) { const int c = idx >> 7, d = idx & 127; vs[c * 129 + d] *= beta[c]; ks[c * 129 + d] *= beta[c] * __expf(gc[c]); }
        __syncthreads();
        if (tid < 256) {
            float* X = (tid < 128 ? vs : ks) + (tid & 127);
#pragma unroll 1
            for (int c = 1; c < 64; ++c) { float acc = X[c * 129]; const float* Ar = KKs + c * 65;
#pragma unroll 4
                for (int s = 0; s < c; ++s) acc -= Ar[s] * X[s * 129];
                X[c * 129] = acc; }
            if (tid < 128) { for (int c = 0; c < 64; ++c) GD[ub + R_U + clay_off(c, tid)] = (bf16)f2bf(X[c * 129]); }
            else { for (int c = 0; c < 64; ++c) GD[ub + R_W + afrag_off(c, tid - 128, 8)] = (bf16)f2bf(-X[c * 129]); }
        }
    }
    __syncthreads();
}

constexpr int SC_WN = 0, SC_QD = 16384, SC_KDT = 32768, SC_QK = 49152, SC_U = 57344, SC_GL = 61440, SC_BUF = 61504;
__device__ __forceinline__ bf16x8 pack8(const f32x16& x, int s) { v4u w; w.x = cvtpk(x[8 * s], x[8 * s + 1]); w.y = cvtpk(x[8 * s + 2], x[8 * s + 3]); w.z = cvtpk(x[8 * s + 4], x[8 * s + 5]); w.w = cvtpk(x[8 * s + 6], x[8 * s + 7]); return __builtin_bit_cast(bf16x8, w); }
__device__ __forceinline__ void phase_gdn_scan(const Args& a, unsigned char* lds, int l, int wv_) {
    const bf16* GD = (const bf16*)(a.ws + WS_REGD); const float* GL = (const float*)(a.ws + WS_GL); float* OG = (float*)(a.ws + WS_REGB);
    int tid_ = wv_ * 64 + mk_lane(); asm volatile("" : "+v"(tid_)); const int tid = tid_, lane = tid & 63, r32 = lane & 31, hi = lane >> 5, wave = tid >> 6;
#pragma unroll 1
    for (int job = blockIdx.x; job < 32; job += gridDim.x) {
        const int bh = job >> 2, sl = job & 3, bb = bh >> 2, h = bh & 3;
        f32x16 S[4];
#pragma unroll
        for (int b4 = 0; b4 < 4; ++b4)
#pragma unroll
            for (int r = 0; r < 16; ++r) S[b4][r] = 0.f;
        __syncthreads();
#pragma unroll 1
        for (int n = -1; n < 128; ++n) {
            if (wave != 0 && n + 1 < 128) {
                const int unit = bh * 128 + n + 1; unsigned char* dstb = lds + ((n + 1) & 1) * SC_BUF + (tid - 64) * 16;
                const unsigned char* rec = (const unsigned char*)(GD + (size_t)unit * UREC) + (tid - 64) * 16;
                v4u lr[9];
#pragma unroll
                for (int q = 0; q < 8; ++q) lr[q] = *(const v4u*)(rec + q * 7168);
                const int lt = tid - 64; const bool hasu = lt < 256;
                if (hasu) lr[8] = *(const v4u*)((const unsigned char*)(GD + (size_t)unit * UREC + R_U) + ((lt >> 7) * 512 + sl * 128 + (lt & 127)) * 16);
#pragma unroll
                for (int q = 0; q < 8; ++q) *(v4u*)(dstb + q * 7168) = lr[q];
                if (hasu) *(v4u*)(dstb + 8 * 7168) = lr[8];
                dstb -= (tid - 64) * 16;
                if (tid == 64) *(float*)(dstb + SC_GL) = GL[unit];
            }
            if (wave == 0 && n >= 0) {
                const unsigned char* base = lds + (n & 1) * SC_BUF;
#define SFRAG(off, f) (*(const bf16x8*)(base + (off) + (f) * 1024 + lane * 16))
                bf16x8 Spk[8];
#pragma unroll
                for (int ks = 0; ks < 8; ++ks) Spk[ks] = pack8(S[ks >> 1], ks & 1);
                f32x16 Vn[2];
#pragma unroll
                for (int rt = 0; rt < 2; ++rt) { const v4u u0 = *(const v4u*)(base + SC_U + (rt * 64 + lane) * 32), u1 = *(const v4u*)(base + SC_U + (rt * 64 + lane) * 32 + 16);
                    const unsigned uw[8] = {u0.x, u0.y, u0.z, u0.w, u1.x, u1.y, u1.z, u1.w};
#pragma unroll
                    for (int x = 0; x < 8; ++x) { Vn[rt][2 * x] = bflo(uw[x]); Vn[rt][2 * x + 1] = bfhi(uw[x]); }
#pragma unroll
                    for (int ks = 0; ks < 8; ++ks) Vn[rt] = MFMA32(SFRAG(SC_WN, rt * 8 + ks), Spk[ks], Vn[rt]); }
                bf16x8 Vpk[4];
#pragma unroll
                for (int ks = 0; ks < 4; ++ks) Vpk[ks] = pack8(Vn[ks >> 1], ks & 1);
#pragma unroll
                for (int rt = 0; rt < 2; ++rt) { f32x16 O;
#pragma unroll
                    for (int r = 0; r < 16; ++r) O[r] = 0.f;
#pragma unroll
                    for (int ks = 0; ks < 8; ++ks) O = MFMA32(SFRAG(SC_QD, rt * 8 + ks), Spk[ks], O);
#pragma unroll
                    for (int ks = 0; ks < 4; ++ks) O = MFMA32(SFRAG(SC_QK, rt * 4 + ks), Vpk[ks], O);
                    float* op = OG + ((size_t)bb * SEQ + n * 64 + rt * 32) * BW + h * 128 + sl * 32 + r32;
#pragma unroll
                    for (int i = 0; i < 16; ++i) op[(size_t)crow(i, hi) * BW] = O[i]; }
                const float g = *(const float*)(base + SC_GL);
#pragma unroll
                for (int b4 = 0; b4 < 4; ++b4) {
#pragma unroll
                    for (int r = 0; r < 16; ++r) S[b4][r] *= g;
#pragma unroll
                    for (int ks = 0; ks < 4; ++ks) S[b4] = MFMA32(SFRAG(SC_KDT, b4 * 4 + ks), Vpk[ks], S[b4]); }
#undef SFRAG
            }
            __syncthreads();
        }
    }
    __syncthreads();
}

__device__ __forceinline__ void phase_finalize(const Args& a, int l, int wv_) {
    const bf16* P = (const bf16*)(a.ws + WS_PROJ); const float* OG = (const float*)(a.ws + WS_REGB); const float* OATT = (const float*)(a.ws + WS_REGC);
    bf16* Y = (bf16*)(a.ws + WS_REGD);
    int tid_ = wv_ * 64 + mk_lane(); asm volatile("" : "+v"(tid_)); const int tid = tid_, lane = tid & 63, wave = tid >> 6;
    const int gw = blockIdx.x * NWAVES + wave, NGW = gridDim.x * NWAVES;
    const float lam_init = 0.8f - 0.6f * expf(-0.3f * (float)l);
    const float* lv = a.diff_lambda + (size_t)l * 256;
    const float lam = expf(wave_sum(lv[lane] * lv[64 + lane])) - expf(wave_sum(lv[128 + lane] * lv[192 + lane])) + lam_init;
    const int e0 = (lane & 15) * 8, hh = lane >> 4, c0 = lane * 8;
    float gnw[8], dnw[8], scw[3][8];
#pragma unroll
    for (int j = 0; j < 8; ++j) { gnw[j] = a.gdn_norm_w[l * 128 + e0 + j]; dnw[j] = a.diff_norm_w[l * 128 + e0 + j] * (1.f - lam_init);
#pragma unroll
        for (int k = 0; k < 3; ++k) scw[k][j] = a.sc_conv_w[((size_t)l * 3 + k) * BW + c0 + j]; }
    for (int row = gw; row < M; row += NGW) {
        const int t = row & (SEQ - 1);
        const bf16* pr = P + (size_t)row * NP;
        float y[8], z[8];
        { const f32x4 o0 = *(const f32x4*)(OG + (size_t)row * BW + c0), o1 = *(const f32x4*)(OG + (size_t)row * BW + c0 + 4);
          float o[8] = {o0.x, o0.y, o0.z, o0.w, o1.x, o1.y, o1.z, o1.w}; float ss = 0.f;
#pragma unroll
          for (int j = 0; j < 8; ++j) ss += o[j] * o[j];
          ss += __shfl_xor(ss, 1); ss += __shfl_xor(ss, 2); ss += __shfl_xor(ss, 4); ss += __shfl_xor(ss, 8);
          const float rs = rsqrtf(ss * (1.f / 128.f) + EPS); ld8(pr + C_GZ + c0, z);
#pragma unroll
          for (int j = 0; j < 8; ++j) y[j] = o[j] * rs * gnw[j] * siluf_(z[j]);
          st8(Y + (size_t)row * BW + c0, y); }
        { const float* op = OATT + (((size_t)row * 4 + hh) * 2) * 128 + e0;
          const f32x4 a0 = *(const f32x4*)op, a1 = *(const f32x4*)(op + 4), b0 = *(const f32x4*)(op + 128), b1 = *(const f32x4*)(op + 132);
          float d[8] = {a0.x - lam * b0.x, a0.y - lam * b0.y, a0.z - lam * b0.z, a0.w - lam * b0.w, a1.x - lam * b1.x, a1.y - lam * b1.y, a1.z - lam * b1.z, a1.w - lam * b1.w}; float ss = 0.f;
#pragma unroll
          for (int j = 0; j < 8; ++j) ss += d[j] * d[j];
          ss += __shfl_xor(ss, 1); ss += __shfl_xor(ss, 2); ss += __shfl_xor(ss, 4); ss += __shfl_xor(ss, 8);
          const float rs = rsqrtf(ss * (1.f / 128.f) + EPS); ld8(pr + C_DZ + c0, z);
#pragma unroll
          for (int j = 0; j < 8; ++j) y[j] = d[j] * rs * dnw[j] * siluf_(z[j]);
          st8(Y + (size_t)M * BW + (size_t)row * BW + c0, y); }
        { float acc[8];
#pragma unroll
          for (int j = 0; j < 8; ++j) acc[j] = 0.f;
#pragma unroll
          for (int k = 0; k < 3; ++k) { const int tt = t - 2 + k; if (tt >= 0) { float cc[8], xx[8]; const bf16* p2 = P + (size_t)(row - 2 + k) * NP; ld8(p2 + C_SC + c0, cc); ld8(p2 + C_SX + c0, xx);
#pragma unroll
              for (int j = 0; j < 8; ++j) acc[j] += scw[k][j] * (cc[j] * xx[j]); } }
          float sb[8]; ld8(pr + C_SB + c0, sb); ld8(pr + C_SZ + c0, z);
#pragma unroll
          for (int j = 0; j < 8; ++j) y[j] = sb[j] * acc[j] * siluf_(z[j]);
          st8(Y + 2 * (size_t)M * BW + (size_t)row * BW + c0, y); }
    }
}

__device__ __forceinline__ void phase_postnorm(const Args& a, int l, int wv_) {
    const float* OUT = (const float*)(a.ws + WS_REGC); bf16* H = (bf16*)(a.ws + WS_REGB);
    const float* xin = (l == 0) ? a.x : a.out;
    int tid_ = wv_ * 64 + mk_lane(); asm volatile("" : "+v"(tid_)); const int tid = tid_, lane = tid & 63, wave = tid >> 6;
    const int gw = blockIdx.x * NWAVES + wave, NGW = gridDim.x * NWAVES;
    const float* wpost = a.norm_post + (size_t)l * DM; const float* wpre = a.norm_pre + (size_t)(l + 1 < DEPTH ? l + 1 : l) * DM;
    for (int row = gw; row < M; row += NGW) {
        f32x4 o[4], x[4]; float s = 0.f;
#pragma unroll
        for (int j = 0; j < 4; ++j) { o[j] = *(const f32x4*)(OUT + (size_t)row * DM + 4 * lane + 256 * j); x[j] = *(const f32x4*)(xin + (size_t)row * DM + 4 * lane + 256 * j);
            s += (o[j].x * o[j].x + o[j].y * o[j].y) + (o[j].z * o[j].z + o[j].w * o[j].w); }
        const float rs = rsqrtf(wave_sum(s) * (1.f / DM) + EPS); float s2 = 0.f;
#pragma unroll
        for (int j = 0; j < 4; ++j) { const f32x4 w = *(const f32x4*)(wpost + 4 * lane + 256 * j); x[j] = x[j] + o[j] * rs * w; *(f32x4*)(a.out + (size_t)row * DM + 4 * lane + 256 * j) = x[j];
            s2 += (x[j].x * x[j].x + x[j].y * x[j].y) + (x[j].z * x[j].z + x[j].w * x[j].w); }
        if (l + 1 < DEPTH) { const float rs2 = rsqrtf(wave_sum(s2) * (1.f / DM) + EPS);
#pragma unroll
            for (int j = 0; j < 4; ++j) { const f32x4 w = *(const f32x4*)(wpre + 4 * lane + 256 * j); v2u ob; ob.x = pk2(x[j].x * rs2 * w.x, x[j].y * rs2 * w.y); ob.y = pk2(x[j].z * rs2 * w.z, x[j].w * rs2 * w.w);
                *(v2u*)(H + (size_t)row * DM + 4 * lane + 256 * j) = ob; } }
    }
}

constexpr int ARGS_OFF = 143360;
constexpr int ARGS_WORDS = (int)(sizeof(Args) / 4);
#ifndef PROBE_SEL
#define PROBE_SEL -1
#endif
constexpr int TS_OFF = ARGS_OFF + 512;
__device__ __forceinline__ void ts_mark(unsigned char* lds, int k) {
    if (PROBE_SEL >= 0 && blockIdx.x == 0 && threadIdx.x == 0) { volatile LAS unsigned long long* p = (volatile LAS unsigned long long*)((LAS unsigned char*)lds + TS_OFF);
        const unsigned long long t = __builtin_amdgcn_s_memrealtime(); p[1 + k] += t - p[0]; p[0] = t; }
}
__device__ __forceinline__ void load_args(Args& b, unsigned char* lds) {
    volatile LAS unsigned* s = (volatile LAS unsigned*)((LAS unsigned char*)lds + ARGS_OFF); unsigned w[ARGS_WORDS];
#pragma unroll
    for (int i = 0; i < ARGS_WORDS; ++i) w[i] = (unsigned)__builtin_amdgcn_readfirstlane((int)s[i]);
    __builtin_memcpy(&b, w, sizeof(Args));
}
template <int L> __device__ __forceinline__ void run_layer(unsigned char* lds, cg::grid_group& grid, int wv) {
    PG8_LAS unsigned char* lds3 = (PG8_LAS unsigned char*)lds;
    constexpr int l = L;
    {
        Args a; load_args(a, lds); const int G = gridDim.x;
        bf16* WIN = (bf16*)(a.ws + WS_WIN); bf16* PROJ = (bf16*)(a.ws + WS_PROJ); float* BA = (float*)(a.ws + WS_BA); bf16* REGB = (bf16*)(a.ws + WS_REGB);
        pg8::Gemm g{REGB, WIN + (size_t)l * WIN_L, M, NPAD, DM}; pg8::StaticOrder S; S.init(M, NPAD, G, (int)blockIdx.x);
        EpiProj E{PROJ, BA};
        pg8::gemm_phase<EpiProj, pg8::StaticOrder, true, true>(lds3, g, S, E, wv);
    }
    grid.sync();
    ts_mark(lds, 1);
    { Args a; load_args(a, lds); phase_gdn_local_v1(a, lds, l, wv); }
    grid.sync();
    ts_mark(lds, 2);
    { Args a; load_args(a, lds); phase_gdn_scan(a, lds, l, wv); }
    ts_mark(lds, 4);
    { Args a; load_args(a, lds); phase_attn(a, lds, l, wv); }
    grid.sync();
    ts_mark(lds, 3);
    { Args a; load_args(a, lds); phase_finalize(a, l, wv); }
    grid.sync();
    ts_mark(lds, 5);
    {
        Args a; load_args(a, lds); const int G = gridDim.x;
        bf16* WBR = (bf16*)(a.ws + WS_WBR); bf16* PROJ = (bf16*)(a.ws + WS_PROJ); bf16* REGB = (bf16*)(a.ws + WS_REGB); float* REGC = (float*)(a.ws + WS_REGC); bf16* Y = (bf16*)(a.ws + WS_REGD);
        pg8::StaticOrder S; S.init(M, DM, G, (int)blockIdx.x);
        { pg8::Gemm g{Y, WBR + ((size_t)l * 3 + 0) * DM * BW, M, DM, BW}; EpiBranch<0> E{PROJ, REGC, REGB}; pg8::gemm_phase<EpiBranch<0>, pg8::StaticOrder, true, true>(lds3, g, S, E, wv); }
        { pg8::Gemm g{Y + (size_t)M * BW, WBR + ((size_t)l * 3 + 1) * DM * BW, M, DM, BW}; EpiBranch<1> E{PROJ, REGC, REGB}; pg8::gemm_phase<EpiBranch<1>, pg8::StaticOrder, true, true>(lds3, g, S, E, wv); }
        { pg8::Gemm g{Y + 2 * (size_t)M * BW, WBR + ((size_t)l * 3 + 2) * DM * BW, M, DM, BW}; EpiBranch<2> E{PROJ, REGC, REGB}; pg8::gemm_phase<EpiBranch<2>, pg8::StaticOrder, true, true>(lds3, g, S, E, wv); }
    }
    grid.sync();
    ts_mark(lds, 6);
    {
        Args a; load_args(a, lds); const int G = gridDim.x;
        bf16* WOUT = (bf16*)(a.ws + WS_WOUT); bf16* REGB = (bf16*)(a.ws + WS_REGB); float* REGC = (float*)(a.ws + WS_REGC);
        pg8::Gemm g{REGB, WOUT + (size_t)l * DM * DM, M, DM, DM}; pg8::StaticOrder S; S.init(M, DM, G, (int)blockIdx.x);
        EpiOutF32 E{REGC};
        pg8::gemm_phase<EpiOutF32, pg8::StaticOrder, true, true>(lds3, g, S, E, wv);
    }
    grid.sync();
    ts_mark(lds, 7);
    { Args a; load_args(a, lds); phase_postnorm(a, l, wv); }
    if (L + 1 < DEPTH) grid.sync();
    ts_mark(lds, 8);
}
__global__ void __launch_bounds__(NTHR, 2) fwd(Args a0) {
    extern __shared__ __attribute__((aligned(16))) unsigned char lds[];
    cg::grid_group grid = cg::this_grid();
    const int wv = __builtin_amdgcn_readfirstlane((int)threadIdx.x >> 6);
    if (threadIdx.x == 0) { unsigned w[ARGS_WORDS]; __builtin_memcpy(w, &a0, sizeof(Args));
#pragma unroll
        for (int i = 0; i < ARGS_WORDS; ++i) ((volatile LAS unsigned*)((LAS unsigned char*)lds + ARGS_OFF))[i] = w[i]; }
    if (PROBE_SEL >= 0 && threadIdx.x == 0) { volatile LAS unsigned long long* p = (volatile LAS unsigned long long*)((LAS unsigned char*)lds + TS_OFF); for (int i = 1; i < 17; ++i) p[i] = 0; p[0] = __builtin_amdgcn_s_memrealtime(); }
    __syncthreads();
    { Args a; load_args(a, lds); phase_prologue(a, lds, wv); }
    grid.sync();
    ts_mark(lds, 0);
    run_layer<0>(lds, grid, wv);
    run_layer<1>(lds, grid, wv);
    run_layer<2>(lds, grid, wv);
    run_layer<3>(lds, grid, wv);
    if (PROBE_SEL >= 0 && blockIdx.x == 0 && threadIdx.x == 0) { volatile LAS unsigned long long* p = (volatile LAS unsigned long long*)((LAS unsigned char*)lds + TS_OFF);
        Args a; load_args(a, lds); a.out[0] = floorf((float)p[1 + PROBE_SEL] * 0.01f * 0.02f + 0.5f) * 50.f; }
}

extern "C" void kernel_launch(void* const* d_in, const int* in_sizes, int n_in, void* d_out, int out_size, void* d_ws, size_t ws_size, hipStream_t stream) {
    static int grid = 0;
    if (grid == 0) {
        if (n_in != 13 || ws_size < WS_END) { fprintf(stderr, "kernel_launch: unexpected n_in %d or ws %zu\n", n_in, ws_size); grid = -1; return; }
        int dev = 0, cus = 0, per_cu = 0;
        hipGetDevice(&dev); hipDeviceGetAttribute(&cus, hipDeviceAttributeMultiprocessorCount, dev);
        hipFuncSetAttribute((const void*)fwd, hipFuncAttributeMaxDynamicSharedMemorySize, LDS_BYTES);
        hipOccupancyMaxActiveBlocksPerMultiprocessor(&per_cu, (const void*)fwd, NTHR, LDS_BYTES);
        (void)hipGetLastError();
        if (per_cu < 1) { fprintf(stderr, "kernel_launch: occupancy query says %d\n", per_cu); per_cu = 1; }
        grid = cus;
    }
    if (grid < 0) return;
    Args a{};
    a.x = (const float*)d_in[0]; a.norm_pre = (const float*)d_in[1]; a.norm_post = (const float*)d_in[2]; a.w_in = (const float*)d_in[3]; a.gdn_conv_w = (const float*)d_in[4];
    a.gdn_a_log = (const float*)d_in[5]; a.gdn_dt_bias = (const float*)d_in[6]; a.gdn_norm_w = (const float*)d_in[7]; a.diff_lambda = (const float*)d_in[8]; a.diff_norm_w = (const float*)d_in[9];
    a.sc_conv_w = (const float*)d_in[10]; a.w_branch = (const float*)d_in[11]; a.w_out = (const float*)d_in[12];
    a.out = (float*)d_out; a.ws = (unsigned char*)d_ws; a.ph_lo = 0; a.ph_hi = 0; a.coop = 1; a.pad = 0;
    void* args[] = {&a};
    hipError_t e = hipLaunchCooperativeKernel((const void*)fwd, dim3(grid), dim3(NTHR), args, LDS_BYTES, stream);
    if (e != hipSuccess) fprintf(stderr, "cooperative launch failed: %s (grid %d)\n", hipGetErrorString(e), grid);
}
```

```cpp
#include <hip/hip_runtime.h>
#include <hip/hip_cooperative_groups.h>
#include <cstdio>
#include <cstdint>
namespace cg = cooperative_groups;
__device__ __forceinline__ int mk_lane() { int r; asm volatile("v_mbcnt_lo_u32_b32 %0, -1, 0\n\tv_mbcnt_hi_u32_b32 %0, -1, %0" : "=v"(r)); return r; }
namespace pg8 {
#define PG8_LAS __attribute__((address_space(3)))
typedef unsigned short bf16_t;
typedef short bf16x8 __attribute__((ext_vector_type(8)));
typedef float f32x4 __attribute__((ext_vector_type(4)));
typedef unsigned u32x4 __attribute__((ext_vector_type(4)));
constexpr int BM = 256, BK = 64, HALF = 128, HTB = HALF * BK * 2  , STAGE_BYTES = 8 * HTB, NXCD = 8, WGM = 8;

__host__ __device__ __forceinline__ int lds_byte(int r, int c) { const int st = (r >> 4) * 2 + (c >> 5), rr = r & 15, cc = c & 31, ob = rr * 64 + cc * 2; return st * 1024 + (ob ^ (((ob >> 9) & 1) << 5)); }
__host__ __device__ __forceinline__ void stage_rc(int b, int& R, int& C) { const int st = b / 1024, sb = b % 1024, swz = sb ^ (((sb >> 9) & 1) << 5); R = (st >> 1) * 16 + swz / 64; C = (st & 1) * 32 + (swz % 64) / 2; }
__host__ __device__ __forceinline__ int perm32(int rho) { const int n = rho >> 4, i = rho & 15; return 8 * (i >> 2) + 4 * n + (i & 3); }

struct Unit { int pm, pn; };
struct Gemm { const bf16_t* A; const bf16_t* Bt; int M, N, K; };

struct StaticOrder {
    int nM, nN, nwg, G, c;
    __host__ __device__ void init(int M, int N, int G_, int c_) { nM = M / BM; nN = N / BM; nwg = nM * nN; G = G_; c = c_; }
    __host__ __device__ bool next(int i, Unit& u) const {
        const long L = (long)i * G + c; if (L >= nwg) return false;
        int wgid = (int)L; { const int q = nwg / NXCD, r = nwg % NXCD, xcd = wgid % NXCD, off = wgid / NXCD; wgid = (xcd < r ? xcd * (q + 1) : r * (q + 1) + (xcd - r) * q) + off; }
        const int nig = WGM * nN, gid = wgid / nig, fm = gid * WGM, gsz = (nM - fm) < WGM ? (nM - fm) : WGM;
        u.pm = fm + ((wgid % nig) % gsz); u.pn = (wgid % nig) / gsz; return true;
    }
    __device__ __forceinline__ void a_ready(const Unit&) const {}
    __device__ __forceinline__ void done(const Unit&) const {}
};
__device__ __forceinline__ unsigned cvt_pk_bf16(float lo, float hi) { unsigned r; asm volatile("v_cvt_pk_bf16_f32 %0, %1, %2" : "=v"(r) : "v"(lo), "v"(hi)); return r; }
typedef float f32x2 __attribute__((ext_vector_type(2)));
template <class Epi, class Sched, bool ALIGN_EPI = false, bool SP2 = false>
__device__ __forceinline__ void gemm_phase(PG8_LAS unsigned char* lds, const Gemm g, const Sched& S, const Epi& E, int wv_) {
    int tid_ = wv_ * 64 + mk_lane(); asm volatile("" : "+v"(tid_)); const int tid = tid_, wid = __builtin_amdgcn_readfirstlane(tid >> 6), lane = tid & 63, wr = wid >> 2, wc = wid & 3, fr = lane & 15, fq = lane >> 4;
    const int K = g.K, nt = K / BK;
    unsigned voffA[2], voffB[2];
#pragma unroll
    for (int i = 0; i < 2; ++i) { int R, C; stage_rc(tid * 16 + i * 8192, R, C); const int Rb = Epi::PERM ? ((R & ~31) + perm32(R & 31)) : R;
        voffA[i] = (unsigned)(R * K + C) * 2u; voffB[i] = (unsigned)(Rb * K + C) * 2u; }
    const size_t kstep = (size_t)(BK * 2);
    const size_t hstep = (size_t)HALF * K * 2;
    const size_t tstep = 2 * hstep;
    const unsigned ldsw = (unsigned)wid * 1024u;
    const int aoff = lds_byte(wr * 64 + fr, fq * 8), boff = lds_byte(wc * 32 + fr, fq * 8);
#define PG8_SA(b, h) (((b) * 2 + (h)) * HTB)
#define PG8_SB(b, h) ((4 + (b) * 2 + (h)) * HTB)
#define PG8_STAGE(bufoff, gbase, voff) do { _Pragma("unroll") for (int _i = 0; _i < 2; ++_i) \
        __builtin_amdgcn_global_load_lds((const unsigned*)((const char*)(gbase) + (voff)[_i]), (PG8_LAS unsigned*)(lds + (bufoff) + ldsw + _i * 8192), 16, 0, 0); } while (0)
#define PG8_LDA(dst, b, h) do { _Pragma("unroll") for (int m = 0; m < 4; ++m) _Pragma("unroll") for (int k = 0; k < 2; ++k) dst[m][k] = *(const PG8_LAS bf16x8*)(lds + PG8_SA(b, h) + aoff + m * 2048 + k * 1024); } while (0)
#define PG8_LDB(dst, b, h) do { _Pragma("unroll") for (int n = 0; n < 2; ++n) _Pragma("unroll") for (int k = 0; k < 2; ++k) dst[n][k] = *(const PG8_LAS bf16x8*)(lds + PG8_SB(b, h) + boff + n * 2048 + k * 1024); } while (0)
#define PG8_MMA(ai, bj, At, Bt) do { __builtin_amdgcn_s_setprio(1); _Pragma("unroll") for (int m = 0; m < 4; ++m) _Pragma("unroll") for (int n = 0; n < 2; ++n) _Pragma("unroll") for (int k = 0; k < 2; ++k) \
        acc[ai][bj][m][n] = __builtin_amdgcn_mfma_f32_16x16x32_bf16(Bt[n][k], At[m][k], acc[ai][bj][m][n], 0, 0, 0); __builtin_amdgcn_s_setprio(0); } while (0)
#define PG8_WAIT_V(n) asm volatile("s_waitcnt vmcnt(" #n ")" ::: "memory")
#define PG8_WAIT_L(n) asm volatile("s_waitcnt lgkmcnt(" #n ")" ::: "memory")
#define PG8_BAR __builtin_amdgcn_s_barrier()
#define PG8_SCHED __builtin_amdgcn_sched_barrier(0)
    Unit cur, nxt; int ui = 0;
    if (!S.next(0, cur)) return;
    f32x4 acc[2][2][4][2];
#pragma unroll
    for (int a = 0; a < 2; ++a)
#pragma unroll
        for (int b = 0; b < 2; ++b)
#pragma unroll
            for (int m = 0; m < 4; ++m)
#pragma unroll
                for (int n = 0; n < 2; ++n) acc[a][b][m][n] = (f32x4){0.f, 0.f, 0.f, 0.f};
    bf16x8 At[4][2], B0[2][2], B1[2][2];
    const char* cA = (const char*)g.A + (size_t)cur.pm * tstep; const char* cB = (const char*)g.Bt + (size_t)cur.pn * tstep;
    S.a_ready(cur);
    if constexpr (SP2) {
        PG8_STAGE(PG8_SB(0, 0), cB, voffB); PG8_STAGE(PG8_SB(0, 1), cB + hstep, voffB); PG8_STAGE(PG8_SA(0, 0), cA, voffA); PG8_STAGE(PG8_SA(0, 1), cA + hstep, voffA);
        if (wr == 1) PG8_BAR;
        PG8_WAIT_V(2); PG8_BAR;
        PG8_STAGE(PG8_SB(1, 0), cB + kstep, voffB); PG8_STAGE(PG8_SA(1, 0), cA + kstep, voffA); PG8_STAGE(PG8_SB(1, 1), cB + hstep + kstep, voffB);
        PG8_WAIT_V(6); PG8_BAR;
    } else {
        PG8_STAGE(PG8_SB(0, 0), cB, voffB); PG8_STAGE(PG8_SA(0, 0), cA, voffA); PG8_STAGE(PG8_SB(0, 1), cB + hstep, voffB); PG8_STAGE(PG8_SA(0, 1), cA + hstep, voffA);
        if (wr == 1) PG8_BAR;
        PG8_WAIT_V(4); PG8_BAR;
        PG8_STAGE(PG8_SB(1, 0), cB + kstep, voffB); PG8_STAGE(PG8_SA(1, 0), cA + kstep, voffA); PG8_STAGE(PG8_SB(1, 1), cB + hstep + kstep, voffB);
        PG8_WAIT_V(6); PG8_BAR;
    }
    for (;;) {
        const bool has_next = S.next(ui + 1, nxt);
        const char* nA = has_next ? (const char*)g.A + (size_t)nxt.pm * tstep : cA; const char* nB = has_next ? (const char*)g.Bt + (size_t)nxt.pn * tstep : cB;
        for (int t = 0; t < nt; t += 2) {
            const bool last = (t == nt - 2);
            const char* a1 = cA + (size_t)(t + 1) * kstep;
            const char* a2 = last ? nA : cA + (size_t)(t + 2) * kstep; const char* b2 = last ? nB : cB + (size_t)(t + 2) * kstep;
            const char* a3 = a2 + kstep; const char* b3 = b2 + kstep;
            if (last && has_next) S.a_ready(nxt);
            if constexpr (SP2) {
            PG8_LDB(B0, 0, 0); PG8_LDB(B1, 0, 1); PG8_SCHED; PG8_LDA(At, 0, 0); PG8_STAGE(PG8_SA(1, 1), a1 + hstep, voffA);
            PG8_WAIT_V(8); PG8_WAIT_L(0); PG8_BAR; PG8_MMA(0, 0, At, B0); PG8_MMA(0, 1, At, B1); PG8_BAR; PG8_SCHED;
            PG8_LDA(At, 0, 1); PG8_STAGE(PG8_SB(0, 0), b2, voffB); PG8_STAGE(PG8_SB(0, 1), b2 + hstep, voffB); PG8_STAGE(PG8_SA(0, 0), a2, voffA);
            PG8_WAIT_V(8); PG8_WAIT_L(0); PG8_BAR; PG8_MMA(1, 0, At, B0); PG8_MMA(1, 1, At, B1); PG8_BAR; PG8_SCHED;
            PG8_LDB(B0, 1, 0); PG8_LDB(B1, 1, 1); PG8_SCHED; PG8_LDA(At, 1, 0); PG8_STAGE(PG8_SA(0, 1), a2 + hstep, voffA);
            PG8_WAIT_V(8); PG8_WAIT_L(0); PG8_BAR; PG8_MMA(0, 0, At, B0); PG8_MMA(0, 1, At, B1); PG8_BAR; PG8_SCHED;
            PG8_LDA(At, 1, 1); PG8_STAGE(PG8_SB(1, 0), b3, voffB); PG8_STAGE(PG8_SB(1, 1), b3 + hstep, voffB); PG8_STAGE(PG8_SA(1, 0), a3, voffA);
            PG8_WAIT_V(8); PG8_WAIT_L(0); PG8_BAR; PG8_MMA(1, 0, At, B0); PG8_MMA(1, 1, At, B1); PG8_BAR; PG8_SCHED;
            } else {
            PG8_LDB(B0, 0, 0); PG8_SCHED; PG8_LDA(At, 0, 0); PG8_STAGE(PG8_SA(1, 1), a1 + hstep, voffA);
            PG8_WAIT_L(8); PG8_BAR; PG8_WAIT_L(0); PG8_MMA(0, 0, At, B0); PG8_BAR; PG8_SCHED;
            PG8_LDB(B1, 0, 1); PG8_STAGE(PG8_SB(0, 0), b2, voffB);
            PG8_BAR; PG8_WAIT_L(0); PG8_MMA(0, 1, At, B1); PG8_BAR;
            PG8_LDA(At, 0, 1); PG8_STAGE(PG8_SA(0, 0), a2, voffA);
            PG8_BAR; PG8_WAIT_L(0); PG8_MMA(1, 0, At, B0); PG8_BAR; PG8_SCHED;
            PG8_STAGE(PG8_SB(0, 1), b2 + hstep, voffB);
            PG8_WAIT_V(6); PG8_BAR; PG8_MMA(1, 1, At, B1); PG8_BAR;
            PG8_LDB(B0, 1, 0); PG8_SCHED; PG8_LDA(At, 1, 0); PG8_STAGE(PG8_SA(0, 1), a2 + hstep, voffA);
            PG8_WAIT_L(8); PG8_BAR; PG8_WAIT_L(0); PG8_MMA(0, 0, At, B0); PG8_BAR; PG8_SCHED;
            PG8_LDB(B1, 1, 1); PG8_STAGE(PG8_SB(1, 0), b3, voffB);
            PG8_BAR; PG8_WAIT_L(0); PG8_MMA(0, 1, At, B1); PG8_BAR;
            PG8_LDA(At, 1, 1); PG8_STAGE(PG8_SA(1, 0), a3, voffA);
            PG8_BAR; PG8_WAIT_L(0); PG8_MMA(1, 0, At, B0); PG8_BAR; PG8_SCHED;
            PG8_STAGE(PG8_SB(1, 1), b3 + hstep, voffB);
            PG8_WAIT_V(6); PG8_BAR; PG8_MMA(1, 1, At, B1); PG8_BAR;
            }
        }
        if constexpr (ALIGN_EPI) { if (wr == 0) PG8_BAR; }
        if constexpr (!Epi::AFTER_DRAIN) { E(acc, cur, wr, wc, fr, fq); S.done(cur); }
        if (!has_next) break;
#pragma unroll
        for (int a = 0; a < 2; ++a)
#pragma unroll
            for (int b = 0; b < 2; ++b)
#pragma unroll
                for (int m = 0; m < 4; ++m)
#pragma unroll
                    for (int n = 0; n < 2; ++n) acc[a][b][m][n] = (f32x4){0.f, 0.f, 0.f, 0.f};
        cur = nxt; cA = nA; cB = nB; ++ui;
        if constexpr (ALIGN_EPI) { if (wr == 1) PG8_BAR; }
    }
    PG8_WAIT_V(0);
    if constexpr (!ALIGN_EPI) { if (wr == 0) PG8_BAR; }
    PG8_BAR;
    if constexpr (Epi::AFTER_DRAIN) { E.fused(acc, cur, wr, wc, fr, fq, lds, wid, lane); S.done(cur); }
#undef PG8_SA
#undef PG8_SB
#undef PG8_STAGE
#undef PG8_LDA
#undef PG8_LDB
#undef PG8_MMA
#undef PG8_WAIT_V
#undef PG8_WAIT_L
#undef PG8_BAR
#undef PG8_SCHED
}
}
constexpr int BATCH = 2, SEQ = 8192, DM = 1024, DEPTH = 4, M = BATCH * SEQ;
constexpr int NIN = 9224, NP = 9216, NPAD = 9472, BW = 512;
constexpr int C_GQ = 0, C_GK = 512, C_GV = 1024, C_GZ = 1536, C_DQ = 2048, C_DK = 2560, C_DV = 3072, C_DZ = 3584,
              C_SB = 4096, C_SC = 4608, C_SX = 5120, C_SZ = 5632, C_MG = 6144;
constexpr float EPS = 1e-6f;
constexpr int NWAVES = 8, NTHR = 512;
constexpr int LDS_BYTES = 147456;
constexpr size_t MiB = 1u << 20;
constexpr size_t WS_CTL = 0;
constexpr size_t WS_WIN = 2 * MiB;
constexpr size_t WIN_L = (size_t)NPAD * DM;
constexpr size_t WS_WBR = 76 * MiB;
constexpr size_t WS_WOUT = 88 * MiB;
constexpr size_t WS_PROJ = 96 * MiB;
constexpr size_t WS_BA = 384 * MiB;
constexpr size_t WS_REGB = 386 * MiB;
constexpr size_t WS_REGC = 418 * MiB;
constexpr size_t WS_REGD = 482 * MiB;
constexpr size_t WS_GL = 554 * MiB;
constexpr size_t WS_END = 555 * MiB;
constexpr int NUNIT = BATCH * 4 * 128;
constexpr size_t UREC = 36864, R_W = 0, R_QD = 8192, R_KD = 16384, R_QK = 24576, R_U = 28672;

typedef unsigned short bf16;
typedef unsigned v4u __attribute__((ext_vector_type(4)));
typedef unsigned v2u __attribute__((ext_vector_type(2)));
typedef float f32x4 __attribute__((ext_vector_type(4)));
#define LAS __attribute__((address_space(3)))

__device__ __forceinline__ unsigned f2bf(float f) { unsigned u = __builtin_bit_cast(unsigned, f); return (u + 0x7fffu + ((u >> 16) & 1u)) >> 16; }
__device__ __forceinline__ unsigned pk2(float lo, float hi) { return f2bf(lo) | (f2bf(hi) << 16); }
__device__ __forceinline__ float bf2f(unsigned short b) { return __builtin_bit_cast(float, (unsigned)b << 16); }
__device__ __forceinline__ float bflo(unsigned w) { return __builtin_bit_cast(float, w << 16); }
__device__ __forceinline__ float bfhi(unsigned w) { return __builtin_bit_cast(float, w & 0xffff0000u); }
__device__ __forceinline__ void ld8(const bf16* p, float* f) { const v4u w = *(const v4u*)p; f[0] = bflo(w.x); f[1] = bfhi(w.x); f[2] = bflo(w.y); f[3] = bfhi(w.y); f[4] = bflo(w.z); f[5] = bfhi(w.z); f[6] = bflo(w.w); f[7] = bfhi(w.w); }
__device__ __forceinline__ void st8(bf16* p, const float* f) { v4u w; w.x = pk2(f[0], f[1]); w.y = pk2(f[2], f[3]); w.z = pk2(f[4], f[5]); w.w = pk2(f[6], f[7]); *(v4u*)p = w; }
__device__ __forceinline__ float wave_sum(float v) {
#pragma unroll
    for (int o = 1; o < 64; o <<= 1) v += __shfl_xor(v, o);
    return v;
}
__device__ __forceinline__ float sigmoidf_(float x) { return 1.f / (1.f + __expf(-x)); }
__device__ __forceinline__ float siluf_(float x) { return x / (1.f + __expf(-x)); }
__device__ __forceinline__ int srccol(int p) { return p < 2048 ? p : (p < 9216 ? p + 8 : (p < 9224 ? 2048 + (p - 9216) : -1)); }

struct Args {
    const float* x; const float* norm_pre; const float* norm_post; const float* w_in; const float* gdn_conv_w; const float* gdn_a_log; const float* gdn_dt_bias;
    const float* gdn_norm_w; const float* diff_lambda; const float* diff_norm_w; const float* sc_conv_w; const float* w_branch; const float* w_out;
    float* out; unsigned char* ws; int ph_lo, ph_hi, coop, pad;
};

struct EpiProj {
    static constexpr bool PERM = true, AFTER_DRAIN = false;
    bf16* P; float* BA;
    __device__ __forceinline__ void operator()(const pg8::f32x4 (&acc)[2][2][4][2], const pg8::Unit& u, int wr, int wc, int fr, int fq) const {
        const int row0 = u.pm * 256 + wr * 64 + fr;
        if (u.pn == 36) {
            if (wc == 0 && fq == 0) {
#pragma unroll
                for (int ai = 0; ai < 2; ++ai)
#pragma unroll
                    for (int m = 0; m < 4; ++m) { float* o = BA + (size_t)(row0 + ai * 128 + m * 16) * 8; *(pg8::f32x4*)o = acc[ai][0][m][0]; *(pg8::f32x4*)(o + 4) = acc[ai][0][m][1]; }
            }
            return;
        }
        const int colt = u.pn * 256; const float sc = (colt >= C_DQ && colt < C_DK) ? 0.18033688011112042f : 1.f;
        const int col0 = colt + wc * 32 + 8 * fq;
#pragma unroll
        for (int ai = 0; ai < 2; ++ai)
#pragma unroll
            for (int m = 0; m < 4; ++m) { bf16* rowp = P + (size_t)(row0 + ai * 128 + m * 16) * NP + col0;
#pragma unroll
                for (int bj = 0; bj < 2; ++bj) { const pg8::f32x4 v0 = acc[ai][bj][m][0] * sc, v1 = acc[ai][bj][m][1] * sc; v4u w;
                    w.x = pg8::cvt_pk_bf16(v0[0], v0[1]); w.y = pg8::cvt_pk_bf16(v0[2], v0[3]); w.z = pg8::cvt_pk_bf16(v1[0], v1[1]); w.w = pg8::cvt_pk_bf16(v1[2], v1[3]);
                    *(v4u*)(rowp + bj * 128) = w; } }
    }
};
template <int KB> struct EpiBranch {
    static constexpr bool PERM = true, AFTER_DRAIN = false;
    const bf16* P; float* MG; bf16* MB;
    __device__ __forceinline__ void operator()(const pg8::f32x4 (&acc)[2][2][4][2], const pg8::Unit& u, int wr, int wc, int fr, int fq) const {
        const int row0 = u.pm * 256 + wr * 64 + fr; const int col0 = u.pn * 256 + wc * 32 + 8 * fq;
#pragma unroll
        for (int ai = 0; ai < 2; ++ai)
#pragma unroll
            for (int m = 0; m < 4; ++m) { const size_t row = (size_t)(row0 + ai * 128 + m * 16);
#pragma unroll
                for (int bj = 0; bj < 2; ++bj) { const int col = col0 + bj * 128; float lg[8]; ld8(P + row * NP + C_MG + KB * 1024 + col, lg);
                    float v[8];
#pragma unroll
                    for (int j = 0; j < 4; ++j) { v[j] = acc[ai][bj][m][0][j] * sigmoidf_(lg[j]); v[4 + j] = acc[ai][bj][m][1][j] * sigmoidf_(lg[4 + j]); }
                    float* mp = MG + row * DM + col;
                    if (KB > 0) { const pg8::f32x4 a = *(const pg8::f32x4*)mp, b = *(const pg8::f32x4*)(mp + 4);
#pragma unroll
                        for (int j = 0; j < 4; ++j) { v[j] += a[j]; v[4 + j] += b[j]; } }
                    if (KB < 2) { *(pg8::f32x4*)mp = (pg8::f32x4){v[0], v[1], v[2], v[3]}; *(pg8::f32x4*)(mp + 4) = (pg8::f32x4){v[4], v[5], v[6], v[7]}; }
                    else st8(MB + row * DM + col, v); } }
    }
};
struct EpiOutF32 {
    static constexpr bool PERM = true, AFTER_DRAIN = false;
    float* O;
    __device__ __forceinline__ void operator()(const pg8::f32x4 (&acc)[2][2][4][2], const pg8::Unit& u, int wr, int wc, int fr, int fq) const {
        const int row0 = u.pm * 256 + wr * 64 + fr; const int col0 = u.pn * 256 + wc * 32 + 8 * fq;
#pragma unroll
        for (int ai = 0; ai < 2; ++ai)
#pragma unroll
            for (int m = 0; m < 4; ++m) { float* rowp = O + (size_t)(row0 + ai * 128 + m * 16) * DM + col0;
#pragma unroll
                for (int bj = 0; bj < 2; ++bj) { *(pg8::f32x4*)(rowp + bj * 128) = acc[ai][bj][m][0]; *(pg8::f32x4*)(rowp + bj * 128 + 4) = acc[ai][bj][m][1]; } }
    }
};

__device__ __forceinline__ void tr_item(const float* W, int ldw, int K, bf16* WT, int k0, int p0, int mode, float* scr, int lane) {
    const int n = lane & 31; const int p = p0 + n; const int sc = mode ? srccol(p) : p;
#pragma unroll 8
    for (int i = 0; i < 32; ++i) { const int kk = 2 * i + (lane >> 5); scr[kk * 33 + n] = sc >= 0 ? W[(size_t)(k0 + kk) * ldw + sc] : 0.f; }
    asm volatile("s_waitcnt lgkmcnt(0)" ::: "memory");
    const int c = lane & 7;
#pragma unroll
    for (int j = 0; j < 4; ++j) { const int nn = (lane >> 3) + 8 * j; const float* s = scr + (8 * c) * 33 + nn;
        v4u o; o.x = pk2(s[0 * 33], s[1 * 33]); o.y = pk2(s[2 * 33], s[3 * 33]); o.z = pk2(s[4 * 33], s[5 * 33]); o.w = pk2(s[6 * 33], s[7 * 33]);
        *(v4u*)(WT + (size_t)(p0 + nn) * K + k0 + 8 * c) = o; }
    asm volatile("s_waitcnt lgkmcnt(0)" ::: "memory");
}
__device__ __forceinline__ void norm_row_to_h(const float* xrow, const float* wpre, bf16* hrow, int lane) {
    f32x4 v[4]; float s = 0.f;
#pragma unroll
    for (int j = 0; j < 4; ++j) { v[j] = *(const f32x4*)(xrow + 4 * lane + 256 * j); s += (v[j].x * v[j].x + v[j].y * v[j].y) + (v[j].z * v[j].z + v[j].w * v[j].w); }
    const float rs = rsqrtf(wave_sum(s) * (1.f / DM) + EPS);
#pragma unroll
    for (int j = 0; j < 4; ++j) { const f32x4 w = *(const f32x4*)(wpre + 4 * lane + 256 * j); v2u o; o.x = pk2(v[j].x * rs * w.x, v[j].y * rs * w.y); o.y = pk2(v[j].z * rs * w.z, v[j].w * rs * w.w);
        *(v2u*)(hrow + 4 * lane + 256 * j) = o; }
}
__device__ __forceinline__ void phase_prologue(const Args& a, unsigned char* lds, int wv_) {
    int tid_ = wv_ * 64 + mk_lane(); asm volatile("" : "+v"(tid_)); const int tid = tid_, lane = tid & 63, wave = tid >> 6;
    float* scr = (float*)(lds + wave * 16384);
    const int gw = blockIdx.x * NWAVES + wave, NGW = gridDim.x * NWAVES;
    constexpr int I_IN = (DM / 64) * (NPAD / 32), I_BR = (BW / 64) * (DM / 32), I_OUT = (DM / 64) * (DM / 32);
    constexpr int NITEMS = DEPTH * I_IN + DEPTH * 3 * I_BR + DEPTH * I_OUT;
    bf16* win = (bf16*)(a.ws + WS_WIN); bf16* wbr = (bf16*)(a.ws + WS_WBR); bf16* wout = (bf16*)(a.ws + WS_WOUT);
    for (int it = gw; it < NITEMS; it += NGW) {
        int r = it;
        if (r < DEPTH * I_IN) { const int l = r / I_IN; r %= I_IN; const int nb = NPAD / 32, kb = r / nb, pb = r % nb;
            tr_item(a.w_in + (size_t)l * DM * NIN, NIN, DM, win + (size_t)l * WIN_L, kb * 64, pb * 32, 1, scr, lane); continue; }
        r -= DEPTH * I_IN;
        if (r < DEPTH * 3 * I_BR) { const int lk = r / I_BR; r %= I_BR; const int nb = DM / 32, kb = r / nb, pb = r % nb;
            tr_item(a.w_branch + (size_t)lk * BW * DM, DM, BW, wbr + (size_t)lk * DM * BW, kb * 64, pb * 32, 0, scr, lane); continue; }
        r -= DEPTH * 3 * I_BR;
        { const int l = r / I_OUT; r %= I_OUT; const int nb = DM / 32, kb = r / nb, pb = r % nb;
            tr_item(a.w_out + (size_t)l * DM * DM, DM, DM, wout + (size_t)l * DM * DM, kb * 64, pb * 32, 0, scr, lane); }
    }
    if (blockIdx.x == 0 && tid < DEPTH) ((unsigned*)(a.ws + WS_CTL))[64 * tid] = 0u;
    bf16* H = (bf16*)(a.ws + WS_REGB);
    for (int m = gw; m < M; m += NGW) norm_row_to_h(a.x + (size_t)m * DM, a.norm_pre, H + (size_t)m * DM, lane);
}

typedef short bf16x8 __attribute__((ext_vector_type(8)));
typedef float f32x16 __attribute__((ext_vector_type(16)));
typedef float f32x2_t __attribute__((ext_vector_type(2))); typedef __bf16 bf16x2_t __attribute__((ext_vector_type(2)));
__device__ __forceinline__ unsigned cvtpk(float lo, float hi) { f32x2_t v = {lo, hi}; bf16x2_t bb = __builtin_convertvector(v, bf16x2_t); return __builtin_bit_cast(unsigned, bb); }
__device__ __forceinline__ int crow(int r, int hi) { return (r & 3) + 8 * (r >> 2) + 4 * hi; }
#define MFMA32(a, b, c) __builtin_amdgcn_mfma_f32_32x32x16_bf16((a), (b), (c), 0, 0, 0)
constexpr int AT_KS = 0, AT_VT = 64 * 144, AT_FS = AT_VT + 128 * 144, AT_CTR = AT_FS + 1024;
__device__ __forceinline__ void phase_attn(const Args& a, unsigned char* lds, int l, int wv_) {
    const bf16* P = (const bf16*)(a.ws + WS_PROJ); float* OATT = (float*)(a.ws + WS_REGC);
    int tid_ = wv_ * 64 + mk_lane(); asm volatile("" : "+v"(tid_)); const int tid = tid_, lane = tid & 63, r32 = lane & 31, hi = lane >> 5, wave = tid >> 6;
    float* fs = (float*)(lds + AT_FS) + wave * 32;
    unsigned* ctr = (unsigned*)(a.ws + WS_CTL) + 64 * l;
#pragma unroll 1
    for (;;) {
        __syncthreads();
        if (tid == 0) *(volatile unsigned*)(lds + AT_CTR) = atomicAdd(ctr, 1u);
        __syncthreads();
        const unsigned uidx = *(volatile unsigned*)(lds + AT_CTR);
        if (uidx >= 512u) break;
        const int stream = (int)(uidx & 15u), qb = 31 - (int)(uidx >> 4);
        const int bb = stream >> 3, h = (stream >> 1) & 3, mp = stream & 1;
        const float slope2 = exp2f(-2.f * (float)(h + 1)) * 1.4426950408889634f;
        const bf16* Kg = P + (size_t)bb * SEQ * NP + C_DK + h * 128 + mp * 64 + (size_t)(tid >> 3) * NP + (tid & 7) * 8;
        const bf16* Vg = P + (size_t)bb * SEQ * NP + C_DV + h * 128 + (size_t)lane * NP + wave * 8;
        {
            const int q0 = qb * 256 + wave * 32, t = q0 + r32;
            bf16x8 qr[4];
            { const bf16* qp = P + ((size_t)bb * SEQ + t) * NP + C_DQ + h * 128 + mp * 64 + hi * 8;
#pragma unroll
              for (int d0 = 0; d0 < 4; ++d0) qr[d0] = *(const bf16x8*)(qp + d0 * 16); }
            float cb[16];
#pragma unroll
            for (int r = 0; r < 16; ++r) cb[r] = slope2 * (float)crow(r, hi);
            f32x16 o[4];
#pragma unroll
            for (int db = 0; db < 4; ++db)
#pragma unroll
                for (int r = 0; r < 16; ++r) o[db][r] = 0.f;
            float m_ref = -1e30f, lsum = 0.f;
            const int ntile = 4 * qb + 4;
            v4u kreg, vreg0, vreg1;
            { const size_t jo = (size_t)(ntile - 1) * 64 * NP; kreg = *(const v4u*)(Kg + jo); vreg0 = *(const v4u*)(Vg + jo); vreg1 = *(const v4u*)(Vg + jo + 64); }
#pragma unroll 1
            for (int tt = ntile - 1; tt >= 0; --tt) {
                __syncthreads();
                *(v4u*)(lds + AT_KS + (tid >> 3) * 144 + (tid & 7) * 16) = kreg;
                { unsigned short* vt = (unsigned short*)(lds + AT_VT) + lane;
                  const unsigned w0[4] = {vreg0.x, vreg0.y, vreg0.z, vreg0.w}, w1[4] = {vreg1.x, vreg1.y, vreg1.z, vreg1.w};
#pragma unroll
                  for (int x = 0; x < 4; ++x) { vt[(wave * 8 + 2 * x) * 72] = (unsigned short)(w0[x] & 0xffffu); vt[(wave * 8 + 2 * x + 1) * 72] = (unsigned short)(w0[x] >> 16);
                      vt[(64 + wave * 8 + 2 * x) * 72] = (unsigned short)(w1[x] & 0xffffu); vt[(64 + wave * 8 + 2 * x + 1) * 72] = (unsigned short)(w1[x] >> 16); } }
                __syncthreads();
                if (tt > 0) { const size_t jo = (size_t)(tt - 1) * 64 * NP; kreg = *(const v4u*)(Kg + jo); vreg0 = *(const v4u*)(Vg + jo); vreg1 = *(const v4u*)(Vg + jo + 64); }
                const int j0 = tt * 64;
                if (j0 <= q0 + 31) {
                    const float base = slope2 * (float)(j0 - t), base1 = base + 32.f * slope2;
                    f32x16 p0, p1;
#pragma unroll
                    for (int r = 0; r < 16; ++r) { p0[r] = cb[r] + base; p1[r] = cb[r] + base1; }
                    { const unsigned char* kb = lds + AT_KS + r32 * 144 + hi * 16;
#pragma unroll
                      for (int d0 = 0; d0 < 4; ++d0) { const bf16x8 a0 = *(const bf16x8*)(kb + d0 * 32), a1 = *(const bf16x8*)(kb + 32 * 144 + d0 * 32);
                          p0 = MFMA32(a0, qr[d0], p0); p1 = MFMA32(a1, qr[d0], p1); } }
                    if (j0 + 63 > q0) {
#pragma unroll
                        for (int r = 0; r < 16; ++r) { const int kv = j0 + crow(r, hi); if (kv > t) p0[r] = -1e30f; if (kv + 32 > t) p1[r] = -1e30f; }
                    }
                    float mx = fmaxf(p0[0], p1[0]);
#pragma unroll
                    for (int r = 1; r < 16; ++r) mx = fmaxf(mx, fmaxf(p0[r], p1[r]));
                    mx = fmaxf(mx, __shfl_xor(mx, 32));
                    if (__any(mx > m_ref + 8.f)) {
                        const float m_new = fmaxf(m_ref, mx), f = __builtin_amdgcn_exp2f(m_ref - m_new); m_ref = m_new; lsum *= f;
                        if (hi == 0) fs[r32] = f;
                        __builtin_amdgcn_wave_barrier();
#pragma unroll
                        for (int g = 0; g < 4; ++g) { const f32x4 ff = *(const f32x4*)(fs + 8 * g + 4 * hi);
#pragma unroll
                            for (int db = 0; db < 4; ++db) { o[db][4 * g] *= ff.x; o[db][4 * g + 1] *= ff.y; o[db][4 * g + 2] *= ff.z; o[db][4 * g + 3] *= ff.w; } }
                        __builtin_amdgcn_wave_barrier();
                    }
                    float sacc = 0.f;
#pragma unroll
                    for (int r = 0; r < 16; ++r) { p0[r] = __builtin_amdgcn_exp2f(p0[r] - m_ref); p1[r] = __builtin_amdgcn_exp2f(p1[r] - m_ref); sacc += p0[r] + p1[r]; }
                    lsum += sacc;
                    bf16x8 pk[4];
#pragma unroll
                    for (int s = 0; s < 2; ++s) { v4u w0, w1;
                        w0.x = cvtpk(p0[8 * s], p0[8 * s + 1]); w0.y = cvtpk(p0[8 * s + 2], p0[8 * s + 3]); w0.z = cvtpk(p0[8 * s + 4], p0[8 * s + 5]); w0.w = cvtpk(p0[8 * s + 6], p0[8 * s + 7]);
                        w1.x = cvtpk(p1[8 * s], p1[8 * s + 1]); w1.y = cvtpk(p1[8 * s + 2], p1[8 * s + 3]); w1.z = cvtpk(p1[8 * s + 4], p1[8 * s + 5]); w1.w = cvtpk(p1[8 * s + 6], p1[8 * s + 7]);
                        pk[s] = __builtin_bit_cast(bf16x8, w0); pk[2 + s] = __builtin_bit_cast(bf16x8, w1); }
                    const unsigned char* vb = lds + AT_VT + r32 * 144 + hi * 8;
#pragma unroll
                    for (int s = 0; s < 4; ++s)
#pragma unroll
                        for (int db = 0; db < 4; ++db) { const v2u lo = *(const v2u*)(vb + db * 32 * 144 + s * 32), hi8 = *(const v2u*)(vb + db * 32 * 144 + s * 32 + 16);
                            v4u w; w.x = lo.x; w.y = lo.y; w.z = hi8.x; w.w = hi8.y;
                            o[db] = MFMA32(pk[s], __builtin_bit_cast(bf16x8, w), o[db]); }
                }
            }
            lsum += __shfl_xor(lsum, 32);
            __builtin_amdgcn_wave_barrier();
            if (hi == 0) fs[r32] = 1.f / lsum;
            __builtin_amdgcn_wave_barrier();
#pragma unroll
            for (int g = 0; g < 4; ++g) { const f32x4 ff = *(const f32x4*)(fs + 8 * g + 4 * hi); const float fv[4] = {ff.x, ff.y, ff.z, ff.w};
#pragma unroll
                for (int x = 0; x < 4; ++x) { const size_t row = (size_t)bb * SEQ + q0 + 8 * g + 4 * hi + x; float* dst = OATT + ((row * 4 + h) * 2 + mp) * 128 + r32;
#pragma unroll
                    for (int db = 0; db < 4; ++db) dst[db * 32] = o[db][4 * g + x] * fv[x]; } }
            __builtin_amdgcn_wave_barrier();
        }
    }
    __syncthreads();
}

__device__ __forceinline__ int afrag_off(int row, int k, int nks) { const int rt = row >> 5, r = row & 31, ks = k >> 4, kk = k & 15, h = (kk >> 2) & 1, j = ((kk >> 3) << 2) | (kk & 3); return ((rt * nks + ks) * 64 + r + 32 * h) * 8 + j; }
__device__ __forceinline__ int clay_off(int c, int dv) { const int rt = c >> 5, cc = c & 31, hi = (cc >> 2) & 1, i = ((cc >> 3) << 2) | (cc & 3), sl = dv >> 5, r32 = dv & 31; return ((rt * 4 + sl) * 64 + r32 + 32 * hi) * 16 + i; }
__device__ __forceinline__ void phase_gdn_local_v1(const Args& a, unsigned char* lds, int l, int wv_) {
    const bf16* P = (const bf16*)(a.ws + WS_PROJ); const float* BA = (const float*)(a.ws + WS_BA);
    bf16* GD = (bf16*)(a.ws + WS_REGD); float* GL = (float*)(a.ws + WS_GL);
    float* qs = (float*)lds; float* ks = qs + 64 * 129; float* vs = ks + 64 * 129; float* KKs = vs + 64 * 129; float* QKs = KKs + 64 * 65;
    float* beta = QKs + 64 * 65; float* gc = beta + 64;
    int tid_ = wv_ * 64 + mk_lane(); asm volatile("" : "+v"(tid_)); const int tid = tid_, lane = tid & 63, wave = tid >> 6;
    const float* cw = a.gdn_conv_w + (size_t)l * 4 * 1536;
    for (int unit = blockIdx.x; unit < NUNIT; unit += gridDim.x) {
        const int bb = unit >> 9, h = (unit >> 7) & 3, n = unit & 127;
        __syncthreads();
#pragma unroll 1
        for (int idx = tid; idx < 3 * 64 * 128; idx += NTHR) {
            const int mat = idx >> 13, rem = idx & 8191, t = rem >> 7, c = rem & 127, col = mat * 512 + h * 128 + c;
            float acc = 0.f;
#pragma unroll
            for (int j = 0; j < 4; ++j) { const int tt = n * 64 + t - 3 + j; if (tt >= 0) acc += cw[j * 1536 + col] * bf2f(P[((size_t)bb * SEQ + tt) * NP + col]); }
            (mat == 0 ? qs : mat == 1 ? ks : vs)[t * 129 + c] = siluf_(acc);
        }
        if (tid < 64) {
            const size_t row = (size_t)bb * SEQ + n * 64 + tid;
            beta[tid] = sigmoidf_(BA[row * 8 + h]);
            const float xx = BA[row * 8 + 4 + h] + a.gdn_dt_bias[l * 4 + h];
            const float sp = xx > 20.f ? xx : log1pf(__expf(xx));
            gc[tid] = -__expf(a.gdn_a_log[l * 4 + h]) * sp;
        }
        __syncthreads();
        if (tid == 0) { float run = 0.f;
#pragma unroll 1
            for (int c = 0; c < 64; ++c) { run += gc[c]; gc[c] = run; } }
        __syncthreads();
#pragma unroll 1
        for (int r = wave * 8; r < wave * 8 + 8; ++r) {
            { float x0 = qs[r * 129 + lane], x1 = qs[r * 129 + 64 + lane]; const float sc = rsqrtf(wave_sum(x0 * x0 + x1 * x1) + 1e-6f) * 0.08838834764831845f; qs[r * 129 + lane] = x0 * sc; qs[r * 129 + 64 + lane] = x1 * sc; }
            { float x0 = ks[r * 129 + lane], x1 = ks[r * 129 + 64 + lane]; const float sc = rsqrtf(wave_sum(x0 * x0 + x1 * x1) + 1e-6f); ks[r * 129 + lane] = x0 * sc; ks[r * 129 + 64 + lane] = x1 * sc; }
        }
        __syncthreads();
#pragma unroll 1
        for (int i = 0; i < 8; ++i) { const int idx = tid + NTHR * i, c = idx >> 6, s = idx & 63; float kk = 0.f, qk = 0.f;
#pragma unroll 4
            for (int d = 0; d < 128; ++d) { const float kv = ks[s * 129 + d]; kk += ks[c * 129 + d] * kv; qk += qs[c * 129 + d] * kv; }
            const float dec = (s <= c) ? __expf(gc[c] - gc[s]) : 0.f;
            KKs[c * 65 + s] = (s < c) ? kk * beta[c] * dec : 0.f; QKs[c * 65 + s] = qk * dec; }
        __syncthreads();
        const size_t ub = (size_t)unit * UREC;
        { const float gl = gc[63];
          for (int idx = tid; idx < 8192; idx += NTHR) { const int c = idx >> 7, d = idx & 127;
              GD[ub + R_QD + afrag_off(c, d, 8)] = (bf16)f2bf(qs[c * 129 + d] * __expf(gc[c])); GD[ub + R_KD + afrag_off(d, c, 4)] = (bf16)f2bf(ks[c * 129 + d] * __expf(gl - gc[c])); }
          for (int idx = tid; idx < 4096; idx += NTHR) { const int c = idx >> 6, s = idx & 63; GD[ub + R_QK + afrag_off(c, s, 4)] = (bf16)f2bf(QKs[c * 65 + s]); }
          if (tid == 0) GL[unit] = __expf(gl); }
        __syncthreads();
        for (int idx = tid; idx < 8192; idx += NTHR) { const int c = idx >> 7, d = idx & 127; vs[c * 129 + d] *= beta[c]; ks[c * 129 + d] *= beta[c] * __expf(gc[c]); }
        __syncthreads();
        if (tid < 256) {
            float* X = (tid < 128 ? vs : ks) + (tid & 127);
#pragma unroll 1
            for (int c = 1; c < 64; ++c) { float acc = X[c * 129]; const float* Ar = KKs + c * 65;
#pragma unroll 4
                for (int s = 0; s < c; ++s) acc -= Ar[s] * X[s * 129];
                X[c * 129] = acc; }
            if (tid < 128) { for (int c = 0; c < 64; ++c) GD[ub + R_U + clay_off(c, tid)] = (bf16)f2bf(X[c * 129]); }
            else { for (int c = 0; c < 64; ++c) GD[ub + R_W + afrag_off(c, tid - 128, 8)] = (bf16)f2bf(-X[c * 129]); }
        }
    }
    __syncthreads();
}

constexpr int GL_QB = 0, GL_KB = 17408, GL_VB = 34816, GL_AM = 52224, GL_QK = 69632, GL_XT = 78848, GL_BETA = 115712, GL_GC = 115968, GL_EGC = 116224;
template <int ROFF> __device__ __forceinline__ void tri_solve32(float (&x)[32], const float* Am) {
#pragma unroll
    for (int c = 1; c < 32; ++c) { int off = (ROFF + c) * 68 + ROFF;
        if (c >= 2) asm volatile("" : "+v"(off), "+v"(x[c - 2])); else asm volatile("" : "+v"(off));
        const float* ar = Am + off; float acc = x[c];
#pragma unroll
        for (int s4 = 0; s4 < c; s4 += 4) { const f32x4 av = *(const f32x4*)(ar + s4);
            acc -= av.x * x[s4]; if (s4 + 1 < c) acc -= av.y * x[s4 + 1]; if (s4 + 2 < c) acc -= av.z * x[s4 + 2]; if (s4 + 3 < c) acc -= av.w * x[s4 + 3]; }
        x[c] = acc; }
}
__device__ __forceinline__ void phase_gdn_local(const Args& a, unsigned char* lds, int l, int wv_) {
    const bf16* P = (const bf16*)(a.ws + WS_PROJ); const float* BA = (const float*)(a.ws + WS_BA);
    bf16* GD = (bf16*)(a.ws + WS_REGD); float* GL = (float*)(a.ws + WS_GL);
    bf16* qb = (bf16*)(lds + GL_QB); bf16* kb = (bf16*)(lds + GL_KB); bf16* vb = (bf16*)(lds + GL_VB); float* Am = (float*)(lds + GL_AM); bf16* QKb = (bf16*)(lds + GL_QK); bf16* XT = (bf16*)(lds + GL_XT);
    float* beta = (float*)(lds + GL_BETA); float* gc = (float*)(lds + GL_GC); float* egc = (float*)(lds + GL_EGC);
    const float* cwp = a.gdn_conv_w + (size_t)l * 4 * 1536;
#pragma unroll 1
    for (int unit = blockIdx.x; unit < NUNIT; unit += gridDim.x) {
        const int bb = unit >> 9, h = (unit >> 7) & 3, n = unit & 127;
        const size_t ub = (size_t)unit * UREC;
        __syncthreads();
        { const int tid = wv_ * 64 + mk_lane(), lane = tid & 63, r32 = lane & 31, hi = lane >> 5, wave = tid >> 6; (void)r32; (void)hi; (void)wave; (void)lane;
        if (tid < 384) {
            const int g = tid >> 4, cg = tid & 15, mat = g >> 3, tg = g & 7, col = mat * 512 + h * 128 + cg * 8;
            float cw[4][8];
#pragma unroll
            for (int j = 0; j < 4; ++j) { const f32x4 w0 = *(const f32x4*)(cwp + j * 1536 + col), w1 = *(const f32x4*)(cwp + j * 1536 + col + 4);
                cw[j][0] = w0.x; cw[j][1] = w0.y; cw[j][2] = w0.z; cw[j][3] = w0.w; cw[j][4] = w1.x; cw[j][5] = w1.y; cw[j][6] = w1.z; cw[j][7] = w1.w; }
            v4u in[11];
#pragma unroll
            for (int r = 0; r < 11; ++r) { const int tt = n * 64 + tg * 8 - 3 + r; in[r] = (v4u){0u, 0u, 0u, 0u}; if (tt >= 0) in[r] = *(const v4u*)(P + ((size_t)bb * SEQ + tt) * NP + col); }
            bf16* dstm = (mat == 0 ? qb : mat == 1 ? kb : vb) + cg * 8;
#pragma unroll
            for (int i = 0; i < 8; ++i) { float o[8];
#pragma unroll
                for (int e = 0; e < 8; ++e) o[e] = 0.f;
#pragma unroll
                for (int j = 0; j < 4; ++j) { const v4u w = in[i + j]; const float f[8] = {bflo(w.x), bfhi(w.x), bflo(w.y), bfhi(w.y), bflo(w.z), bfhi(w.z), bflo(w.w), bfhi(w.w)};
#pragma unroll
                    for (int e = 0; e < 8; ++e) o[e] += cw[j][e] * f[e]; }
                float ss = 0.f;
#pragma unroll
                for (int e = 0; e < 8; ++e) { o[e] = siluf_(o[e]); ss += o[e] * o[e]; }
                ss += __shfl_xor(ss, 1); ss += __shfl_xor(ss, 2); ss += __shfl_xor(ss, 4); ss += __shfl_xor(ss, 8);
                const float sc = mat == 2 ? 1.f : rsqrtf(ss + 1e-6f) * (mat == 0 ? 0.08838834764831845f : 1.f);
#pragma unroll
                for (int e = 0; e < 8; ++e) o[e] *= sc;
                st8(dstm + (tg * 8 + i) * 136, o); }
        } else if (tid < 448) {
            const int t = tid - 384; const size_t row = (size_t)bb * SEQ + n * 64 + t;
            beta[t] = sigmoidf_(BA[row * 8 + h]);
            const float xx = BA[row * 8 + 4 + h] + a.gdn_dt_bias[l * 4 + h];
            const float sp = xx > 20.f ? xx : log1pf(__expf(xx));
            float gv = -__expf(a.gdn_a_log[l * 4 + h]) * sp;
#pragma unroll
            for (int o = 1; o < 64; o <<= 1) { const float v = __shfl_up(gv, o); if (t >= o) gv += v; }
            gc[t] = gv; egc[t] = __expf(gv);
        }
        }
        __syncthreads();
        { const int tid = wv_ * 64 + mk_lane(), lane = tid & 63, r32 = lane & 31, hi = lane >> 5, wave = tid >> 6; (void)r32; (void)hi; (void)wave; (void)lane;
        { const int mat = wave >> 2, rt = (wave >> 1) & 1, ct = wave & 1;
          if (mat == 1 || !(rt == 0 && ct == 1)) {
            f32x16 acc;
#pragma unroll
            for (int r = 0; r < 16; ++r) acc[r] = 0.f;
            const bf16* Ab = (mat == 0 ? kb : qb) + (32 * rt + r32) * 136 + 8 * hi; const bf16* Bb = kb + (32 * ct + r32) * 136 + 8 * hi;
            if (!(rt == 0 && ct == 1)) {
#pragma unroll
                for (int ks = 0; ks < 8; ++ks) acc = MFMA32(*(const bf16x8*)(Ab + 16 * ks), *(const bf16x8*)(Bb + 16 * ks), acc);
            }
            const int s = 32 * ct + r32; const float gs = gc[s];
#pragma unroll
            for (int i = 0; i < 16; ++i) { const int c = 32 * rt + crow(i, hi); const float dec = (s <= c) ? __expf(gc[c] - gs) : 0.f;
                if (mat == 0) Am[c * 68 + s] = (s < c) ? acc[i] * beta[c] * dec : 0.f;
                else QKb[c * 72 + s] = (bf16)f2bf(acc[i] * dec); }
          } }
        }
        __syncthreads();
        { const int tid = wv_ * 64 + mk_lane(), lane = tid & 63, r32 = lane & 31, hi = lane >> 5, wave = tid >> 6; (void)r32; (void)hi; (void)wave; (void)lane;
        if (tid < 256) {
            const int col = tid; float x[32];
#pragma unroll
            for (int c = 0; c < 32; ++c) x[c] = (col < 128) ? bf2f(vb[c * 136 + col]) * beta[c] : bf2f(kb[c * 136 + col - 128]) * beta[c] * egc[c];
            tri_solve32<0>(x, Am);
#pragma unroll
            for (int c = 0; c < 32; c += 8) st8(XT + col * 72 + c, x + c);
        } else {
            const int lt = tid - 256; const float gl = gc[63];
#pragma unroll 1
            for (int q = 0; q < 4; ++q) { const int item = lt + 256 * q, f = item >> 6, ln = item & 63, r = ln & 31, hh = ln >> 5;
                { const int rt = f >> 3, ks = f & 7, c = 32 * rt + r; const float e = egc[c]; const bf16* sp = qb + c * 136 + 16 * ks + 4 * hh;
                  const v2u lo = *(const v2u*)sp, hi8 = *(const v2u*)(sp + 8); v4u w;
                  w.x = pk2(bflo(lo.x) * e, bfhi(lo.x) * e); w.y = pk2(bflo(lo.y) * e, bfhi(lo.y) * e); w.z = pk2(bflo(hi8.x) * e, bfhi(hi8.x) * e); w.w = pk2(bflo(hi8.y) * e, bfhi(hi8.y) * e);
                  *(v4u*)(GD + ub + R_QD + item * 8) = w; }
                { const int rt = f >> 2, ks = f & 3, dk = 32 * rt + r; float v[8];
#pragma unroll
                  for (int j = 0; j < 8; ++j) { const int c = 16 * ks + 8 * (j >> 2) + 4 * hh + (j & 3); v[j] = bf2f(kb[c * 136 + dk]) * __expf(gl - gc[c]); }
                  st8(GD + ub + R_KD + item * 8, v); } }
#pragma unroll 1
            for (int q = 0; q < 2; ++q) { const int item = lt + 256 * q, f = item >> 6, ln = item & 63, r = ln & 31, hh = ln >> 5, rt = f >> 2, ks = f & 3, c = 32 * rt + r;
                const bf16* sp = QKb + c * 72 + 16 * ks + 4 * hh; const v2u lo = *(const v2u*)sp, hi8 = *(const v2u*)(sp + 8); v4u w; w.x = lo.x; w.y = lo.y; w.z = hi8.x; w.w = hi8.y;
                *(v4u*)(GD + ub + R_QK + item * 8) = w; }
            if (lt == 0) GL[unit] = __expf(gl);
        }
        }
        __syncthreads();
        { const int tid = wv_ * 64 + mk_lane(), lane = tid & 63, r32 = lane & 31, hi = lane >> 5, wave = tid >> 6; (void)r32; (void)hi; (void)wave; (void)lane;
        { const int col = 32 * wave + r32; f32x16 acc;
#pragma unroll
          for (int i = 0; i < 16; ++i) { const int c = 32 + crow(i, hi); acc[i] = (col < 128) ? bf2f(vb[c * 136 + col]) * beta[c] : bf2f(kb[c * 136 + col - 128]) * beta[c] * egc[c]; }
#pragma unroll
          for (int ks = 0; ks < 2; ++ks) { const float* ap = Am + (32 + r32) * 68 + 16 * ks + 8 * hi; const f32x4 a0 = *(const f32x4*)ap, a1 = *(const f32x4*)(ap + 4);
              v4u w; w.x = cvtpk(-a0.x, -a0.y); w.y = cvtpk(-a0.z, -a0.w); w.z = cvtpk(-a1.x, -a1.y); w.w = cvtpk(-a1.z, -a1.w);
              acc = MFMA32(__builtin_bit_cast(bf16x8, w), *(const bf16x8*)(XT + col * 72 + 16 * ks + 8 * hi), acc); }
#pragma unroll
          for (int g = 0; g < 4; ++g) { v2u w; w.x = cvtpk(acc[4 * g], acc[4 * g + 1]); w.y = cvtpk(acc[4 * g + 2], acc[4 * g + 3]); *(v2u*)(XT + col * 72 + 32 + 8 * g + 4 * hi) = w; } }
        }
        __syncthreads();
        { const int tid = wv_ * 64 + mk_lane(), lane = tid & 63, r32 = lane & 31, hi = lane >> 5, wave = tid >> 6; (void)r32; (void)hi; (void)wave; (void)lane;
        if (tid < 256) {
            const int col = tid; float x[32];
#pragma unroll
            for (int c = 0; c < 32; c += 8) ld8(XT + col * 72 + 32 + c, x + c);
            tri_solve32<32>(x, Am);
#pragma unroll
            for (int c = 0; c < 32; c += 8) st8(XT + col * 72 + 32 + c, x + c);
        }
        }
        __syncthreads();
        { const int tid = wv_ * 64 + mk_lane(), lane = tid & 63, r32 = lane & 31, hi = lane >> 5, wave = tid >> 6; (void)r32; (void)hi; (void)wave; (void)lane;
        { const int item = tid, tile = item >> 6, ln = item & 63, rr = ln & 31, hh = ln >> 5, rt = tile >> 2, sl = tile & 3, dv = sl * 32 + rr;
          const bf16* xp = XT + dv * 72 + 32 * rt + 4 * hh; const v2u g0 = *(const v2u*)xp, g1 = *(const v2u*)(xp + 8), g2 = *(const v2u*)(xp + 16), g3 = *(const v2u*)(xp + 24);
          v4u w0, w1; w0.x = g0.x; w0.y = g0.y; w0.z = g1.x; w0.w = g1.y; w1.x = g2.x; w1.y = g2.y; w1.z = g3.x; w1.w = g3.y;
          *(v4u*)(GD + ub + R_U + item * 16) = w0; *(v4u*)(GD + ub + R_U + item * 16 + 8) = w1; }
#pragma unroll 1
        for (int q = 0; q < 2; ++q) { const int item = tid + 512 * q, f = item >> 6, ln = item & 63, r = ln & 31, hh = ln >> 5, rt = f >> 3, ks = f & 7, c = 32 * rt + r;
            unsigned short v[8];
#pragma unroll
            for (int j = 0; j < 8; ++j) { const int kc = 16 * ks + 8 * (j >> 2) + 4 * hh + (j & 3); v[j] = XT[(128 + kc) * 72 + c] ^ 0x8000u; }
            v4u w; w.x = v[0] | ((unsigned)v[1] << 16); w.y = v[2] | ((unsigned)v[3] << 16); w.z = v[4] | ((unsigned)v[5] << 16); w.w = v[6] | ((unsigned)v[7] << 16);
            *(v4u*)(GD + ub + R_W + item * 8) = w; }
        }
    }
    __syncthreads();
}

constexpr int SC_WN = 0, SC_QD = 16384, SC_KDT = 32768, SC_QK = 49152, SC_U = 57344, SC_GL = 61440, SC_BUF = 61504;
__device__ __forceinline__ bf16x8 pack8(const f32x16& x, int s) { v4u w; w.x = cvtpk(x[8 * s], x[8 * s + 1]); w.y = cvtpk(x[8 * s + 2], x[8 * s + 3]); w.z = cvtpk(x[8 * s + 4], x[8 * s + 5]); w.w = cvtpk(x[8 * s + 6], x[8 * s + 7]); return __builtin_bit_cast(bf16x8, w); }
__device__ __forceinline__ void phase_gdn_scan(const Args& a, unsigned char* lds, int l, int wv_) {
    const bf16* GD = (const bf16*)(a.ws + WS_REGD); const float* GL = (const float*)(a.ws + WS_GL); float* OG = (float*)(a.ws + WS_REGB);
    int tid_ = wv_ * 64 + mk_lane(); asm volatile("" : "+v"(tid_)); const int tid = tid_, lane = tid & 63, r32 = lane & 31, hi = lane >> 5, wave = tid >> 6;
#pragma unroll 1
    for (int job = blockIdx.x; job < 32; job += gridDim.x) {
        const int bh = job >> 2, sl = job & 3, bb = bh >> 2, h = bh & 3;
        f32x16 S[4];
#pragma unroll
        for (int b4 = 0; b4 < 4; ++b4)
#pragma unroll
            for (int r = 0; r < 16; ++r) S[b4][r] = 0.f;
        __syncthreads();
#pragma unroll 1
        for (int n = -1; n < 128; ++n) {
            if (wave != 0 && n + 1 < 128) {
                const int unit = bh * 128 + n + 1; unsigned char* dstb = lds + ((n + 1) & 1) * SC_BUF + (tid - 64) * 16;
                const unsigned char* rec = (const unsigned char*)(GD + (size_t)unit * UREC) + (tid - 64) * 16;
                v4u lr[9];
#pragma unroll
                for (int q = 0; q < 8; ++q) lr[q] = *(const v4u*)(rec + q * 7168);
                const int lt = tid - 64; const bool hasu = lt < 256;
                if (hasu) lr[8] = *(const v4u*)((const unsigned char*)(GD + (size_t)unit * UREC + R_U) + ((lt >> 7) * 512 + sl * 128 + (lt & 127)) * 16);
#pragma unroll
                for (int q = 0; q < 8; ++q) *(v4u*)(dstb + q * 7168) = lr[q];
                if (hasu) *(v4u*)(dstb + 8 * 7168) = lr[8];
                dstb -= (tid - 64) * 16;
                if (tid == 64) *(float*)(dstb + SC_GL) = GL[unit];
            }
            if (wave == 0 && n >= 0) {
                const unsigned char* base = lds + (n & 1) * SC_BUF;
#define SFRAG(off, f) (*(const bf16x8*)(base + (off) + (f) * 1024 + lane * 16))
                bf16x8 Spk[8];
#pragma unroll
                for (int ks = 0; ks < 8; ++ks) Spk[ks] = pack8(S[ks >> 1], ks & 1);
                f32x16 Vn[2];
#pragma unroll
                for (int rt = 0; rt < 2; ++rt) { const v4u u0 = *(const v4u*)(base + SC_U + (rt * 64 + lane) * 32), u1 = *(const v4u*)(base + SC_U + (rt * 64 + lane) * 32 + 16);
                    const unsigned uw[8] = {u0.x, u0.y, u0.z, u0.w, u1.x, u1.y, u1.z, u1.w};
#pragma unroll
                    for (int x = 0; x < 8; ++x) { Vn[rt][2 * x] = bflo(uw[x]); Vn[rt][2 * x + 1] = bfhi(uw[x]); }
#pragma unroll
                    for (int ks = 0; ks < 8; ++ks) Vn[rt] = MFMA32(SFRAG(SC_WN, rt * 8 + ks), Spk[ks], Vn[rt]); }
                bf16x8 Vpk[4];
#pragma unroll
                for (int ks = 0; ks < 4; ++ks) Vpk[ks] = pack8(Vn[ks >> 1], ks & 1);
#pragma unroll
                for (int rt = 0; rt < 2; ++rt) { f32x16 O;
#pragma unroll
                    for (int r = 0; r < 16; ++r) O[r] = 0.f;
#pragma unroll
                    for (int ks = 0; ks < 8; ++ks) O = MFMA32(SFRAG(SC_QD, rt * 8 + ks), Spk[ks], O);
#pragma unroll
                    for (int ks = 0; ks < 4; ++ks) O = MFMA32(SFRAG(SC_QK, rt * 4 + ks), Vpk[ks], O);
                    float* op = OG + ((size_t)bb * SEQ + n * 64 + rt * 32) * BW + h * 128 + sl * 32 + r32;
#pragma unroll
                    for (int i = 0; i < 16; ++i) op[(size_t)crow(i, hi) * BW] = O[i]; }
                const float g = *(const float*)(base + SC_GL);
#pragma unroll
                for (int b4 = 0; b4 < 4; ++b4) {
#pragma unroll
                    for (int r = 0; r < 16; ++r) S[b4][r] *= g;
#pragma unroll
                    for (int ks = 0; ks < 4; ++ks) S[b4] = MFMA32(SFRAG(SC_KDT, b4 * 4 + ks), Vpk[ks], S[b4]); }
#undef SFRAG
            }
            __syncthreads();
        }
    }
    __syncthreads();
}

__device__ __forceinline__ void phase_finalize(const Args& a, int l, int wv_) {
    const bf16* P = (const bf16*)(a.ws + WS_PROJ); const float* OG = (const float*)(a.ws + WS_REGB); const float* OATT = (const float*)(a.ws + WS_REGC);
    bf16* Y = (bf16*)(a.ws + WS_REGD);
    int tid_ = wv_ * 64 + mk_lane(); asm volatile("" : "+v"(tid_)); const int tid = tid_, lane = tid & 63, wave = tid >> 6;
    const int gw = blockIdx.x * NWAVES + wave, NGW = gridDim.x * NWAVES;
    const float lam_init = 0.8f - 0.6f * expf(-0.3f * (float)l);
    const float* lv = a.diff_lambda + (size_t)l * 256;
    const float lam = expf(wave_sum(lv[lane] * lv[64 + lane])) - expf(wave_sum(lv[128 + lane] * lv[192 + lane])) + lam_init;
    const int e0 = (lane & 15) * 8, hh = lane >> 4, c0 = lane * 8;
    float gnw[8], dnw[8], scw[3][8];
#pragma unroll
    for (int j = 0; j < 8; ++j) { gnw[j] = a.gdn_norm_w[l * 128 + e0 + j]; dnw[j] = a.diff_norm_w[l * 128 + e0 + j] * (1.f - lam_init);
#pragma unroll
        for (int k = 0; k < 3; ++k) scw[k][j] = a.sc_conv_w[((size_t)l * 3 + k) * BW + c0 + j]; }
    for (int row = gw; row < M; row += NGW) {
        const int t = row & (SEQ - 1);
        const bf16* pr = P + (size_t)row * NP;
        float y[8], z[8];
        { const f32x4 o0 = *(const f32x4*)(OG + (size_t)row * BW + c0), o1 = *(const f32x4*)(OG + (size_t)row * BW + c0 + 4);
          float o[8] = {o0.x, o0.y, o0.z, o0.w, o1.x, o1.y, o1.z, o1.w}; float ss = 0.f;
#pragma unroll
          for (int j = 0; j < 8; ++j) ss += o[j] * o[j];
          ss += __shfl_xor(ss, 1); ss += __shfl_xor(ss, 2); ss += __shfl_xor(ss, 4); ss += __shfl_xor(ss, 8);
          const float rs = rsqrtf(ss * (1.f / 128.f) + EPS); ld8(pr + C_GZ + c0, z);
#pragma unroll
          for (int j = 0; j < 8; ++j) y[j] = o[j] * rs * gnw[j] * siluf_(z[j]);
          st8(Y + (size_t)row * BW + c0, y); }
        { const float* op = OATT + (((size_t)row * 4 + hh) * 2) * 128 + e0;
          const f32x4 a0 = *(const f32x4*)op, a1 = *(const f32x4*)(op + 4), b0 = *(const f32x4*)(op + 128), b1 = *(const f32x4*)(op + 132);
          float d[8] = {a0.x - lam * b0.x, a0.y - lam * b0.y, a0.z - lam * b0.z, a0.w - lam * b0.w, a1.x - lam * b1.x, a1.y - lam * b1.y, a1.z - lam * b1.z, a1.w - lam * b1.w}; float ss = 0.f;
#pragma unroll
          for (int j = 0; j < 8; ++j) ss += d[j] * d[j];
          ss += __shfl_xor(ss, 1); ss += __shfl_xor(ss, 2); ss += __shfl_xor(ss, 4); ss += __shfl_xor(ss, 8);
          const float rs = rsqrtf(ss * (1.f / 128.f) + EPS); ld8(pr + C_DZ + c0, z);
#pragma unroll
          for (int j = 0; j < 8; ++j) y[j] = d[j] * rs * dnw[j] * siluf_(z[j]);
          st8(Y + (size_t)M * BW + (size_t)row * BW + c0, y); }
        { float acc[8];
#pragma unroll
          for (int j = 0; j < 8; ++j) acc[j] = 0.f;
#pragma unroll
          for (int k = 0; k < 3; ++k) { const int tt = t - 2 + k; if (tt >= 0) { float cc[8], xx[8]; const bf16* p2 = P + (size_t)(row - 2 + k) * NP; ld8(p2 + C_SC + c0, cc); ld8(p2 + C_SX + c0, xx);
#pragma unroll
              for (int j = 0; j < 8; ++j) acc[j] += scw[k][j] * (cc[j] * xx[j]); } }
          float sb[8]; ld8(pr + C_SB + c0, sb); ld8(pr + C_SZ + c0, z);
#pragma unroll
          for (int j = 0; j < 8; ++j) y[j] = sb[j] * acc[j] * siluf_(z[j]);
          st8(Y + 2 * (size_t)M * BW + (size_t)row * BW + c0, y); }
    }
}

__device__ __forceinline__ void phase_postnorm(const Args& a, int l, int wv_) {
    const float* OUT = (const float*)(a.ws + WS_REGC); bf16* H = (bf16*)(a.ws + WS_REGB);
    const float* xin = (l == 0) ? a.x : a.out;
    int tid_ = wv_ * 64 + mk_lane(); asm volatile("" : "+v"(tid_)); const int tid = tid_, lane = tid & 63, wave = tid >> 6;
    const int gw = blockIdx.x * NWAVES + wave, NGW = gridDim.x * NWAVES;
    const float* wpost = a.norm_post + (size_t)l * DM; const float* wpre = a.norm_pre + (size_t)(l + 1 < DEPTH ? l + 1 : l) * DM;
    for (int row = gw; row < M; row += NGW) {
        f32x4 o[4], x[4]; float s = 0.f;
#pragma unroll
        for (int j = 0; j < 4; ++j) { o[j] = *(const f32x4*)(OUT + (size_t)row * DM + 4 * lane + 256 * j); x[j] = *(const f32x4*)(xin + (size_t)row * DM + 4 * lane + 256 * j);
            s += (o[j].x * o[j].x + o[j].y * o[j].y) + (o[j].z * o[j].z + o[j].w * o[j].w); }
        const float rs = rsqrtf(wave_sum(s) * (1.f / DM) + EPS); float s2 = 0.f;
#pragma unroll
        for (int j = 0; j < 4; ++j) { const f32x4 w = *(const f32x4*)(wpost + 4 * lane + 256 * j); x[j] = x[j] + o[j] * rs * w; *(f32x4*)(a.out + (size_t)row * DM + 4 * lane + 256 * j) = x[j];
            s2 += (x[j].x * x[j].x + x[j].y * x[j].y) + (x[j].z * x[j].z + x[j].w * x[j].w); }
        if (l + 1 < DEPTH) { const float rs2 = rsqrtf(wave_sum(s2) * (1.f / DM) + EPS);
#pragma unroll
            for (int j = 0; j < 4; ++j) { const f32x4 w = *(const f32x4*)(wpre + 4 * lane + 256 * j); v2u ob; ob.x = pk2(x[j].x * rs2 * w.x, x[j].y * rs2 * w.y); ob.y = pk2(x[j].z * rs2 * w.z, x[j].w * rs2 * w.w);
                *(v2u*)(H + (size_t)row * DM + 4 * lane + 256 * j) = ob; } }
    }
}

constexpr int ARGS_OFF = 143360;
constexpr int ARGS_WORDS = (int)(sizeof(Args) / 4);
#ifndef PROBE_SEL
#define PROBE_SEL -1
#endif
constexpr int TS_OFF = ARGS_OFF + 512;
__device__ __forceinline__ void ts_mark(unsigned char* lds, int k) {
    if (PROBE_SEL >= 0 && blockIdx.x == 0 && threadIdx.x == 0) { volatile LAS unsigned long long* p = (volatile LAS unsigned long long*)((LAS unsigned char*)lds + TS_OFF);
        const unsigned long long t = __builtin_amdgcn_s_memrealtime(); p[1 + k] += t - p[0]; p[0] = t; }
}
__device__ __forceinline__ void load_args(Args& b, unsigned char* lds) {
    volatile LAS unsigned* s = (volatile LAS unsigned*)((LAS unsigned char*)lds + ARGS_OFF); unsigned w[ARGS_WORDS];
#pragma unroll
    for (int i = 0; i < ARGS_WORDS; ++i) w[i] = (unsigned)__builtin_amdgcn_readfirstlane((int)s[i]);
    __builtin_memcpy(&b, w, sizeof(Args));
}
template <int L> __device__ __forceinline__ void run_layer(unsigned char* lds, cg::grid_group& grid, int wv) {
    PG8_LAS unsigned char* lds3 = (PG8_LAS unsigned char*)lds;
    constexpr int l = L;
    {
        Args a; load_args(a, lds); const int G = gridDim.x;
        bf16* WIN = (bf16*)(a.ws + WS_WIN); bf16* PROJ = (bf16*)(a.ws + WS_PROJ); float* BA = (float*)(a.ws + WS_BA); bf16* REGB = (bf16*)(a.ws + WS_REGB);
        pg8::Gemm g{REGB, WIN + (size_t)l * WIN_L, M, NPAD, DM}; pg8::StaticOrder S; S.init(M, NPAD, G, (int)blockIdx.x);
        EpiProj E{PROJ, BA};
        pg8::gemm_phase<EpiProj, pg8::StaticOrder, true, true>(lds3, g, S, E, wv);
    }
    grid.sync();
    ts_mark(lds, 1);
    { Args a; load_args(a, lds); phase_gdn_local(a, lds, l, wv); }
    grid.sync();
    ts_mark(lds, 2);
    { Args a; load_args(a, lds); phase_gdn_scan(a, lds, l, wv); }
    ts_mark(lds, 4);
    { Args a; load_args(a, lds); phase_attn(a, lds, l, wv); }
    grid.sync();
    ts_mark(lds, 3);
    { Args a; load_args(a, lds); phase_finalize(a, l, wv); }
    grid.sync();
    ts_mark(lds, 5);
    {
        Args a; load_args(a, lds); const int G = gridDim.x;
        bf16* WBR = (bf16*)(a.ws + WS_WBR); bf16* PROJ = (bf16*)(a.ws + WS_PROJ); bf16* REGB = (bf16*)(a.ws + WS_REGB); float* REGC = (float*)(a.ws + WS_REGC); bf16* Y = (bf16*)(a.ws + WS_REGD);
        pg8::StaticOrder S; S.init(M, DM, G, (int)blockIdx.x);
        { pg8::Gemm g{Y, WBR + ((size_t)l * 3 + 0) * DM * BW, M, DM, BW}; EpiBranch<0> E{PROJ, REGC, REGB}; pg8::gemm_phase<EpiBranch<0>, pg8::StaticOrder, true, true>(lds3, g, S, E, wv); }
        { pg8::Gemm g{Y + (size_t)M * BW, WBR + ((size_t)l * 3 + 1) * DM * BW, M, DM, BW}; EpiBranch<1> E{PROJ, REGC, REGB}; pg8::gemm_phase<EpiBranch<1>, pg8::StaticOrder, true, true>(lds3, g, S, E, wv); }
        { pg8::Gemm g{Y + 2 * (size_t)M * BW, WBR + ((size_t)l * 3 + 2) * DM * BW, M, DM, BW}; EpiBranch<2> E{PROJ, REGC, REGB}; pg8::gemm_phase<EpiBranch<2>, pg8::StaticOrder, true, true>(lds3, g, S, E, wv); }
    }
    grid.sync();
    ts_mark(lds, 6);
    {
        Args a; load_args(a, lds); const int G = gridDim.x;
        bf16* WOUT = (bf16*)(a.ws + WS_WOUT); bf16* REGB = (bf16*)(a.ws + WS_REGB); float* REGC = (float*)(a.ws + WS_REGC);
        pg8::Gemm g{REGB, WOUT + (size_t)l * DM * DM, M, DM, DM}; pg8::StaticOrder S; S.init(M, DM, G, (int)blockIdx.x);
        EpiOutF32 E{REGC};
        pg8::gemm_phase<EpiOutF32, pg8::StaticOrder, true, true>(lds3, g, S, E, wv);
    }
    grid.sync();
    ts_mark(lds, 7);
    { Args a; load_args(a, lds); phase_postnorm(a, l, wv); }
    if (L + 1 < DEPTH) grid.sync();
    ts_mark(lds, 8);
}
__global__ void __launch_bounds__(NTHR, 2) fwd(Args a0) {
    extern __shared__ __attribute__((aligned(16))) unsigned char lds[];
    cg::grid_group grid = cg::this_grid();
    const int wv = __builtin_amdgcn_readfirstlane((int)threadIdx.x >> 6);
    if (threadIdx.x == 0) { unsigned w[ARGS_WORDS]; __builtin_memcpy(w, &a0, sizeof(Args));
#pragma unroll
        for (int i = 0; i < ARGS_WORDS; ++i) ((volatile LAS unsigned*)((LAS unsigned char*)lds + ARGS_OFF))[i] = w[i]; }
    if (PROBE_SEL >= 0 && threadIdx.x == 0) { volatile LAS unsigned long long* p = (volatile LAS unsigned long long*)((LAS unsigned char*)lds + TS_OFF); for (int i = 1; i < 17; ++i) p[i] = 0; p[0] = __builtin_amdgcn_s_memrealtime(); }
    __syncthreads();
    { Args a; load_args(a, lds); phase_prologue(a, lds, wv); }
    grid.sync();
    ts_mark(lds, 0);
    run_layer<0>(lds, grid, wv);
    run_layer<1>(lds, grid, wv);
    run_layer<2>(lds, grid, wv);
    run_layer<3>(lds, grid, wv);
    if (PROBE_SEL >= 0 && blockIdx.x == 0 && threadIdx.x == 0) { volatile LAS unsigned long long* p = (volatile LAS unsigned long long*)((LAS unsigned char*)lds + TS_OFF);
        Args a; load_args(a, lds); a.out[0] = floorf((float)p[1 + PROBE_SEL] * 0.01f * 0.02f + 0.5f) * 50.f; }
}

extern "C" void kernel_launch(void* const* d_in, const int* in_sizes, int n_in, void* d_out, int out_size, void* d_ws, size_t ws_size, hipStream_t stream) {
    static int grid = 0;
    if (grid == 0) {
        if (n_in != 13 || ws_size < WS_END) { fprintf(stderr, "kernel_launch: unexpected n_in %d or ws %zu\n", n_in, ws_size); grid = -1; return; }
        int dev = 0, cus = 0, per_cu = 0;
        hipGetDevice(&dev); hipDeviceGetAttribute(&cus, hipDeviceAttributeMultiprocessorCount, dev);
        hipFuncSetAttribute((const void*)fwd, hipFuncAttributeMaxDynamicSharedMemorySize, LDS_BYTES);
        hipOccupancyMaxActiveBlocksPerMultiprocessor(&per_cu, (const void*)fwd, NTHR, LDS_BYTES);
        (void)hipGetLastError();
        if (per_cu < 1) { fprintf(stderr, "kernel_launch: occupancy query says %d\n", per_cu); per_cu = 1; }
        grid = cus;
    }
    if (grid < 0) return;
    Args a{};
    a.x = (const float*)d_in[0]; a.norm_pre = (const float*)d_in[1]; a.norm_post = (const float*)d_in[2]; a.w_in = (const float*)d_in[3]; a.gdn_conv_w = (const float*)d_in[4];
    a.gdn_a_log = (const float*)d_in[5]; a.gdn_dt_bias = (const float*)d_in[6]; a.gdn_norm_w = (const float*)d_in[7]; a.diff_lambda = (const float*)d_in[8]; a.diff_norm_w = (const float*)d_in[9];
    a.sc_conv_w = (const float*)d_in[10]; a.w_branch = (const float*)d_in[11]; a.w_out = (const float*)d_in[12];
    a.out = (float*)d_out; a.ws = (unsigned char*)d_ws; a.ph_lo = 0; a.ph_hi = 0; a.coop = 1; a.pad = 0;
    void* args[] = {&a};
    hipError_t e = hipLaunchCooperativeKernel((const void*)fwd, dim3(grid), dim3(NTHR), args, LDS_BYTES, stream);
    if (e != hipSuccess) fprintf(stderr, "cooperative launch failed: %s (grid %d)\n", hipGetErrorString(e), grid);
}
```

```cpp
#include <hip/hip_runtime.h>
#include <hip/hip_cooperative_groups.h>
#include <cstdio>
#include <cstdint>
namespace cg = cooperative_groups;
__device__ __forceinline__ int mk_lane() { int r; asm volatile("v_mbcnt_lo_u32_b32 %0, -1, 0\n\tv_mbcnt_hi_u32_b32 %0, -1, %0" : "=v"(r)); return r; }
namespace pg8 {
#define PG8_LAS __attribute__((address_space(3)))
typedef unsigned short bf16_t;
typedef short bf16x8 __attribute__((ext_vector_type(8)));
typedef float f32x4 __attribute__((ext_vector_type(4)));
typedef unsigned u32x4 __attribute__((ext_vector_type(4)));
constexpr int BM = 256, BK = 64, HALF = 128, HTB = HALF * BK * 2  , STAGE_BYTES = 8 * HTB, NXCD = 8, WGM = 8;

__host__ __device__ __forceinline__ int lds_byte(int r, int c) { const int st = (r >> 4) * 2 + (c >> 5), rr = r & 15, cc = c & 31, ob = rr * 64 + cc * 2; return st * 1024 + (ob ^ (((ob >> 9) & 1) << 5)); }
__host__ __device__ __forceinline__ void stage_rc(int b, int& R, int& C) { const int st = b / 1024, sb = b % 1024, swz = sb ^ (((sb >> 9) & 1) << 5); R = (st >> 1) * 16 + swz / 64; C = (st & 1) * 32 + (swz % 64) / 2; }
__host__ __device__ __forceinline__ int perm32(int rho) { const int n = rho >> 4, i = rho & 15; return 8 * (i >> 2) + 4 * n + (i & 3); }

struct Unit { int pm, pn; };
struct Gemm { const bf16_t* A; const bf16_t* Bt; int M, N, K; };

struct StaticOrder {
    int nM, nN, nwg, G, c;
    __host__ __device__ void init(int M, int N, int G_, int c_) { nM = M / BM; nN = N / BM; nwg = nM * nN; G = G_; c = c_; }
    __host__ __device__ bool next(int i, Unit& u) const {
        const long L = (long)i * G + c; if (L >= nwg) return false;
        int wgid = (int)L; { const int q = nwg / NXCD, r = nwg % NXCD, xcd = wgid % NXCD, off = wgid / NXCD; wgid = (xcd < r ? xcd * (q + 1) : r * (q + 1) + (xcd - r) * q) + off; }
        const int nig = WGM * nN, gid = wgid / nig, fm = gid * WGM, gsz = (nM - fm) < WGM ? (nM - fm) : WGM;
        u.pm = fm + ((wgid % nig) % gsz); u.pn = (wgid % nig) / gsz; return true;
    }
    __device__ __forceinline__ void a_ready(const Unit&) const {}
    __device__ __forceinline__ void done(const Unit&) const {}
};
__device__ __forceinline__ unsigned cvt_pk_bf16(float lo, float hi) { unsigned r; asm volatile("v_cvt_pk_bf16_f32 %0, %1, %2" : "=v"(r) : "v"(lo), "v"(hi)); return r; }
typedef float f32x2 __attribute__((ext_vector_type(2)));
template <class Epi, class Sched, bool ALIGN_EPI = false, bool SP2 = false>
__device__ __forceinline__ void gemm_phase(PG8_LAS unsigned char* lds, const Gemm g, const Sched& S, const Epi& E, int wv_) {
    int tid_ = wv_ * 64 + mk_lane(); asm volatile("" : "+v"(tid_)); const int tid = tid_, wid = __builtin_amdgcn_readfirstlane(tid >> 6), lane = tid & 63, wr = wid >> 2, wc = wid & 3, fr = lane & 15, fq = lane >> 4;
    const int K = g.K, nt = K / BK;
    unsigned voffA[2], voffB[2];
#pragma unroll
    for (int i = 0; i < 2; ++i) { int R, C; stage_rc(tid * 16 + i * 8192, R, C); const int Rb = Epi::PERM ? ((R & ~31) + perm32(R & 31)) : R;
        voffA[i] = (unsigned)(R * K + C) * 2u; voffB[i] = (unsigned)(Rb * K + C) * 2u; }
    const size_t kstep = (size_t)(BK * 2);
    const size_t hstep = (size_t)HALF * K * 2;
    const size_t tstep = 2 * hstep;
    const unsigned ldsw = (unsigned)wid * 1024u;
    const int aoff = lds_byte(wr * 64 + fr, fq * 8), boff = lds_byte(wc * 32 + fr, fq * 8);
#define PG8_SA(b, h) (((b) * 2 + (h)) * HTB)
#define PG8_SB(b, h) ((4 + (b) * 2 + (h)) * HTB)
#define PG8_STAGE(bufoff, gbase, voff) do { _Pragma("unroll") for (int _i = 0; _i < 2; ++_i) \
        __builtin_amdgcn_global_load_lds((const unsigned*)((const char*)(gbase) + (voff)[_i]), (PG8_LAS unsigned*)(lds + (bufoff) + ldsw + _i * 8192), 16, 0, 0); } while (0)
#define PG8_LDA(dst, b, h) do { _Pragma("unroll") for (int m = 0; m < 4; ++m) _Pragma("unroll") for (int k = 0; k < 2; ++k) dst[m][k] = *(const PG8_LAS bf16x8*)(lds + PG8_SA(b, h) + aoff + m * 2048 + k * 1024); } while (0)
#define PG8_LDB(dst, b, h) do { _Pragma("unroll") for (int n = 0; n < 2; ++n) _Pragma("unroll") for (int k = 0; k < 2; ++k) dst[n][k] = *(const PG8_LAS bf16x8*)(lds + PG8_SB(b, h) + boff + n * 2048 + k * 1024); } while (0)
#define PG8_MMA(ai, bj, At, Bt) do { __builtin_amdgcn_s_setprio(1); _Pragma("unroll") for (int m = 0; m < 4; ++m) _Pragma("unroll") for (int n = 0; n < 2; ++n) _Pragma("unroll") for (int k = 0; k < 2; ++k) \
        acc[ai][bj][m][n] = __builtin_amdgcn_mfma_f32_16x16x32_bf16(Bt[n][k], At[m][k], acc[ai][bj][m][n], 0, 0, 0); __builtin_amdgcn_s_setprio(0); } while (0)
#define PG8_WAIT_V(n) asm volatile("s_waitcnt vmcnt(" #n ")" ::: "memory")
#define PG8_WAIT_L(n) asm volatile("s_waitcnt lgkmcnt(" #n ")" ::: "memory")
#define PG8_BAR __builtin_amdgcn_s_barrier()
#define PG8_SCHED __builtin_amdgcn_sched_barrier(0)
    Unit cur, nxt; int ui = 0;
    if (!S.next(0, cur)) return;
    f32x4 acc[2][2][4][2];
#pragma unroll
    for (int a = 0; a < 2; ++a)
#pragma unroll
        for (int b = 0; b < 2; ++b)
#pragma unroll
            for (int m = 0; m < 4; ++m)
#pragma unroll
                for (int n = 0; n < 2; ++n) acc[a][b][m][n] = (f32x4){0.f, 0.f, 0.f, 0.f};
    bf16x8 At[4][2], B0[2][2], B1[2][2];
    const char* cA = (const char*)g.A + (size_t)cur.pm * tstep; const char* cB = (const char*)g.Bt + (size_t)cur.pn * tstep;
    S.a_ready(cur);
    if constexpr (SP2) {
        PG8_STAGE(PG8_SB(0, 0), cB, voffB); PG8_STAGE(PG8_SB(0, 1), cB + hstep, voffB); PG8_STAGE(PG8_SA(0, 0), cA, voffA); PG8_STAGE(PG8_SA(0, 1), cA + hstep, voffA);
        if (wr == 1) PG8_BAR;
        PG8_WAIT_V(2); PG8_BAR;
        PG8_STAGE(PG8_SB(1, 0), cB + kstep, voffB); PG8_STAGE(PG8_SA(1, 0), cA + kstep, voffA); PG8_STAGE(PG8_SB(1, 1), cB + hstep + kstep, voffB);
        PG8_WAIT_V(6); PG8_BAR;
    } else {
        PG8_STAGE(PG8_SB(0, 0), cB, voffB); PG8_STAGE(PG8_SA(0, 0), cA, voffA); PG8_STAGE(PG8_SB(0, 1), cB + hstep, voffB); PG8_STAGE(PG8_SA(0, 1), cA + hstep, voffA);
        if (wr == 1) PG8_BAR;
        PG8_WAIT_V(4); PG8_BAR;
        PG8_STAGE(PG8_SB(1, 0), cB + kstep, voffB); PG8_STAGE(PG8_SA(1, 0), cA + kstep, voffA); PG8_STAGE(PG8_SB(1, 1), cB + hstep + kstep, voffB);
        PG8_WAIT_V(6); PG8_BAR;
    }
    for (;;) {
        const bool has_next = S.next(ui + 1, nxt);
        const char* nA = has_next ? (const char*)g.A + (size_t)nxt.pm * tstep : cA; const char* nB = has_next ? (const char*)g.Bt + (size_t)nxt.pn * tstep : cB;
        for (int t = 0; t < nt; t += 2) {
            const bool last = (t == nt - 2);
            const char* a1 = cA + (size_t)(t + 1) * kstep;
            const char* a2 = last ? nA : cA + (size_t)(t + 2) * kstep; const char* b2 = last ? nB : cB + (size_t)(t + 2) * kstep;
            const char* a3 = a2 + kstep; const char* b3 = b2 + kstep;
            if (last && has_next) S.a_ready(nxt);
            if constexpr (SP2) {
            PG8_LDB(B0, 0, 0); PG8_LDB(B1, 0, 1); PG8_SCHED; PG8_LDA(At, 0, 0); PG8_STAGE(PG8_SA(1, 1), a1 + hstep, voffA);
            PG8_WAIT_V(8); PG8_WAIT_L(0); PG8_BAR; PG8_MMA(0, 0, At, B0); PG8_MMA(0, 1, At, B1); PG8_BAR; PG8_SCHED;
            PG8_LDA(At, 0, 1); PG8_STAGE(PG8_SB(0, 0), b2, voffB); PG8_STAGE(PG8_SB(0, 1), b2 + hstep, voffB); PG8_STAGE(PG8_SA(0, 0), a2, voffA);
            PG8_WAIT_V(8); PG8_WAIT_L(0); PG8_BAR; PG8_MMA(1, 0, At, B0); PG8_MMA(1, 1, At, B1); PG8_BAR; PG8_SCHED;
            PG8_LDB(B0, 1, 0); PG8_LDB(B1, 1, 1); PG8_SCHED; PG8_LDA(At, 1, 0); PG8_STAGE(PG8_SA(0, 1), a2 + hstep, voffA);
            PG8_WAIT_V(8); PG8_WAIT_L(0); PG8_BAR; PG8_MMA(0, 0, At, B0); PG8_MMA(0, 1, At, B1); PG8_BAR; PG8_SCHED;
            PG8_LDA(At, 1, 1); PG8_STAGE(PG8_SB(1, 0), b3, voffB); PG8_STAGE(PG8_SB(1, 1), b3 + hstep, voffB); PG8_STAGE(PG8_SA(1, 0), a3, voffA);
            PG8_WAIT_V(8); PG8_WAIT_L(0); PG8_BAR; PG8_MMA(1, 0, At, B0); PG8_MMA(1, 1, At, B1); PG8_BAR; PG8_SCHED;
            } else {
            PG8_LDB(B0, 0, 0); PG8_SCHED; PG8_LDA(At, 0, 0); PG8_STAGE(PG8_SA(1, 1), a1 + hstep, voffA);
            PG8_WAIT_L(8); PG8_BAR; PG8_WAIT_L(0); PG8_MMA(0, 0, At, B0); PG8_BAR; PG8_SCHED;
            PG8_LDB(B1, 0, 1); PG8_STAGE(PG8_SB(0, 0), b2, voffB);
            PG8_BAR; PG8_WAIT_L(0); PG8_MMA(0, 1, At, B1); PG8_BAR;
            PG8_LDA(At, 0, 1); PG8_STAGE(PG8_SA(0, 0), a2, voffA);
            PG8_BAR; PG8_WAIT_L(0); PG8_MMA(1, 0, At, B0); PG8_BAR; PG8_SCHED;
            PG8_STAGE(PG8_SB(0, 1), b2 + hstep, voffB);
            PG8_WAIT_V(6); PG8_BAR; PG8_MMA(1, 1, At, B1); PG8_BAR;
            PG8_LDB(B0, 1, 0); PG8_SCHED; PG8_LDA(At, 1, 0); PG8_STAGE(PG8_SA(0, 1), a2 + hstep, voffA);
            PG8_WAIT_L(8); PG8_BAR; PG8_WAIT_L(0); PG8_MMA(0, 0, At, B0); PG8_BAR; PG8_SCHED;
            PG8_LDB(B1, 1, 1); PG8_STAGE(PG8_SB(1, 0), b3, voffB);
            PG8_BAR; PG8_WAIT_L(0); PG8_MMA(0, 1, At, B1); PG8_BAR;
            PG8_LDA(At, 1, 1); PG8_STAGE(PG8_SA(1, 0), a3, voffA);
            PG8_BAR; PG8_WAIT_L(0); PG8_MMA(1, 0, At, B0); PG8_BAR; PG8_SCHED;
            PG8_STAGE(PG8_SB(1, 1), b3 + hstep, voffB);
            PG8_WAIT_V(6); PG8_BAR; PG8_MMA(1, 1, At, B1); PG8_BAR;
            }
        }
        if constexpr (ALIGN_EPI) { if (wr == 0) PG8_BAR; }
        if constexpr (!Epi::AFTER_DRAIN) { E(acc, cur, wr, wc, fr, fq); S.done(cur); }
        if (!has_next) break;
#pragma unroll
        for (int a = 0; a < 2; ++a)
#pragma unroll
            for (int b = 0; b < 2; ++b)
#pragma unroll
                for (int m = 0; m < 4; ++m)
#pragma unroll
                    for (int n = 0; n < 2; ++n) acc[a][b][m][n] = (f32x4){0.f, 0.f, 0.f, 0.f};
        cur = nxt; cA = nA; cB = nB; ++ui;
        if constexpr (ALIGN_EPI) { if (wr == 1) PG8_BAR; }
    }
    PG8_WAIT_V(0);
    if constexpr (!ALIGN_EPI) { if (wr == 0) PG8_BAR; }
    PG8_BAR;
    if constexpr (Epi::AFTER_DRAIN) { E.fused(acc, cur, wr, wc, fr, fq, lds, wid, lane); S.done(cur); }
#undef PG8_SA
#undef PG8_SB
#undef PG8_STAGE
#undef PG8_LDA
#undef PG8_LDB
#undef PG8_MMA
#undef PG8_WAIT_V
#undef PG8_WAIT_L
#undef PG8_BAR
#undef PG8_SCHED
}
}
constexpr int BATCH = 2, SEQ = 8192, DM = 1024, DEPTH = 4, M = BATCH * SEQ;
constexpr int NIN = 9224, NP = 9216, NPAD = 9472, BW = 512;
constexpr int C_GQ = 0, C_GK = 512, C_GV = 1024, C_GZ = 1536, C_DQ = 2048, C_DK = 2560, C_DV = 3072, C_DZ = 3584,
              C_SB = 4096, C_SC = 4608, C_SX = 5120, C_SZ = 5632, C_MG = 6144;
constexpr float EPS = 1e-6f;
constexpr int NWAVES = 8, NTHR = 512;
constexpr int LDS_BYTES = 147456;
constexpr size_t MiB = 1u << 20;
constexpr size_t WS_CTL = 0;
constexpr size_t WS_WIN = 2 * MiB;
constexpr size_t WIN_L = (size_t)NPAD * DM;
constexpr size_t WS_WBR = 76 * MiB;
constexpr size_t WS_WOUT = 88 * MiB;
constexpr size_t WS_PROJ = 96 * MiB;
constexpr size_t WS_BA = 384 * MiB;
constexpr size_t WS_REGB = 386 * MiB;
constexpr size_t WS_REGC = 418 * MiB;
constexpr size_t WS_REGD = 482 * MiB;
constexpr size_t WS_GL = 554 * MiB;
constexpr size_t WS_END = 555 * MiB;
constexpr int NUNIT = BATCH * 4 * 128;
constexpr size_t UREC = 36864, R_W = 0, R_QD = 8192, R_KD = 16384, R_QK = 24576, R_U = 28672;

typedef unsigned short bf16;
typedef unsigned v4u __attribute__((ext_vector_type(4)));
typedef unsigned v2u __attribute__((ext_vector_type(2)));
typedef float f32x4 __attribute__((ext_vector_type(4)));
#define LAS __attribute__((address_space(3)))

__device__ __forceinline__ unsigned f2bf(float f) { unsigned u = __builtin_bit_cast(unsigned, f); return (u + 0x7fffu + ((u >> 16) & 1u)) >> 16; }
__device__ __forceinline__ unsigned pk2(float lo, float hi) { return f2bf(lo) | (f2bf(hi) << 16); }
__device__ __forceinline__ float bf2f(unsigned short b) { return __builtin_bit_cast(float, (unsigned)b << 16); }
__device__ __forceinline__ float bflo(unsigned w) { return __builtin_bit_cast(float, w << 16); }
__device__ __forceinline__ float bfhi(unsigned w) { return __builtin_bit_cast(float, w & 0xffff0000u); }
__device__ __forceinline__ void ld8(const bf16* p, float* f) { const v4u w = *(const v4u*)p; f[0] = bflo(w.x); f[1] = bfhi(w.x); f[2] = bflo(w.y); f[3] = bfhi(w.y); f[4] = bflo(w.z); f[5] = bfhi(w.z); f[6] = bflo(w.w); f[7] = bfhi(w.w); }
__device__ __forceinline__ void st8(bf16* p, const float* f) { v4u w; w.x = pk2(f[0], f[1]); w.y = pk2(f[2], f[3]); w.z = pk2(f[4], f[5]); w.w = pk2(f[6], f[7]); *(v4u*)p = w; }
__device__ __forceinline__ float wave_sum(float v) {
#pragma unroll
    for (int o = 1; o < 64; o <<= 1) v += __shfl_xor(v, o);
    return v;
}
__device__ __forceinline__ float sigmoidf_(float x) { return 1.f / (1.f + __expf(-x)); }
__device__ __forceinline__ float siluf_(float x) { return x / (1.f + __expf(-x)); }
__device__ __forceinline__ int srccol(int p) { return p < 2048 ? p : (p < 9216 ? p + 8 : (p < 9224 ? 2048 + (p - 9216) : -1)); }

struct Args {
    const float* x; const float* norm_pre; const float* norm_post; const float* w_in; const float* gdn_conv_w; const float* gdn_a_log; const float* gdn_dt_bias;
    const float* gdn_norm_w; const float* diff_lambda; const float* diff_norm_w; const float* sc_conv_w; const float* w_branch; const float* w_out;
    float* out; unsigned char* ws; int ph_lo, ph_hi, coop, pad;
};

struct EpiProj {
    static constexpr bool PERM = true, AFTER_DRAIN = false;
    bf16* P; float* BA;
    __device__ __forceinline__ void operator()(const pg8::f32x4 (&acc)[2][2][4][2], const pg8::Unit& u, int wr, int wc, int fr, int fq) const {
        const int row0 = u.pm * 256 + wr * 64 + fr;
        if (u.pn == 36) {
            if (wc == 0 && fq == 0) {
#pragma unroll
                for (int ai = 0; ai < 2; ++ai)
#pragma unroll
                    for (int m = 0; m < 4; ++m) { float* o = BA + (size_t)(row0 + ai * 128 + m * 16) * 8; *(pg8::f32x4*)o = acc[ai][0][m][0]; *(pg8::f32x4*)(o + 4) = acc[ai][0][m][1]; }
            }
            return;
        }
        const int colt = u.pn * 256; const float sc = (colt >= C_DQ && colt < C_DK) ? 0.18033688011112042f : 1.f;
        const int col0 = colt + wc * 32 + 8 * fq;
#pragma unroll
        for (int ai = 0; ai < 2; ++ai)
#pragma unroll
            for (int m = 0; m < 4; ++m) { bf16* rowp = P + (size_t)(row0 + ai * 128 + m * 16) * NP + col0;
#pragma unroll
                for (int bj = 0; bj < 2; ++bj) { const pg8::f32x4 v0 = acc[ai][bj][m][0] * sc, v1 = acc[ai][bj][m][1] * sc; v4u w;
                    w.x = pg8::cvt_pk_bf16(v0[0], v0[1]); w.y = pg8::cvt_pk_bf16(v0[2], v0[3]); w.z = pg8::cvt_pk_bf16(v1[0], v1[1]); w.w = pg8::cvt_pk_bf16(v1[2], v1[3]);
                    *(v4u*)(rowp + bj * 128) = w; } }
    }
};
struct BranchOrder {
    int pm0, pn0;
    __device__ __forceinline__ bool next(int i, pg8::Unit& u) const { if (i >= 3) return false; u.pm = i * 64 + pm0; u.pn = i * 4 + pn0; return true; }
    __device__ __forceinline__ void a_ready(const pg8::Unit&) const {}
    __device__ __forceinline__ void done(const pg8::Unit&) const {}
};
struct EpiBranch {
    static constexpr bool PERM = true, AFTER_DRAIN = false;
    const bf16* P; float* MG; bf16* MB;
    __device__ __forceinline__ void operator()(const pg8::f32x4 (&acc)[2][2][4][2], const pg8::Unit& u, int wr, int wc, int fr, int fq) const {
        const int kb = u.pn >> 2;
        const int row0 = (u.pm & 63) * 256 + wr * 64 + fr; const int col0 = (u.pn & 3) * 256 + wc * 32 + 8 * fq;
#pragma unroll
        for (int ai = 0; ai < 2; ++ai)
#pragma unroll
            for (int m = 0; m < 4; ++m) { const size_t row = (size_t)(row0 + ai * 128 + m * 16);
#pragma unroll
                for (int bj = 0; bj < 2; ++bj) { const int col = col0 + bj * 128; float lg[8]; ld8(P + row * NP + C_MG + kb * 1024 + col, lg);
                    float v[8];
#pragma unroll
                    for (int j = 0; j < 4; ++j) { v[j] = acc[ai][bj][m][0][j] * sigmoidf_(lg[j]); v[4 + j] = acc[ai][bj][m][1][j] * sigmoidf_(lg[4 + j]); }
                    float* mp = MG + row * DM + col;
                    if (kb > 0) { const pg8::f32x4 a = *(const pg8::f32x4*)mp, b = *(const pg8::f32x4*)(mp + 4);
#pragma unroll
                        for (int j = 0; j < 4; ++j) { v[j] += a[j]; v[4 + j] += b[j]; } }
                    if (kb < 2) { *(pg8::f32x4*)mp = (pg8::f32x4){v[0], v[1], v[2], v[3]}; *(pg8::f32x4*)(mp + 4) = (pg8::f32x4){v[4], v[5], v[6], v[7]}; }
                    else st8(MB + row * DM + col, v); } }
    }
};
struct EpiOutF32 {
    static constexpr bool PERM = true, AFTER_DRAIN = false;
    float* O;
    __device__ __forceinline__ void operator()(const pg8::f32x4 (&acc)[2][2][4][2], const pg8::Unit& u, int wr, int wc, int fr, int fq) const {
        const int row0 = u.pm * 256 + wr * 64 + fr; const int col0 = u.pn * 256 + wc * 32 + 8 * fq;
#pragma unroll
        for (int ai = 0; ai < 2; ++ai)
#pragma unroll
            for (int m = 0; m < 4; ++m) { float* rowp = O + (size_t)(row0 + ai * 128 + m * 16) * DM + col0;
#pragma unroll
                for (int bj = 0; bj < 2; ++bj) { *(pg8::f32x4*)(rowp + bj * 128) = acc[ai][bj][m][0]; *(pg8::f32x4*)(rowp + bj * 128 + 4) = acc[ai][bj][m][1]; } }
    }
};

__device__ __forceinline__ void tr_item(const float* W, int ldw, int K, bf16* WT, int k0, int p0, int mode, float* scr, int lane) {
    const int n = lane & 31; const int p = p0 + n; const int sc = mode ? srccol(p) : p;
#pragma unroll 8
    for (int i = 0; i < 32; ++i) { const int kk = 2 * i + (lane >> 5); scr[kk * 33 + n] = sc >= 0 ? W[(size_t)(k0 + kk) * ldw + sc] : 0.f; }
    asm volatile("s_waitcnt lgkmcnt(0)" ::: "memory");
    const int c = lane & 7;
#pragma unroll
    for (int j = 0; j < 4; ++j) { const int nn = (lane >> 3) + 8 * j; const float* s = scr + (8 * c) * 33 + nn;
        v4u o; o.x = pk2(s[0 * 33], s[1 * 33]); o.y = pk2(s[2 * 33], s[3 * 33]); o.z = pk2(s[4 * 33], s[5 * 33]); o.w = pk2(s[6 * 33], s[7 * 33]);
        *(v4u*)(WT + (size_t)(p0 + nn) * K + k0 + 8 * c) = o; }
    asm volatile("s_waitcnt lgkmcnt(0)" ::: "memory");
}
__device__ __forceinline__ void norm_row_to_h(const float* xrow, const float* wpre, bf16* hrow, int lane) {
    f32x4 v[4]; float s = 0.f;
#pragma unroll
    for (int j = 0; j < 4; ++j) { v[j] = *(const f32x4*)(xrow + 4 * lane + 256 * j); s += (v[j].x * v[j].x + v[j].y * v[j].y) + (v[j].z * v[j].z + v[j].w * v[j].w); }
    const float rs = rsqrtf(wave_sum(s) * (1.f / DM) + EPS);
#pragma unroll
    for (int j = 0; j < 4; ++j) { const f32x4 w = *(const f32x4*)(wpre + 4 * lane + 256 * j); v2u o; o.x = pk2(v[j].x * rs * w.x, v[j].y * rs * w.y); o.y = pk2(v[j].z * rs * w.z, v[j].w * rs * w.w);
        *(v2u*)(hrow + 4 * lane + 256 * j) = o; }
}
__device__ __forceinline__ void phase_prologue(const Args& a, unsigned char* lds, int wv_) {
    int tid_ = wv_ * 64 + mk_lane(); asm volatile("" : "+v"(tid_)); const int tid = tid_, lane = tid & 63, wave = tid >> 6;
    float* scr = (float*)(lds + wave * 16384);
    const int gw = blockIdx.x * NWAVES + wave, NGW = gridDim.x * NWAVES;
    constexpr int I_IN = (DM / 64) * (NPAD / 32), I_BR = (BW / 64) * (DM / 32), I_OUT = (DM / 64) * (DM / 32);
    constexpr int NITEMS = DEPTH * I_IN + DEPTH * 3 * I_BR + DEPTH * I_OUT;
    bf16* win = (bf16*)(a.ws + WS_WIN); bf16* wbr = (bf16*)(a.ws + WS_WBR); bf16* wout = (bf16*)(a.ws + WS_WOUT);
    for (int it = gw; it < NITEMS; it += NGW) {
        int r = it;
        if (r < DEPTH * I_IN) { const int l = r / I_IN; r %= I_IN; const int nb = NPAD / 32, kb = r / nb, pb = r % nb;
            tr_item(a.w_in + (size_t)l * DM * NIN, NIN, DM, win + (size_t)l * WIN_L, kb * 64, pb * 32, 1, scr, lane); continue; }
        r -= DEPTH * I_IN;
        if (r < DEPTH * 3 * I_BR) { const int lk = r / I_BR; r %= I_BR; const int nb = DM / 32, kb = r / nb, pb = r % nb;
            tr_item(a.w_branch + (size_t)lk * BW * DM, DM, BW, wbr + (size_t)lk * DM * BW, kb * 64, pb * 32, 0, scr, lane); continue; }
        r -= DEPTH * 3 * I_BR;
        { const int l = r / I_OUT; r %= I_OUT; const int nb = DM / 32, kb = r / nb, pb = r % nb;
            tr_item(a.w_out + (size_t)l * DM * DM, DM, DM, wout + (size_t)l * DM * DM, kb * 64, pb * 32, 0, scr, lane); }
    }
    if (blockIdx.x == 0 && tid < DEPTH) ((unsigned*)(a.ws + WS_CTL))[64 * tid] = 0u;
    bf16* H = (bf16*)(a.ws + WS_REGB);
    for (int m = gw; m < M; m += NGW) norm_row_to_h(a.x + (size_t)m * DM, a.norm_pre, H + (size_t)m * DM, lane);
}

typedef short bf16x8 __attribute__((ext_vector_type(8)));
typedef float f32x16 __attribute__((ext_vector_type(16)));
typedef float f32x2_t __attribute__((ext_vector_type(2))); typedef __bf16 bf16x2_t __attribute__((ext_vector_type(2)));
__device__ __forceinline__ unsigned cvtpk(float lo, float hi) { f32x2_t v = {lo, hi}; bf16x2_t bb = __builtin_convertvector(v, bf16x2_t); return __builtin_bit_cast(unsigned, bb); }
__device__ __forceinline__ int crow(int r, int hi) { return (r & 3) + 8 * (r >> 2) + 4 * hi; }
#define MFMA32(a, b, c) __builtin_amdgcn_mfma_f32_32x32x16_bf16((a), (b), (c), 0, 0, 0)
constexpr int AT_KS = 0, AT_VT = 64 * 144, AT_BUF = 32768, AT_FS = 65536, AT_CTR = AT_FS + 1024;
__device__ __forceinline__ void phase_attn(const Args& a, unsigned char* lds, int l, int wv_) {
    const bf16* P = (const bf16*)(a.ws + WS_PROJ); float* OATT = (float*)(a.ws + WS_REGC);
    int tid_ = wv_ * 64 + mk_lane(); asm volatile("" : "+v"(tid_)); const int tid = tid_, lane = tid & 63, r32 = lane & 31, hi = lane >> 5, wave = tid >> 6;
    float* fs = (float*)(lds + AT_FS) + wave * 32;
    unsigned* ctr = (unsigned*)(a.ws + WS_CTL) + 64 * l;
#pragma unroll 1
    for (;;) {
        __syncthreads();
        if (tid == 0) *(volatile unsigned*)(lds + AT_CTR) = atomicAdd(ctr, 1u);
        __syncthreads();
        const unsigned uidx = *(volatile unsigned*)(lds + AT_CTR);
        if (uidx >= 512u) break;
        const int stream = (int)(uidx & 15u), qb = 31 - (int)(uidx >> 4);
        const int bb = stream >> 3, h = (stream >> 1) & 3, mp = stream & 1;
        const float slope2 = exp2f(-2.f * (float)(h + 1)) * 1.4426950408889634f;
        const bf16* Kg = P + (size_t)bb * SEQ * NP + C_DK + h * 128 + mp * 64 + (size_t)(tid >> 3) * NP + (tid & 7) * 8;
        const int vp = tid & 31, vc = tid >> 5;
        const bf16* Vg = P + (size_t)bb * SEQ * NP + C_DV + h * 128 + (size_t)(2 * vp) * NP + vc * 8;
        const int vpos = ((2 * vp) & 48) | (((2 * vp) & 4) << 1) | (((2 * vp) & 8) >> 1) | ((2 * vp) & 3);
        {
            const int q0 = qb * 256 + wave * 32, t = q0 + r32;
            bf16x8 qr[4];
            { const bf16* qp = P + ((size_t)bb * SEQ + t) * NP + C_DQ + h * 128 + mp * 64 + hi * 8;
#pragma unroll
              for (int d0 = 0; d0 < 4; ++d0) qr[d0] = *(const bf16x8*)(qp + d0 * 16); }
            float cb[16];
#pragma unroll
            for (int r = 0; r < 16; ++r) cb[r] = slope2 * (float)crow(r, hi);
            f32x16 o[4];
#pragma unroll
            for (int db = 0; db < 4; ++db)
#pragma unroll
                for (int r = 0; r < 16; ++r) o[db][r] = 0.f;
            float m_ref = -1e30f, lsum = 0.f;
            const int ntile = 4 * qb + 4;
            v4u kreg, vreg0, vreg1;
#define AT_LOAD(tile) do { const size_t jo_ = (size_t)(tile) * 64 * NP; kreg = *(const v4u*)(Kg + jo_); vreg0 = *(const v4u*)(Vg + jo_); vreg1 = *(const v4u*)(Vg + jo_ + NP); } while (0)
#define AT_STORE(bufo) do { *(v4u*)(lds + (bufo) + AT_KS + (tid >> 3) * 144 + (tid & 7) * 16) = kreg; \
                unsigned* vt_ = (unsigned*)(lds + (bufo) + AT_VT + (vc * 8) * 144 + vpos * 2); \
                const unsigned a_[4] = {vreg0.x, vreg0.y, vreg0.z, vreg0.w}, b_[4] = {vreg1.x, vreg1.y, vreg1.z, vreg1.w}; \
                _Pragma("unroll") for (int x = 0; x < 4; ++x) { vt_[(2 * x) * 36] = (a_[x] & 0xffffu) | (b_[x] << 16); vt_[(2 * x + 1) * 36] = (a_[x] >> 16) | (b_[x] & 0xffff0000u); } } while (0)
            AT_LOAD(ntile - 1);
            __syncthreads();
            AT_STORE(0);
            AT_LOAD(ntile - 2);
            int bufo = 0;
#pragma unroll 1
            for (int tt = ntile - 1; tt >= 0; --tt) {
                __syncthreads();
                if (tt > 0) { AT_STORE(bufo ^ AT_BUF); if (tt > 1) AT_LOAD(tt - 2); }
                const unsigned char* lb = lds + bufo;
                const int j0 = tt * 64;
                if (j0 <= q0 + 31) {
                    const float base = slope2 * (float)(j0 - t), base1 = base + 32.f * slope2;
                    f32x16 p0, p1;
#pragma unroll
                    for (int r = 0; r < 16; ++r) { p0[r] = cb[r] + base; p1[r] = cb[r] + base1; }
                    { const unsigned char* kb = lb + AT_KS + r32 * 144 + hi * 16;
#pragma unroll
                      for (int d0 = 0; d0 < 4; ++d0) { const bf16x8 a0 = *(const bf16x8*)(kb + d0 * 32), a1 = *(const bf16x8*)(kb + 32 * 144 + d0 * 32);
                          p0 = MFMA32(a0, qr[d0], p0); p1 = MFMA32(a1, qr[d0], p1); } }
                    if (j0 + 63 > q0) {
#pragma unroll
                        for (int r = 0; r < 16; ++r) { const int kv = j0 + crow(r, hi); if (kv > t) p0[r] = -1e30f; if (kv + 32 > t) p1[r] = -1e30f; }
                    }
                    float mx = fmaxf(p0[0], p1[0]);
#pragma unroll
                    for (int r = 1; r < 16; ++r) mx = fmaxf(mx, fmaxf(p0[r], p1[r]));
                    mx = fmaxf(mx, __shfl_xor(mx, 32));
                    if (__any(mx > m_ref + 8.f)) {
                        const float m_new = fmaxf(m_ref, mx), f = __builtin_amdgcn_exp2f(m_ref - m_new); m_ref = m_new; lsum *= f;
                        if (hi == 0) fs[r32] = f;
                        __builtin_amdgcn_wave_barrier();
#pragma unroll
                        for (int g = 0; g < 4; ++g) { const f32x4 ff = *(const f32x4*)(fs + 8 * g + 4 * hi);
#pragma unroll
                            for (int db = 0; db < 4; ++db) { o[db][4 * g] *= ff.x; o[db][4 * g + 1] *= ff.y; o[db][4 * g + 2] *= ff.z; o[db][4 * g + 3] *= ff.w; } }
                        __builtin_amdgcn_wave_barrier();
                    }
                    float sacc = 0.f;
#pragma unroll
                    for (int r = 0; r < 16; ++r) { p0[r] = __builtin_amdgcn_exp2f(p0[r] - m_ref); p1[r] = __builtin_amdgcn_exp2f(p1[r] - m_ref); sacc += p0[r] + p1[r]; }
                    lsum += sacc;
                    bf16x8 pk[4];
#pragma unroll
                    for (int s = 0; s < 2; ++s) { v4u w0, w1;
                        w0.x = cvtpk(p0[8 * s], p0[8 * s + 1]); w0.y = cvtpk(p0[8 * s + 2], p0[8 * s + 3]); w0.z = cvtpk(p0[8 * s + 4], p0[8 * s + 5]); w0.w = cvtpk(p0[8 * s + 6], p0[8 * s + 7]);
                        w1.x = cvtpk(p1[8 * s], p1[8 * s + 1]); w1.y = cvtpk(p1[8 * s + 2], p1[8 * s + 3]); w1.z = cvtpk(p1[8 * s + 4], p1[8 * s + 5]); w1.w = cvtpk(p1[8 * s + 6], p1[8 * s + 7]);
                        pk[s] = __builtin_bit_cast(bf16x8, w0); pk[2 + s] = __builtin_bit_cast(bf16x8, w1); }
                    const unsigned char* vb = lb + AT_VT + r32 * 144 + hi * 16;
#pragma unroll
                    for (int s = 0; s < 4; ++s)
#pragma unroll
                        for (int db = 0; db < 4; ++db) o[db] = MFMA32(pk[s], *(const bf16x8*)(vb + db * 32 * 144 + s * 32), o[db]);
                }
                bufo ^= AT_BUF;
            }
#undef AT_LOAD
#undef AT_STORE
            lsum += __shfl_xor(lsum, 32);
            __builtin_amdgcn_wave_barrier();
            if (hi == 0) fs[r32] = 1.f / lsum;
            __builtin_amdgcn_wave_barrier();
#pragma unroll
            for (int g = 0; g < 4; ++g) { const f32x4 ff = *(const f32x4*)(fs + 8 * g + 4 * hi); const float fv[4] = {ff.x, ff.y, ff.z, ff.w};
#pragma unroll
                for (int x = 0; x < 4; ++x) { const size_t row = (size_t)bb * SEQ + q0 + 8 * g + 4 * hi + x; float* dst = OATT + ((row * 4 + h) * 2 + mp) * 128 + r32;
#pragma unroll
                    for (int db = 0; db < 4; ++db) dst[db * 32] = o[db][4 * g + x] * fv[x]; } }
            __builtin_amdgcn_wave_barrier();
        }
    }
    __syncthreads();
}

__device__ __forceinline__ int afrag_off(int row, int k, int nks) { const int rt = row >> 5, r = row & 31, ks = k >> 4, kk = k & 15, h = (kk >> 2) & 1, j = ((kk >> 3) << 2) | (kk & 3); return ((rt * nks + ks) * 64 + r + 32 * h) * 8 + j; }
__device__ __forceinline__ int clay_off(int c, int dv) { const int rt = c >> 5, cc = c & 31, hi = (cc >> 2) & 1, i = ((cc >> 3) << 2) | (cc & 3), sl = dv >> 5, r32 = dv & 31; return ((rt * 4 + sl) * 64 + r32 + 32 * hi) * 16 + i; }
__device__ __forceinline__ void phase_gdn_local_v1(const Args& a, unsigned char* lds, int l, int wv_) {
    const bf16* P = (const bf16*)(a.ws + WS_PROJ); const float* BA = (const float*)(a.ws + WS_BA);
    bf16* GD = (bf16*)(a.ws + WS_REGD); float* GL = (float*)(a.ws + WS_GL);
    float* qs = (float*)lds; float* ks = qs + 64 * 129; float* vs = ks + 64 * 129; float* KKs = vs + 64 * 129; float* QKs = KKs + 64 * 65;
    float* beta = QKs + 64 * 65; float* gc = beta + 64;
    int tid_ = wv_ * 64 + mk_lane(); asm volatile("" : "+v"(tid_)); const int tid = tid_, lane = tid & 63, wave = tid >> 6;
    const float* cw = a.gdn_conv_w + (size_t)l * 4 * 1536;
    for (int unit = blockIdx.x; unit < NUNIT; unit += gridDim.x) {
        const int bb = unit >> 9, h = (unit >> 7) & 3, n = unit & 127;
        __syncthreads();
#pragma unroll 1
        for (int idx = tid; idx < 3 * 64 * 128; idx += NTHR) {
            const int mat = idx >> 13, rem = idx & 8191, t = rem >> 7, c = rem & 127, col = mat * 512 + h * 128 + c;
            float acc = 0.f;
#pragma unroll
            for (int j = 0; j < 4; ++j) { const int tt = n * 64 + t - 3 + j; if (tt >= 0) acc += cw[j * 1536 + col] * bf2f(P[((size_t)bb * SEQ + tt) * NP + col]); }
            (mat == 0 ? qs : mat == 1 ? ks : vs)[t * 129 + c] = siluf_(acc);
        }
        if (tid < 64) {
            const size_t row = (size_t)bb * SEQ + n * 64 + tid;
            beta[tid] = sigmoidf_(BA[row * 8 + h]);
            const float xx = BA[row * 8 + 4 + h] + a.gdn_dt_bias[l * 4 + h];
            const float sp = xx > 20.f ? xx : log1pf(__expf(xx));
            gc[tid] = -__expf(a.gdn_a_log[l * 4 + h]) * sp;
        }
        __syncthreads();
        if (tid == 0) { float run = 0.f;
#pragma unroll 1
            for (int c = 0; c < 64; ++c) { run += gc[c]; gc[c] = run; } }
        __syncthreads();
#pragma unroll 1
        for (int r = wave * 8; r < wave * 8 + 8; ++r) {
            { float x0 = qs[r * 129 + lane], x1 = qs[r * 129 + 64 + lane]; const float sc = rsqrtf(wave_sum(x0 * x0 + x1 * x1) + 1e-6f) * 0.08838834764831845f; qs[r * 129 + lane] = x0 * sc; qs[r * 129 + 64 + lane] = x1 * sc; }
            { float x0 = ks[r * 129 + lane], x1 = ks[r * 129 + 64 + lane]; const float sc = rsqrtf(wave_sum(x0 * x0 + x1 * x1) + 1e-6f); ks[r * 129 + lane] = x0 * sc; ks[r * 129 + 64 + lane] = x1 * sc; }
        }
        __syncthreads();
#pragma unroll 1
        for (int i = 0; i < 8; ++i) { const int idx = tid + NTHR * i, c = idx >> 6, s = idx & 63; float kk = 0.f, qk = 0.f;
#pragma unroll 4
            for (int d = 0; d < 128; ++d) { const float kv = ks[s * 129 + d]; kk += ks[c * 129 + d] * kv; qk += qs[c * 129 + d] * kv; }
            const float dec = (s <= c) ? __expf(gc[c] - gc[s]) : 0.f;
            KKs[c * 65 + s] = (s < c) ? kk * beta[c] * dec : 0.f; QKs[c * 65 + s] = qk * dec; }
        __syncthreads();
        const size_t ub = (size_t)unit * UREC;
        { const float gl = gc[63];
          for (int idx = tid; idx < 8192; idx += NTHR) { const int c = idx >> 7, d = idx & 127;
              GD[ub + R_QD + afrag_off(c, d, 8)] = (bf16)f2bf(qs[c * 129 + d] * __expf(gc[c])); GD[ub + R_KD + afrag_off(d, c, 4)] = (bf16)f2bf(ks[c * 129 + d] * __expf(gl - gc[c])); }
          for (int idx = tid; idx < 4096; idx += NTHR) { const int c = idx >> 6, s = idx & 63; GD[ub + R_QK + afrag_off(c, s, 4)] = (bf16)f2bf(QKs[c * 65 + s]); }
          if (tid == 0) GL[unit] = __expf(gl); }
        __syncthreads();
        for (int idx = tid; idx < 8192; idx += NTHR) { const int c = idx >> 7, d = idx & 127; vs[c * 129 + d] *= beta[c]; ks[c * 129 + d] *= beta[c] * __expf(gc[c]); }
        __syncthreads();
        if (tid < 256) {
            float* X = (tid < 128 ? vs : ks) + (tid & 127);
#pragma unroll 1
            for (int c = 1; c < 64; ++c) { float acc = X[c * 129]; const float* Ar = KKs + c * 65;
#pragma unroll 4
                for (int s = 0; s < c; ++s) acc -= Ar[s] * X[s * 129];
                X[c * 129] = acc; }
            if (tid < 128) { for (int c = 0; c < 64; ++c) GD[ub + R_U + clay_off(c, tid)] = (bf16)f2bf(X[c * 129]); }
            else { for (int c = 0; c < 64; ++c) GD[ub + R_W + afrag_off(c, tid - 128, 8)] = (bf16)f2bf(-X[c * 129]); }
        }
    }
    __syncthreads();
}

constexpr int GL_QB = 0, GL_KB = 17408, GL_VB = 34816, GL_AM = 52224, GL_QK = 69632, GL_XT = 78848, GL_BETA = 115712, GL_GC = 115968, GL_EGC = 116224;
template <int ROFF> __device__ __forceinline__ void tri_solve32(float (&x)[32], const float* Am) {
#pragma unroll
    for (int c = 1; c < 32; ++c) { int off = (ROFF + c) * 68 + ROFF;
        if (c >= 2) asm volatile("" : "+v"(off), "+v"(x[c - 2])); else asm volatile("" : "+v"(off));
        const float* ar = Am + off; float acc = x[c];
#pragma unroll
        for (int s4 = 0; s4 < c; s4 += 4) { const f32x4 av = *(const f32x4*)(ar + s4);
            acc -= av.x * x[s4]; if (s4 + 1 < c) acc -= av.y * x[s4 + 1]; if (s4 + 2 < c) acc -= av.z * x[s4 + 2]; if (s4 + 3 < c) acc -= av.w * x[s4 + 3]; }
        x[c] = acc; }
}
__device__ __forceinline__ void phase_gdn_local(const Args& a, unsigned char* lds, int l, int wv_) {
    const bf16* P = (const bf16*)(a.ws + WS_PROJ); const float* BA = (const float*)(a.ws + WS_BA);
    bf16* GD = (bf16*)(a.ws + WS_REGD); float* GL = (float*)(a.ws + WS_GL);
    bf16* qb = (bf16*)(lds + GL_QB); bf16* kb = (bf16*)(lds + GL_KB); bf16* vb = (bf16*)(lds + GL_VB); float* Am = (float*)(lds + GL_AM); bf16* QKb = (bf16*)(lds + GL_QK); bf16* XT = (bf16*)(lds + GL_XT);
    float* beta = (float*)(lds + GL_BETA); float* gc = (float*)(lds + GL_GC); float* egc = (float*)(lds + GL_EGC);
    const float* cwp = a.gdn_conv_w + (size_t)l * 4 * 1536;
#pragma unroll 1
    for (int unit = blockIdx.x; unit < NUNIT; unit += gridDim.x) {
        const int bb = unit >> 9, h = (unit >> 7) & 3, n = unit & 127;
        const size_t ub = (size_t)unit * UREC;
        __syncthreads();
        { const int tid = wv_ * 64 + mk_lane(), lane = tid & 63, r32 = lane & 31, hi = lane >> 5, wave = tid >> 6; (void)r32; (void)hi; (void)wave; (void)lane;
        if (tid < 384) {
            const int g = tid >> 4, cg = tid & 15, mat = g >> 3, tg = g & 7, col = mat * 512 + h * 128 + cg * 8;
            float cw[4][8];
#pragma unroll
            for (int j = 0; j < 4; ++j) { const f32x4 w0 = *(const f32x4*)(cwp + j * 1536 + col), w1 = *(const f32x4*)(cwp + j * 1536 + col + 4);
                cw[j][0] = w0.x; cw[j][1] = w0.y; cw[j][2] = w0.z; cw[j][3] = w0.w; cw[j][4] = w1.x; cw[j][5] = w1.y; cw[j][6] = w1.z; cw[j][7] = w1.w; }
            v4u in[11];
#pragma unroll
            for (int r = 0; r < 11; ++r) { const int tt = n * 64 + tg * 8 - 3 + r; in[r] = (v4u){0u, 0u, 0u, 0u}; if (tt >= 0) in[r] = *(const v4u*)(P + ((size_t)bb * SEQ + tt) * NP + col); }
            bf16* dstm = (mat == 0 ? qb : mat == 1 ? kb : vb) + cg * 8;
#pragma unroll
            for (int i = 0; i < 8; ++i) { float o[8];
#pragma unroll
                for (int e = 0; e < 8; ++e) o[e] = 0.f;
#pragma unroll
                for (int j = 0; j < 4; ++j) { const v4u w = in[i + j]; const float f[8] = {bflo(w.x), bfhi(w.x), bflo(w.y), bfhi(w.y), bflo(w.z), bfhi(w.z), bflo(w.w), bfhi(w.w)};
#pragma unroll
                    for (int e = 0; e < 8; ++e) o[e] += cw[j][e] * f[e]; }
                float ss = 0.f;
#pragma unroll
                for (int e = 0; e < 8; ++e) { o[e] = siluf_(o[e]); ss += o[e] * o[e]; }
                ss += __shfl_xor(ss, 1); ss += __shfl_xor(ss, 2); ss += __shfl_xor(ss, 4); ss += __shfl_xor(ss, 8);
                const float sc = mat == 2 ? 1.f : rsqrtf(ss + 1e-6f) * (mat == 0 ? 0.08838834764831845f : 1.f);
#pragma unroll
                for (int e = 0; e < 8; ++e) o[e] *= sc;
                st8(dstm + (tg * 8 + i) * 136, o); }
        } else if (tid < 448) {
            const int t = tid - 384; const size_t row = (size_t)bb * SEQ + n * 64 + t;
            beta[t] = sigmoidf_(BA[row * 8 + h]);
            const float xx = BA[row * 8 + 4 + h] + a.gdn_dt_bias[l * 4 + h];
            const float sp = xx > 20.f ? xx : log1pf(__expf(xx));
            float gv = -__expf(a.gdn_a_log[l * 4 + h]) * sp;
#pragma unroll
            for (int o = 1; o < 64; o <<= 1) { const float v = __shfl_up(gv, o); if (t >= o) gv += v; }
            gc[t] = gv; egc[t] = __expf(gv);
        }
        }
        __syncthreads();
        { const int tid = wv_ * 64 + mk_lane(), lane = tid & 63, r32 = lane & 31, hi = lane >> 5, wave = tid >> 6; (void)r32; (void)hi; (void)wave; (void)lane;
        { const int mat = wave >> 2, rt = (wave >> 1) & 1, ct = wave & 1;
          if (mat == 1 || !(rt == 0 && ct == 1)) {
            f32x16 acc;
#pragma unroll
            for (int r = 0; r < 16; ++r) acc[r] = 0.f;
            const bf16* Ab = (mat == 0 ? kb : qb) + (32 * rt + r32) * 136 + 8 * hi; const bf16* Bb = kb + (32 * ct + r32) * 136 + 8 * hi;
            if (!(rt == 0 && ct == 1)) {
#pragma unroll
                for (int ks = 0; ks < 8; ++ks) acc = MFMA32(*(const bf16x8*)(Ab + 16 * ks), *(const bf16x8*)(Bb + 16 * ks), acc);
            }
            const int s = 32 * ct + r32; const float gs = gc[s];
#pragma unroll
            for (int i = 0; i < 16; ++i) { const int c = 32 * rt + crow(i, hi); const float dec = (s <= c) ? __expf(gc[c] - gs) : 0.f;
                if (mat == 0) Am[c * 68 + s] = (s < c) ? acc[i] * beta[c] * dec : 0.f;
                else QKb[c * 72 + s] = (bf16)f2bf(acc[i] * dec); }
          } }
        }
        __syncthreads();
        { const int tid = wv_ * 64 + mk_lane(), lane = tid & 63, r32 = lane & 31, hi = lane >> 5, wave = tid >> 6; (void)r32; (void)hi; (void)wave; (void)lane;
        if (tid < 256) {
            const int col = tid; float x[32];
#pragma unroll
            for (int c = 0; c < 32; ++c) x[c] = (col < 128) ? bf2f(vb[c * 136 + col]) * beta[c] : bf2f(kb[c * 136 + col - 128]) * beta[c] * egc[c];
            tri_solve32<0>(x, Am);
#pragma unroll
            for (int c = 0; c < 32; c += 8) st8(XT + col * 72 + c, x + c);
        } else {
            const int lt = tid - 256; const float gl = gc[63];
#pragma unroll 1
            for (int q = 0; q < 4; ++q) { const int item = lt + 256 * q, f = item >> 6, ln = item & 63, r = ln & 31, hh = ln >> 5;
                { const int rt = f >> 3, ks = f & 7, c = 32 * rt + r; const float e = egc[c]; const bf16* sp = qb + c * 136 + 16 * ks + 4 * hh;
                  const v2u lo = *(const v2u*)sp, hi8 = *(const v2u*)(sp + 8); v4u w;
                  w.x = pk2(bflo(lo.x) * e, bfhi(lo.x) * e); w.y = pk2(bflo(lo.y) * e, bfhi(lo.y) * e); w.z = pk2(bflo(hi8.x) * e, bfhi(hi8.x) * e); w.w = pk2(bflo(hi8.y) * e, bfhi(hi8.y) * e);
                  *(v4u*)(GD + ub + R_QD + item * 8) = w; }
                { const int rt = f >> 2, ks = f & 3, dk = 32 * rt + r; float v[8];
#pragma unroll
                  for (int j = 0; j < 8; ++j) { const int c = 16 * ks + 8 * (j >> 2) + 4 * hh + (j & 3); v[j] = bf2f(kb[c * 136 + dk]) * __expf(gl - gc[c]); }
                  st8(GD + ub + R_KD + item * 8, v); } }
#pragma unroll 1
            for (int q = 0; q < 2; ++q) { const int item = lt + 256 * q, f = item >> 6, ln = item & 63, r = ln & 31, hh = ln >> 5, rt = f >> 2, ks = f & 3, c = 32 * rt + r;
                const bf16* sp = QKb + c * 72 + 16 * ks + 4 * hh; const v2u lo = *(const v2u*)sp, hi8 = *(const v2u*)(sp + 8); v4u w; w.x = lo.x; w.y = lo.y; w.z = hi8.x; w.w = hi8.y;
                *(v4u*)(GD + ub + R_QK + item * 8) = w; }
            if (lt == 0) GL[unit] = __expf(gl);
        }
        }
        __syncthreads();
        { const int tid = wv_ * 64 + mk_lane(), lane = tid & 63, r32 = lane & 31, hi = lane >> 5, wave = tid >> 6; (void)r32; (void)hi; (void)wave; (void)lane;
        { const int col = 32 * wave + r32; f32x16 acc;
#pragma unroll
          for (int i = 0; i < 16; ++i) { const int c = 32 + crow(i, hi); acc[i] = (col < 128) ? bf2f(vb[c * 136 + col]) * beta[c] : bf2f(kb[c * 136 + col - 128]) * beta[c] * egc[c]; }
#pragma unroll
          for (int ks = 0; ks < 2; ++ks) { const float* ap = Am + (32 + r32) * 68 + 16 * ks + 8 * hi; const f32x4 a0 = *(const f32x4*)ap, a1 = *(const f32x4*)(ap + 4);
              v4u w; w.x = cvtpk(-a0.x, -a0.y); w.y = cvtpk(-a0.z, -a0.w); w.z = cvtpk(-a1.x, -a1.y); w.w = cvtpk(-a1.z, -a1.w);
              acc = MFMA32(__builtin_bit_cast(bf16x8, w), *(const bf16x8*)(XT + col * 72 + 16 * ks + 8 * hi), acc); }
#pragma unroll
          for (int g = 0; g < 4; ++g) { v2u w; w.x = cvtpk(acc[4 * g], acc[4 * g + 1]); w.y = cvtpk(acc[4 * g + 2], acc[4 * g + 3]); *(v2u*)(XT + col * 72 + 32 + 8 * g + 4 * hi) = w; } }
        }
        __syncthreads();
        { const int tid = wv_ * 64 + mk_lane(), lane = tid & 63, r32 = lane & 31, hi = lane >> 5, wave = tid >> 6; (void)r32; (void)hi; (void)wave; (void)lane;
        if (tid < 256) {
            const int col = tid; float x[32];
#pragma unroll
            for (int c = 0; c < 32; c += 8) ld8(XT + col * 72 + 32 + c, x + c);
            tri_solve32<32>(x, Am);
#pragma unroll
            for (int c = 0; c < 32; c += 8) st8(XT + col * 72 + 32 + c, x + c);
        }
        }
        __syncthreads();
        { const int tid = wv_ * 64 + mk_lane(), lane = tid & 63, r32 = lane & 31, hi = lane >> 5, wave = tid >> 6; (void)r32; (void)hi; (void)wave; (void)lane;
        { const int item = tid, tile = item >> 6, ln = item & 63, rr = ln & 31, hh = ln >> 5, rt = tile >> 2, sl = tile & 3, dv = sl * 32 + rr;
          const bf16* xp = XT + dv * 72 + 32 * rt + 4 * hh; const v2u g0 = *(const v2u*)xp, g1 = *(const v2u*)(xp + 8), g2 = *(const v2u*)(xp + 16), g3 = *(const v2u*)(xp + 24);
          v4u w0, w1; w0.x = g0.x; w0.y = g0.y; w0.z = g1.x; w0.w = g1.y; w1.x = g2.x; w1.y = g2.y; w1.z = g3.x; w1.w = g3.y;
          *(v4u*)(GD + ub + R_U + item * 16) = w0; *(v4u*)(GD + ub + R_U + item * 16 + 8) = w1; }
#pragma unroll 1
        for (int q = 0; q < 2; ++q) { const int item = tid + 512 * q, f = item >> 6, ln = item & 63, r = ln & 31, hh = ln >> 5, rt = f >> 3, ks = f & 7, c = 32 * rt + r;
            unsigned short v[8];
#pragma unroll
            for (int j = 0; j < 8; ++j) { const int kc = 16 * ks + 8 * (j >> 2) + 4 * hh + (j & 3); v[j] = XT[(128 + kc) * 72 + c] ^ 0x8000u; }
            v4u w; w.x = v[0] | ((unsigned)v[1] << 16); w.y = v[2] | ((unsigned)v[3] << 16); w.z = v[4] | ((unsigned)v[5] << 16); w.w = v[6] | ((unsigned)v[7] << 16);
            *(v4u*)(GD + ub + R_W + item * 8) = w; }
        }
    }
    __syncthreads();
}

constexpr int SC_WN = 0, SC_QD = 16384, SC_KDT = 32768, SC_QK = 49152, SC_U = 57344, SC_GL = 61440, SC_BUF = 61504;
__device__ __forceinline__ bf16x8 pack8(const f32x16& x, int s) { v4u w; w.x = cvtpk(x[8 * s], x[8 * s + 1]); w.y = cvtpk(x[8 * s + 2], x[8 * s + 3]); w.z = cvtpk(x[8 * s + 4], x[8 * s + 5]); w.w = cvtpk(x[8 * s + 6], x[8 * s + 7]); return __builtin_bit_cast(bf16x8, w); }
__device__ __forceinline__ void phase_gdn_scan(const Args& a, unsigned char* lds, int l, int wv_) {
    const bf16* GD = (const bf16*)(a.ws + WS_REGD); const float* GL = (const float*)(a.ws + WS_GL); float* OG = (float*)(a.ws + WS_REGB);
    int tid_ = wv_ * 64 + mk_lane(); asm volatile("" : "+v"(tid_)); const int tid = tid_, lane = tid & 63, r32 = lane & 31, hi = lane >> 5, wave = tid >> 6;
#pragma unroll 1
    for (int job = blockIdx.x; job < 32; job += gridDim.x) {
        const int bh = job >> 2, sl = job & 3, bb = bh >> 2, h = bh & 3;
        f32x16 S[4];
#pragma unroll
        for (int b4 = 0; b4 < 4; ++b4)
#pragma unroll
            for (int r = 0; r < 16; ++r) S[b4][r] = 0.f;
        __syncthreads();
#pragma unroll 1
        for (int n = -1; n < 128; ++n) {
            if (wave != 0 && n + 1 < 128) {
                const int unit = bh * 128 + n + 1; unsigned char* dstb = lds + ((n + 1) & 1) * SC_BUF + (tid - 64) * 16;
                const unsigned char* rec = (const unsigned char*)(GD + (size_t)unit * UREC) + (tid - 64) * 16;
                v4u lr[9];
#pragma unroll
                for (int q = 0; q < 8; ++q) lr[q] = *(const v4u*)(rec + q * 7168);
                const int lt = tid - 64; const bool hasu = lt < 256;
                if (hasu) lr[8] = *(const v4u*)((const unsigned char*)(GD + (size_t)unit * UREC + R_U) + ((lt >> 7) * 512 + sl * 128 + (lt & 127)) * 16);
#pragma unroll
                for (int q = 0; q < 8; ++q) *(v4u*)(dstb + q * 7168) = lr[q];
                if (hasu) *(v4u*)(dstb + 8 * 7168) = lr[8];
                dstb -= (tid - 64) * 16;
                if (tid == 64) *(float*)(dstb + SC_GL) = GL[unit];
            }
            if (wave == 0 && n >= 0) {
                const unsigned char* base = lds + (n & 1) * SC_BUF;
#define SFRAG(off, f) (*(const bf16x8*)(base + (off) + (f) * 1024 + lane * 16))
                bf16x8 Spk[8];
#pragma unroll
                for (int ks = 0; ks < 8; ++ks) Spk[ks] = pack8(S[ks >> 1], ks & 1);
                f32x16 Vn[2];
#pragma unroll
                for (int rt = 0; rt < 2; ++rt) { const v4u u0 = *(const v4u*)(base + SC_U + (rt * 64 + lane) * 32), u1 = *(const v4u*)(base + SC_U + (rt * 64 + lane) * 32 + 16);
                    const unsigned uw[8] = {u0.x, u0.y, u0.z, u0.w, u1.x, u1.y, u1.z, u1.w};
#pragma unroll
                    for (int x = 0; x < 8; ++x) { Vn[rt][2 * x] = bflo(uw[x]); Vn[rt][2 * x + 1] = bfhi(uw[x]); }
#pragma unroll
                    for (int ks = 0; ks < 8; ++ks) Vn[rt] = MFMA32(SFRAG(SC_WN, rt * 8 + ks), Spk[ks], Vn[rt]); }
                bf16x8 Vpk[4];
#pragma unroll
                for (int ks = 0; ks < 4; ++ks) Vpk[ks] = pack8(Vn[ks >> 1], ks & 1);
#pragma unroll
                for (int rt = 0; rt < 2; ++rt) { f32x16 O;
#pragma unroll
                    for (int r = 0; r < 16; ++r) O[r] = 0.f;
#pragma unroll
                    for (int ks = 0; ks < 8; ++ks) O = MFMA32(SFRAG(SC_QD, rt * 8 + ks), Spk[ks], O);
#pragma unroll
                    for (int ks = 0; ks < 4; ++ks) O = MFMA32(SFRAG(SC_QK, rt * 4 + ks), Vpk[ks], O);
                    float* op = OG + ((size_t)bb * SEQ + n * 64 + rt * 32) * BW + h * 128 + sl * 32 + r32;
#pragma unroll
                    for (int i = 0; i < 16; ++i) op[(size_t)crow(i, hi) * BW] = O[i]; }
                const float g = *(const float*)(base + SC_GL);
#pragma unroll
                for (int b4 = 0; b4 < 4; ++b4) {
#pragma unroll
                    for (int r = 0; r < 16; ++r) S[b4][r] *= g;
#pragma unroll
                    for (int ks = 0; ks < 4; ++ks) S[b4] = MFMA32(SFRAG(SC_KDT, b4 * 4 + ks), Vpk[ks], S[b4]); }
#undef SFRAG
            }
            __syncthreads();
        }
    }
    __syncthreads();
}

__device__ __forceinline__ void phase_finalize(const Args& a, int l, int wv_) {
    const bf16* P = (const bf16*)(a.ws + WS_PROJ); const float* OG = (const float*)(a.ws + WS_REGB); const float* OATT = (const float*)(a.ws + WS_REGC);
    bf16* Y = (bf16*)(a.ws + WS_REGD);
    int tid_ = wv_ * 64 + mk_lane(); asm volatile("" : "+v"(tid_)); const int tid = tid_, lane = tid & 63, wave = tid >> 6;
    const int gw = blockIdx.x * NWAVES + wave, NGW = gridDim.x * NWAVES;
    const float lam_init = 0.8f - 0.6f * expf(-0.3f * (float)l);
    const float* lv = a.diff_lambda + (size_t)l * 256;
    const float lam = expf(wave_sum(lv[lane] * lv[64 + lane])) - expf(wave_sum(lv[128 + lane] * lv[192 + lane])) + lam_init;
    const int e0 = (lane & 15) * 8, hh = lane >> 4, c0 = lane * 8;
    float gnw[8], dnw[8], scw[3][8];
#pragma unroll
    for (int j = 0; j < 8; ++j) { gnw[j] = a.gdn_norm_w[l * 128 + e0 + j]; dnw[j] = a.diff_norm_w[l * 128 + e0 + j] * (1.f - lam_init);
#pragma unroll
        for (int k = 0; k < 3; ++k) scw[k][j] = a.sc_conv_w[((size_t)l * 3 + k) * BW + c0 + j]; }
    for (int row = gw; row < M; row += NGW) {
        const int t = row & (SEQ - 1);
        const bf16* pr = P + (size_t)row * NP;
        float y[8], z[8];
        { const f32x4 o0 = *(const f32x4*)(OG + (size_t)row * BW + c0), o1 = *(const f32x4*)(OG + (size_t)row * BW + c0 + 4);
          float o[8] = {o0.x, o0.y, o0.z, o0.w, o1.x, o1.y, o1.z, o1.w}; float ss = 0.f;
#pragma unroll
          for (int j = 0; j < 8; ++j) ss += o[j] * o[j];
          ss += __shfl_xor(ss, 1); ss += __shfl_xor(ss, 2); ss += __shfl_xor(ss, 4); ss += __shfl_xor(ss, 8);
          const float rs = rsqrtf(ss * (1.f / 128.f) + EPS); ld8(pr + C_GZ + c0, z);
#pragma unroll
          for (int j = 0; j < 8; ++j) y[j] = o[j] * rs * gnw[j] * siluf_(z[j]);
          st8(Y + (size_t)row * BW + c0, y); }
        { const float* op = OATT + (((size_t)row * 4 + hh) * 2) * 128 + e0;
          const f32x4 a0 = *(const f32x4*)op, a1 = *(const f32x4*)(op + 4), b0 = *(const f32x4*)(op + 128), b1 = *(const f32x4*)(op + 132);
          float d[8] = {a0.x - lam * b0.x, a0.y - lam * b0.y, a0.z - lam * b0.z, a0.w - lam * b0.w, a1.x - lam * b1.x, a1.y - lam * b1.y, a1.z - lam * b1.z, a1.w - lam * b1.w}; float ss = 0.f;
#pragma unroll
          for (int j = 0; j < 8; ++j) ss += d[j] * d[j];
          ss += __shfl_xor(ss, 1); ss += __shfl_xor(ss, 2); ss += __shfl_xor(ss, 4); ss += __shfl_xor(ss, 8);
          const float rs = rsqrtf(ss * (1.f / 128.f) + EPS); ld8(pr + C_DZ + c0, z);
#pragma unroll
          for (int j = 0; j < 8; ++j) y[j] = d[j] * rs * dnw[j] * siluf_(z[j]);
          st8(Y + (size_t)M * BW + (size_t)row * BW + c0, y); }
        { float acc[8];
#pragma unroll
          for (int j = 0; j < 8; ++j) acc[j] = 0.f;
#pragma unroll
          for (int k = 0; k < 3; ++k) { const int tt = t - 2 + k; if (tt >= 0) { float cc[8], xx[8]; const bf16* p2 = P + (size_t)(row - 2 + k) * NP; ld8(p2 + C_SC + c0, cc); ld8(p2 + C_SX + c0, xx);
#pragma unroll
              for (int j = 0; j < 8; ++j) acc[j] += scw[k][j] * (cc[j] * xx[j]); } }
          float sb[8]; ld8(pr + C_SB + c0, sb); ld8(pr + C_SZ + c0, z);
#pragma unroll
          for (int j = 0; j < 8; ++j) y[j] = sb[j] * acc[j] * siluf_(z[j]);
          st8(Y + 2 * (size_t)M * BW + (size_t)row * BW + c0, y); }
    }
}

__device__ __forceinline__ void phase_postnorm(const Args& a, int l, int wv_) {
    const float* OUT = (const float*)(a.ws + WS_REGC); bf16* H = (bf16*)(a.ws + WS_REGB);
    const float* xin = (l == 0) ? a.x : a.out;
    int tid_ = wv_ * 64 + mk_lane(); asm volatile("" : "+v"(tid_)); const int tid = tid_, lane = tid & 63, wave = tid >> 6;
    const int gw = blockIdx.x * NWAVES + wave, NGW = gridDim.x * NWAVES;
    const float* wpost = a.norm_post + (size_t)l * DM; const float* wpre = a.norm_pre + (size_t)(l + 1 < DEPTH ? l + 1 : l) * DM;
    for (int row = gw; row < M; row += NGW) {
        f32x4 o[4], x[4]; float s = 0.f;
#pragma unroll
        for (int j = 0; j < 4; ++j) { o[j] = *(const f32x4*)(OUT + (size_t)row * DM + 4 * lane + 256 * j); x[j] = *(const f32x4*)(xin + (size_t)row * DM + 4 * lane + 256 * j);
            s += (o[j].x * o[j].x + o[j].y * o[j].y) + (o[j].z * o[j].z + o[j].w * o[j].w); }
        const float rs = rsqrtf(wave_sum(s) * (1.f / DM) + EPS); float s2 = 0.f;
#pragma unroll
        for (int j = 0; j < 4; ++j) { const f32x4 w = *(const f32x4*)(wpost + 4 * lane + 256 * j); x[j] = x[j] + o[j] * rs * w; *(f32x4*)(a.out + (size_t)row * DM + 4 * lane + 256 * j) = x[j];
            s2 += (x[j].x * x[j].x + x[j].y * x[j].y) + (x[j].z * x[j].z + x[j].w * x[j].w); }
        if (l + 1 < DEPTH) { const float rs2 = rsqrtf(wave_sum(s2) * (1.f / DM) + EPS);
#pragma unroll
            for (int j = 0; j < 4; ++j) { const f32x4 w = *(const f32x4*)(wpre + 4 * lane + 256 * j); v2u ob; ob.x = pk2(x[j].x * rs2 * w.x, x[j].y * rs2 * w.y); ob.y = pk2(x[j].z * rs2 * w.z, x[j].w * rs2 * w.w);
                *(v2u*)(H + (size_t)row * DM + 4 * lane + 256 * j) = ob; } }
    }
}

constexpr int ARGS_OFF = 143360;
constexpr int ARGS_WORDS = (int)(sizeof(Args) / 4);
#ifndef PROBE_SEL
#define PROBE_SEL -1
#endif
constexpr int TS_OFF = ARGS_OFF + 512;
__device__ __forceinline__ void ts_mark(unsigned char* lds, int k) {
    if (PROBE_SEL >= 0 && blockIdx.x == 0 && threadIdx.x == 0) { volatile LAS unsigned long long* p = (volatile LAS unsigned long long*)((LAS unsigned char*)lds + TS_OFF);
        const unsigned long long t = __builtin_amdgcn_s_memrealtime(); p[1 + k] += t - p[0]; p[0] = t; }
}
__device__ __forceinline__ void load_args(Args& b, unsigned char* lds) {
    volatile LAS unsigned* s = (volatile LAS unsigned*)((LAS unsigned char*)lds + ARGS_OFF); unsigned w[ARGS_WORDS];
#pragma unroll
    for (int i = 0; i < ARGS_WORDS; ++i) w[i] = (unsigned)__builtin_amdgcn_readfirstlane((int)s[i]);
    __builtin_memcpy(&b, w, sizeof(Args));
}
template <int L> __device__ __forceinline__ void run_layer(unsigned char* lds, cg::grid_group& grid, int wv) {
    PG8_LAS unsigned char* lds3 = (PG8_LAS unsigned char*)lds;
    constexpr int l = L;
    {
        Args a; load_args(a, lds); const int G = gridDim.x;
        bf16* WIN = (bf16*)(a.ws + WS_WIN); bf16* PROJ = (bf16*)(a.ws + WS_PROJ); float* BA = (float*)(a.ws + WS_BA); bf16* REGB = (bf16*)(a.ws + WS_REGB);
        pg8::Gemm g{REGB, WIN + (size_t)l * WIN_L, M, NPAD, DM}; pg8::StaticOrder S; S.init(M, NPAD, G, (int)blockIdx.x);
        EpiProj E{PROJ, BA};
        pg8::gemm_phase<EpiProj, pg8::StaticOrder, true, true>(lds3, g, S, E, wv);
    }
    grid.sync();
    ts_mark(lds, 1);
    { Args a; load_args(a, lds); phase_gdn_local(a, lds, l, wv); }
    grid.sync();
    ts_mark(lds, 2);
    { Args a; load_args(a, lds); phase_gdn_scan(a, lds, l, wv); }
    ts_mark(lds, 4);
    { Args a; load_args(a, lds); phase_attn(a, lds, l, wv); }
    grid.sync();
    ts_mark(lds, 3);
    { Args a; load_args(a, lds); phase_finalize(a, l, wv); }
    grid.sync();
    ts_mark(lds, 5);
    {
        Args a; load_args(a, lds); const int G = gridDim.x;
        bf16* WBR = (bf16*)(a.ws + WS_WBR); bf16* PROJ = (bf16*)(a.ws + WS_PROJ); bf16* REGB = (bf16*)(a.ws + WS_REGB); float* REGC = (float*)(a.ws + WS_REGC); bf16* Y = (bf16*)(a.ws + WS_REGD);
        pg8::StaticOrder S0; S0.init(M, DM, G, (int)blockIdx.x); pg8::Unit u0; BranchOrder S{0, 0};
        if (S0.next(0, u0)) { S.pm0 = u0.pm; S.pn0 = u0.pn; }
        pg8::Gemm g{Y, WBR + (size_t)l * 3 * DM * BW, 3 * M, 3 * DM, BW}; EpiBranch E{PROJ, REGC, REGB};
        pg8::gemm_phase<EpiBranch, BranchOrder, true, true>(lds3, g, S, E, wv);
    }
    grid.sync();
    ts_mark(lds, 6);
    {
        Args a; load_args(a, lds); const int G = gridDim.x;
        bf16* WOUT = (bf16*)(a.ws + WS_WOUT); bf16* REGB = (bf16*)(a.ws + WS_REGB); float* REGC = (float*)(a.ws + WS_REGC);
        pg8::Gemm g{REGB, WOUT + (size_t)l * DM * DM, M, DM, DM}; pg8::StaticOrder S; S.init(M, DM, G, (int)blockIdx.x);
        EpiOutF32 E{REGC};
        pg8::gemm_phase<EpiOutF32, pg8::StaticOrder, true, true>(lds3, g, S, E, wv);
    }
    grid.sync();
    ts_mark(lds, 7);
    { Args a; load_args(a, lds); phase_postnorm(a, l, wv); }
    if (L + 1 < DEPTH) grid.sync();
    ts_mark(lds, 8);
}
__global__ void __launch_bounds__(NTHR, 2) fwd(Args a0) {
    extern __shared__ __attribute__((aligned(16))) unsigned char lds[];
    cg::grid_group grid = cg::this_grid();
    const int wv = __builtin_amdgcn_readfirstlane((int)threadIdx.x >> 6);
    if (threadIdx.x == 0) { unsigned w[ARGS_WORDS]; __builtin_memcpy(w, &a0, sizeof(Args));
#pragma unroll
        for (int i = 0; i < ARGS_WORDS; ++i) ((volatile LAS unsigned*)((LAS unsigned char*)lds + ARGS_OFF))[i] = w[i]; }
    if (PROBE_SEL >= 0 && threadIdx.x == 0) { volatile LAS unsigned long long* p = (volatile LAS unsigned long long*)((LAS unsigned char*)lds + TS_OFF); for (int i = 1; i < 17; ++i) p[i] = 0; p[0] = __builtin_amdgcn_s_memrealtime(); }
    __syncthreads();
    { Args a; load_args(a, lds); phase_prologue(a, lds, wv); }
    grid.sync();
    ts_mark(lds, 0);
    run_layer<0>(lds, grid, wv);
    run_layer<1>(lds, grid, wv);
    run_layer<2>(lds, grid, wv);
    run_layer<3>(lds, grid, wv);
    if (PROBE_SEL >= 0 && blockIdx.x == 0 && threadIdx.x == 0) { volatile LAS unsigned long long* p = (volatile LAS unsigned long long*)((LAS unsigned char*)lds + TS_OFF);
        Args a; load_args(a, lds); a.out[0] = floorf((float)p[1 + PROBE_SEL] * 0.01f * 0.02f + 0.5f) * 50.f; }
}

extern "C" void kernel_launch(void* const* d_in, const int* in_sizes, int n_in, void* d_out, int out_size, void* d_ws, size_t ws_size, hipStream_t stream) {
    static int grid = 0;
    if (grid == 0) {
        if (n_in != 13 || ws_size < WS_END) { fprintf(stderr, "kernel_launch: unexpected n_in %d or ws %zu\n", n_in, ws_size); grid = -1; return; }
        int dev = 0, cus = 0, per_cu = 0;
        hipGetDevice(&dev); hipDeviceGetAttribute(&cus, hipDeviceAttributeMultiprocessorCount, dev);
        hipFuncSetAttribute((const void*)fwd, hipFuncAttributeMaxDynamicSharedMemorySize, LDS_BYTES);
        hipOccupancyMaxActiveBlocksPerMultiprocessor(&per_cu, (const void*)fwd, NTHR, LDS_BYTES);
        (void)hipGetLastError();
        if (per_cu < 1) { fprintf(stderr, "kernel_launch: occupancy query says %d\n", per_cu); per_cu = 1; }
        grid = cus;
    }
    if (grid < 0) return;
    Args a{};
    a.x = (const float*)d_in[0]; a.norm_pre = (const float*)d_in[1]; a.norm_post = (const float*)d_in[2]; a.w_in = (const float*)d_in[3]; a.gdn_conv_w = (const float*)d_in[4];
    a.gdn_a_log = (const float*)d_in[5]; a.gdn_dt_bias = (const float*)d_in[6]; a.gdn_norm_w = (const float*)d_in[7]; a.diff_lambda = (const float*)d_in[8]; a.diff_norm_w = (const float*)d_in[9];
    a.sc_conv_w = (const float*)d_in[10]; a.w_branch = (const float*)d_in[11]; a.w_out = (const float*)d_in[12];
    a.out = (float*)d_out; a.ws = (unsigned char*)d_ws; a.ph_lo = 0; a.ph_hi = 0; a.coop = 1; a.pad = 0;
    void* args[] = {&a};
    hipError_t e = hipLaunchCooperativeKernel((const void*)fwd, dim3(grid), dim3(NTHR), args, LDS_BYTES, stream);
    if (e != hipSuccess) fprintf(stderr, "cooperative launch failed: %s (grid %d)\n", hipGetErrorString(e), grid);
}
```

```cpp
#include <hip/hip_runtime.h>
#include <hip/hip_cooperative_groups.h>
#include <cstdio>
#include <cstdint>
namespace cg = cooperative_groups;
__device__ __forceinline__ int mk_lane() { int r; asm volatile("v_mbcnt_lo_u32_b32 %0, -1, 0\n\tv_mbcnt_hi_u32_b32 %0, -1, %0" : "=v"(r)); return r; }
namespace pg8 {
#define PG8_LAS __attribute__((address_space(3)))
typedef unsigned short bf16_t;
typedef short bf16x8 __attribute__((ext_vector_type(8)));
typedef float f32x4 __attribute__((ext_vector_type(4)));
typedef unsigned u32x4 __attribute__((ext_vector_type(4)));
constexpr int BM = 256, BK = 64, HALF = 128, HTB = HALF * BK * 2  , STAGE_BYTES = 8 * HTB, NXCD = 8, WGM = 8;

__host__ __device__ __forceinline__ int lds_byte(int r, int c) { const int st = (r >> 4) * 2 + (c >> 5), rr = r & 15, cc = c & 31, ob = rr * 64 + cc * 2; return st * 1024 + (ob ^ (((ob >> 9) & 1) << 5)); }
__host__ __device__ __forceinline__ void stage_rc(int b, int& R, int& C) { const int st = b / 1024, sb = b % 1024, swz = sb ^ (((sb >> 9) & 1) << 5); R = (st >> 1) * 16 + swz / 64; C = (st & 1) * 32 + (swz % 64) / 2; }
__host__ __device__ __forceinline__ int perm32(int rho) { const int n = rho >> 4, i = rho & 15; return 8 * (i >> 2) + 4 * n + (i & 3); }

struct Unit { int pm, pn; };
struct Gemm { const bf16_t* A; const bf16_t* Bt; int M, N, K; };

struct StaticOrder {
    int nM, nN, nwg, G, c;
    __host__ __device__ void init(int M, int N, int G_, int c_) { nM = M / BM; nN = N / BM; nwg = nM * nN; G = G_; c = c_; }
    __host__ __device__ bool next(int i, Unit& u) const {
        const long L = (long)i * G + c; if (L >= nwg) return false;
        int wgid = (int)L; { const int q = nwg / NXCD, r = nwg % NXCD, xcd = wgid % NXCD, off = wgid / NXCD; wgid = (xcd < r ? xcd * (q + 1) : r * (q + 1) + (xcd - r) * q) + off; }
        const int nig = WGM * nN, gid = wgid / nig, fm = gid * WGM, gsz = (nM - fm) < WGM ? (nM - fm) : WGM;
        u.pm = fm + ((wgid % nig) % gsz); u.pn = (wgid % nig) / gsz; return true;
    }
    __device__ __forceinline__ void a_ready(const Unit&) const {}
    __device__ __forceinline__ void done(const Unit&) const {}
};
__device__ __forceinline__ unsigned cvt_pk_bf16(float lo, float hi) { unsigned r; asm volatile("v_cvt_pk_bf16_f32 %0, %1, %2" : "=v"(r) : "v"(lo), "v"(hi)); return r; }
typedef float f32x2 __attribute__((ext_vector_type(2)));
template <class Epi, class Sched, bool ALIGN_EPI = false, bool SP2 = false>
__device__ __forceinline__ void gemm_phase(PG8_LAS unsigned char* lds, const Gemm g, const Sched& S, const Epi& E, int wv_) {
    int tid_ = wv_ * 64 + mk_lane(); asm volatile("" : "+v"(tid_)); const int tid = tid_, wid = __builtin_amdgcn_readfirstlane(tid >> 6), lane = tid & 63, wr = wid >> 2, wc = wid & 3, fr = lane & 15, fq = lane >> 4;
    const int K = g.K, nt = K / BK;
    unsigned voffA[2], voffB[2];
#pragma unroll
    for (int i = 0; i < 2; ++i) { int R, C; stage_rc(tid * 16 + i * 8192, R, C); const int Rb = Epi::PERM ? ((R & ~31) + perm32(R & 31)) : R;
        voffA[i] = (unsigned)(R * K + C) * 2u; voffB[i] = (unsigned)(Rb * K + C) * 2u; }
    const size_t kstep = (size_t)(BK * 2);
    const size_t hstep = (size_t)HALF * K * 2;
    const size_t tstep = 2 * hstep;
    const unsigned ldsw = (unsigned)wid * 1024u;
    const int aoff = lds_byte(wr * 64 + fr, fq * 8), boff = lds_byte(wc * 32 + fr, fq * 8);
#define PG8_SA(b, h) (((b) * 2 + (h)) * HTB)
#define PG8_SB(b, h) ((4 + (b) * 2 + (h)) * HTB)
#define PG8_STAGE(bufoff, gbase, voff) do { _Pragma("unroll") for (int _i = 0; _i < 2; ++_i) \
        __builtin_amdgcn_global_load_lds((const unsigned*)((const char*)(gbase) + (voff)[_i]), (PG8_LAS unsigned*)(lds + (bufoff) + ldsw + _i * 8192), 16, 0, 0); } while (0)
#define PG8_LDA(dst, b, h) do { _Pragma("unroll") for (int m = 0; m < 4; ++m) _Pragma("unroll") for (int k = 0; k < 2; ++k) dst[m][k] = *(const PG8_LAS bf16x8*)(lds + PG8_SA(b, h) + aoff + m * 2048 + k * 1024); } while (0)
#define PG8_LDB(dst, b, h) do { _Pragma("unroll") for (int n = 0; n < 2; ++n) _Pragma("unroll") for (int k = 0; k < 2; ++k) dst[n][k] = *(const PG8_LAS bf16x8*)(lds + PG8_SB(b, h) + boff + n * 2048 + k * 1024); } while (0)
#define PG8_MMA(ai, bj, At, Bt) do { __builtin_amdgcn_s_setprio(1); _Pragma("unroll") for (int m = 0; m < 4; ++m) _Pragma("unroll") for (int n = 0; n < 2; ++n) _Pragma("unroll") for (int k = 0; k < 2; ++k) \
        acc[ai][bj][m][n] = __builtin_amdgcn_mfma_f32_16x16x32_bf16(Bt[n][k], At[m][k], acc[ai][bj][m][n], 0, 0, 0); __builtin_amdgcn_s_setprio(0); } while (0)
#define PG8_WAIT_V(n) asm volatile("s_waitcnt vmcnt(" #n ")" ::: "memory")
#define PG8_WAIT_L(n) asm volatile("s_waitcnt lgkmcnt(" #n ")" ::: "memory")
#define PG8_BAR __builtin_amdgcn_s_barrier()
#define PG8_SCHED __builtin_amdgcn_sched_barrier(0)
    Unit cur, nxt; int ui = 0;
    if (!S.next(0, cur)) return;
    f32x4 acc[2][2][4][2];
#pragma unroll
    for (int a = 0; a < 2; ++a)
#pragma unroll
        for (int b = 0; b < 2; ++b)
#pragma unroll
            for (int m = 0; m < 4; ++m)
#pragma unroll
                for (int n = 0; n < 2; ++n) acc[a][b][m][n] = (f32x4){0.f, 0.f, 0.f, 0.f};
    bf16x8 At[4][2], B0[2][2], B1[2][2];
    const char* cA = (const char*)g.A + (size_t)cur.pm * tstep; const char* cB = (const char*)g.Bt + (size_t)cur.pn * tstep;
    S.a_ready(cur);
    if constexpr (SP2) {
        PG8_STAGE(PG8_SB(0, 0), cB, voffB); PG8_STAGE(PG8_SB(0, 1), cB + hstep, voffB); PG8_STAGE(PG8_SA(0, 0), cA, voffA); PG8_STAGE(PG8_SA(0, 1), cA + hstep, voffA);
        if (wr == 1) PG8_BAR;
        PG8_WAIT_V(2); PG8_BAR;
        PG8_STAGE(PG8_SB(1, 0), cB + kstep, voffB); PG8_STAGE(PG8_SA(1, 0), cA + kstep, voffA); PG8_STAGE(PG8_SB(1, 1), cB + hstep + kstep, voffB);
        PG8_WAIT_V(6); PG8_BAR;
    } else {
        PG8_STAGE(PG8_SB(0, 0), cB, voffB); PG8_STAGE(PG8_SA(0, 0), cA, voffA); PG8_STAGE(PG8_SB(0, 1), cB + hstep, voffB); PG8_STAGE(PG8_SA(0, 1), cA + hstep, voffA);
        if (wr == 1) PG8_BAR;
        PG8_WAIT_V(4); PG8_BAR;
        PG8_STAGE(PG8_SB(1, 0), cB + kstep, voffB); PG8_STAGE(PG8_SA(1, 0), cA + kstep, voffA); PG8_STAGE(PG8_SB(1, 1), cB + hstep + kstep, voffB);
        PG8_WAIT_V(6); PG8_BAR;
    }
    for (;;) {
        const bool has_next = S.next(ui + 1, nxt);
        const char* nA = has_next ? (const char*)g.A + (size_t)nxt.pm * tstep : cA; const char* nB = has_next ? (const char*)g.Bt + (size_t)nxt.pn * tstep : cB;
        for (int t = 0; t < nt; t += 2) {
            const bool last = (t == nt - 2);
            const char* a1 = cA + (size_t)(t + 1) * kstep;
            const char* a2 = last ? nA : cA + (size_t)(t + 2) * kstep; const char* b2 = last ? nB : cB + (size_t)(t + 2) * kstep;
            const char* a3 = a2 + kstep; const char* b3 = b2 + kstep;
            if (last && has_next) S.a_ready(nxt);
            if constexpr (SP2) {
            PG8_LDB(B0, 0, 0); PG8_LDB(B1, 0, 1); PG8_SCHED; PG8_LDA(At, 0, 0); PG8_STAGE(PG8_SA(1, 1), a1 + hstep, voffA);
            PG8_WAIT_V(8); PG8_WAIT_L(0); PG8_BAR; PG8_MMA(0, 0, At, B0); PG8_MMA(0, 1, At, B1); PG8_BAR; PG8_SCHED;
            PG8_LDA(At, 0, 1); PG8_STAGE(PG8_SB(0, 0), b2, voffB); PG8_STAGE(PG8_SB(0, 1), b2 + hstep, voffB); PG8_STAGE(PG8_SA(0, 0), a2, voffA);
            PG8_WAIT_V(8); PG8_WAIT_L(0); PG8_BAR; PG8_MMA(1, 0, At, B0); PG8_MMA(1, 1, At, B1); PG8_BAR; PG8_SCHED;
            PG8_LDB(B0, 1, 0); PG8_LDB(B1, 1, 1); PG8_SCHED; PG8_LDA(At, 1, 0); PG8_STAGE(PG8_SA(0, 1), a2 + hstep, voffA);
            PG8_WAIT_V(8); PG8_WAIT_L(0); PG8_BAR; PG8_MMA(0, 0, At, B0); PG8_MMA(0, 1, At, B1); PG8_BAR; PG8_SCHED;
            PG8_LDA(At, 1, 1); PG8_STAGE(PG8_SB(1, 0), b3, voffB); PG8_STAGE(PG8_SB(1, 1), b3 + hstep, voffB); PG8_STAGE(PG8_SA(1, 0), a3, voffA);
            PG8_WAIT_V(8); PG8_WAIT_L(0); PG8_BAR; PG8_MMA(1, 0, At, B0); PG8_MMA(1, 1, At, B1); PG8_BAR; PG8_SCHED;
            } else {
            PG8_LDB(B0, 0, 0); PG8_SCHED; PG8_LDA(At, 0, 0); PG8_STAGE(PG8_SA(1, 1), a1 + hstep, voffA);
            PG8_WAIT_L(8); PG8_BAR; PG8_WAIT_L(0); PG8_MMA(0, 0, At, B0); PG8_BAR; PG8_SCHED;
            PG8_LDB(B1, 0, 1); PG8_STAGE(PG8_SB(0, 0), b2, voffB);
            PG8_BAR; PG8_WAIT_L(0); PG8_MMA(0, 1, At, B1); PG8_BAR;
            PG8_LDA(At, 0, 1); PG8_STAGE(PG8_SA(0, 0), a2, voffA);
            PG8_BAR; PG8_WAIT_L(0); PG8_MMA(1, 0, At, B0); PG8_BAR; PG8_SCHED;
            PG8_STAGE(PG8_SB(0, 1), b2 + hstep, voffB);
            PG8_WAIT_V(6); PG8_BAR; PG8_MMA(1, 1, At, B1); PG8_BAR;
            PG8_LDB(B0, 1, 0); PG8_SCHED; PG8_LDA(At, 1, 0); PG8_STAGE(PG8_SA(0, 1), a2 + hstep, voffA);
            PG8_WAIT_L(8); PG8_BAR; PG8_WAIT_L(0); PG8_MMA(0, 0, At, B0); PG8_BAR; PG8_SCHED;
            PG8_LDB(B1, 1, 1); PG8_STAGE(PG8_SB(1, 0), b3, voffB);
            PG8_BAR; PG8_WAIT_L(0); PG8_MMA(0, 1, At, B1); PG8_BAR;
            PG8_LDA(At, 1, 1); PG8_STAGE(PG8_SA(1, 0), a3, voffA);
            PG8_BAR; PG8_WAIT_L(0); PG8_MMA(1, 0, At, B0); PG8_BAR; PG8_SCHED;
            PG8_STAGE(PG8_SB(1, 1), b3 + hstep, voffB);
            PG8_WAIT_V(6); PG8_BAR; PG8_MMA(1, 1, At, B1); PG8_BAR;
            }
        }
        if constexpr (ALIGN_EPI) { if (wr == 0) PG8_BAR; }
        if constexpr (!Epi::AFTER_DRAIN) { E(acc, cur, wr, wc, fr, fq); S.done(cur); }
        if (!has_next) break;
#pragma unroll
        for (int a = 0; a < 2; ++a)
#pragma unroll
            for (int b = 0; b < 2; ++b)
#pragma unroll
                for (int m = 0; m < 4; ++m)
#pragma unroll
                    for (int n = 0; n < 2; ++n) acc[a][b][m][n] = (f32x4){0.f, 0.f, 0.f, 0.f};
        cur = nxt; cA = nA; cB = nB; ++ui;
        if constexpr (ALIGN_EPI) { if (wr == 1) PG8_BAR; }
    }
    PG8_WAIT_V(0);
    if constexpr (!ALIGN_EPI) { if (wr == 0) PG8_BAR; }
    PG8_BAR;
    if constexpr (Epi::AFTER_DRAIN) { E.fused(acc, cur, wr, wc, fr, fq, lds, wid, lane); S.done(cur); }
#undef PG8_SA
#undef PG8_SB
#undef PG8_STAGE
#undef PG8_LDA
#undef PG8_LDB
#undef PG8_MMA
#undef PG8_WAIT_V
#undef PG8_WAIT_L
#undef PG8_BAR
#undef PG8_SCHED
}
}
constexpr int BATCH = 2, SEQ = 8192, DM = 1024, DEPTH = 4, M = BATCH * SEQ;
constexpr int NIN = 9224, NP = 9216, NPAD = 9472, BW = 512;
constexpr int C_GQ = 0, C_GK = 512, C_GV = 1024, C_GZ = 1536, C_DQ = 2048, C_DK = 2560, C_DV = 3072, C_DZ = 3584,
              C_SB = 4096, C_SC = 4608, C_SX = 5120, C_SZ = 5632, C_MG = 6144;
constexpr float EPS = 1e-6f;
constexpr int NWAVES = 8, NTHR = 512;
constexpr int LDS_BYTES = 147456;
constexpr size_t MiB = 1u << 20;
constexpr size_t WS_CTL = 0;
constexpr size_t WS_WIN = 2 * MiB;
constexpr size_t WIN_L = (size_t)NPAD * DM;
constexpr size_t WS_WBR = 76 * MiB;
constexpr size_t WS_WOUT = 88 * MiB;
constexpr size_t WS_PROJ = 96 * MiB;
constexpr size_t WS_BA = 384 * MiB;
constexpr size_t WS_REGB = 386 * MiB;
constexpr size_t WS_REGC = 418 * MiB;
constexpr size_t WS_REGD = 482 * MiB;
constexpr size_t WS_GL = 554 * MiB;
constexpr size_t WS_END = 555 * MiB;
constexpr int NUNIT = BATCH * 4 * 128;
constexpr size_t UREC = 36864, R_W = 0, R_QD = 8192, R_KD = 16384, R_QK = 24576, R_U = 28672;

typedef unsigned short bf16;
typedef unsigned v4u __attribute__((ext_vector_type(4)));
typedef unsigned v2u __attribute__((ext_vector_type(2)));
typedef float f32x4 __attribute__((ext_vector_type(4)));
#define LAS __attribute__((address_space(3)))

__device__ __forceinline__ unsigned f2bf(float f) { unsigned u = __builtin_bit_cast(unsigned, f); return (u + 0x7fffu + ((u >> 16) & 1u)) >> 16; }
__device__ __forceinline__ unsigned pk2(float lo, float hi) { return f2bf(lo) | (f2bf(hi) << 16); }
__device__ __forceinline__ float bf2f(unsigned short b) { return __builtin_bit_cast(float, (unsigned)b << 16); }
__device__ __forceinline__ float bflo(unsigned w) { return __builtin_bit_cast(float, w << 16); }
__device__ __forceinline__ float bfhi(unsigned w) { return __builtin_bit_cast(float, w & 0xffff0000u); }
__device__ __forceinline__ void ld8(const bf16* p, float* f) { const v4u w = *(const v4u*)p; f[0] = bflo(w.x); f[1] = bfhi(w.x); f[2] = bflo(w.y); f[3] = bfhi(w.y); f[4] = bflo(w.z); f[5] = bfhi(w.z); f[6] = bflo(w.w); f[7] = bfhi(w.w); }
__device__ __forceinline__ void st8(bf16* p, const float* f) { v4u w; w.x = pk2(f[0], f[1]); w.y = pk2(f[2], f[3]); w.z = pk2(f[4], f[5]); w.w = pk2(f[6], f[7]); *(v4u*)p = w; }
__device__ __forceinline__ float wave_sum(float v) {
#pragma unroll
    for (int o = 1; o < 64; o <<= 1) v += __shfl_xor(v, o);
    return v;
}
__device__ __forceinline__ float sigmoidf_(float x) { return 1.f / (1.f + __expf(-x)); }
__device__ __forceinline__ float siluf_(float x) { return x / (1.f + __expf(-x)); }
__device__ __forceinline__ int srccol(int p) { return p < 2048 ? p : (p < 9216 ? p + 8 : (p < 9224 ? 2048 + (p - 9216) : -1)); }

struct Args {
    const float* x; const float* norm_pre; const float* norm_post; const float* w_in; const float* gdn_conv_w; const float* gdn_a_log; const float* gdn_dt_bias;
    const float* gdn_norm_w; const float* diff_lambda; const float* diff_norm_w; const float* sc_conv_w; const float* w_branch; const float* w_out;
    float* out; unsigned char* ws; int ph_lo, ph_hi, coop, pad;
};

struct EpiProj {
    static constexpr bool PERM = true, AFTER_DRAIN = false;
    bf16* P; float* BA;
    __device__ __forceinline__ void operator()(const pg8::f32x4 (&acc)[2][2][4][2], const pg8::Unit& u, int wr, int wc, int fr, int fq) const {
        const int row0 = u.pm * 256 + wr * 64 + fr;
        if (u.pn == 36) {
            if (wc == 0 && fq == 0) {
#pragma unroll
                for (int ai = 0; ai < 2; ++ai)
#pragma unroll
                    for (int m = 0; m < 4; ++m) { float* o = BA + (size_t)(row0 + ai * 128 + m * 16) * 8; *(pg8::f32x4*)o = acc[ai][0][m][0]; *(pg8::f32x4*)(o + 4) = acc[ai][0][m][1]; }
            }
            return;
        }
        const int colt = u.pn * 256; const float sc = (colt >= C_DQ && colt < C_DK) ? 0.18033688011112042f : 1.f;
        const int col0 = colt + wc * 32 + 8 * fq;
#pragma unroll
        for (int ai = 0; ai < 2; ++ai)
#pragma unroll
            for (int m = 0; m < 4; ++m) { bf16* rowp = P + (size_t)(row0 + ai * 128 + m * 16) * NP + col0;
#pragma unroll
                for (int bj = 0; bj < 2; ++bj) { const pg8::f32x4 v0 = acc[ai][bj][m][0] * sc, v1 = acc[ai][bj][m][1] * sc; v4u w;
                    w.x = pg8::cvt_pk_bf16(v0[0], v0[1]); w.y = pg8::cvt_pk_bf16(v0[2], v0[3]); w.z = pg8::cvt_pk_bf16(v1[0], v1[1]); w.w = pg8::cvt_pk_bf16(v1[2], v1[3]);
                    *(v4u*)(rowp + bj * 128) = w; } }
    }
};
struct BranchOrder {
    int pm0, pn0;
    __device__ __forceinline__ bool next(int i, pg8::Unit& u) const { if (i >= 3) return false; u.pm = i * 64 + pm0; u.pn = i * 4 + pn0; return true; }
    __device__ __forceinline__ void a_ready(const pg8::Unit&) const {}
    __device__ __forceinline__ void done(const pg8::Unit&) const {}
};
struct EpiBranch {
    static constexpr bool PERM = true, AFTER_DRAIN = false;
    const bf16* P; float* MG; bf16* MB;
    __device__ __forceinline__ void operator()(const pg8::f32x4 (&acc)[2][2][4][2], const pg8::Unit& u, int wr, int wc, int fr, int fq) const {
        const int kb = u.pn >> 2;
        const int row0 = (u.pm & 63) * 256 + wr * 64 + fr; const int col0 = (u.pn & 3) * 256 + wc * 32 + 8 * fq;
#pragma unroll
        for (int ai = 0; ai < 2; ++ai)
#pragma unroll
            for (int m = 0; m < 4; ++m) { const size_t row = (size_t)(row0 + ai * 128 + m * 16);
#pragma unroll
                for (int bj = 0; bj < 2; ++bj) { const int col = col0 + bj * 128; float lg[8]; ld8(P + row * NP + C_MG + kb * 1024 + col, lg);
                    float v[8];
#pragma unroll
                    for (int j = 0; j < 4; ++j) { v[j] = acc[ai][bj][m][0][j] * sigmoidf_(lg[j]); v[4 + j] = acc[ai][bj][m][1][j] * sigmoidf_(lg[4 + j]); }
                    float* mp = MG + row * DM + col;
                    if (kb > 0) { const pg8::f32x4 a = *(const pg8::f32x4*)mp, b = *(const pg8::f32x4*)(mp + 4);
#pragma unroll
                        for (int j = 0; j < 4; ++j) { v[j] += a[j]; v[4 + j] += b[j]; } }
                    if (kb < 2) { *(pg8::f32x4*)mp = (pg8::f32x4){v[0], v[1], v[2], v[3]}; *(pg8::f32x4*)(mp + 4) = (pg8::f32x4){v[4], v[5], v[6], v[7]}; }
                    else st8(MB + row * DM + col, v); } }
    }
};
struct EpiOutF32 {
    static constexpr bool PERM = true, AFTER_DRAIN = false;
    float* O;
    __device__ __forceinline__ void operator()(const pg8::f32x4 (&acc)[2][2][4][2], const pg8::Unit& u, int wr, int wc, int fr, int fq) const {
        const int row0 = u.pm * 256 + wr * 64 + fr; const int col0 = u.pn * 256 + wc * 32 + 8 * fq;
#pragma unroll
        for (int ai = 0; ai < 2; ++ai)
#pragma unroll
            for (int m = 0; m < 4; ++m) { float* rowp = O + (size_t)(row0 + ai * 128 + m * 16) * DM + col0;
#pragma unroll
                for (int bj = 0; bj < 2; ++bj) { *(pg8::f32x4*)(rowp + bj * 128) = acc[ai][bj][m][0]; *(pg8::f32x4*)(rowp + bj * 128 + 4) = acc[ai][bj][m][1]; } }
    }
};

__device__ __forceinline__ void tr_item(const float* W, int ldw, int K, bf16* WT, int k0, int p0, int mode, float* scr, int lane) {
    const int n = lane & 31; const int p = p0 + n; const int sc = mode ? srccol(p) : p;
#pragma unroll 8
    for (int i = 0; i < 32; ++i) { const int kk = 2 * i + (lane >> 5); scr[kk * 33 + n] = sc >= 0 ? W[(size_t)(k0 + kk) * ldw + sc] : 0.f; }
    asm volatile("s_waitcnt lgkmcnt(0)" ::: "memory");
    const int c = lane & 7;
#pragma unroll
    for (int j = 0; j < 4; ++j) { const int nn = (lane >> 3) + 8 * j; const float* s = scr + (8 * c) * 33 + nn;
        v4u o; o.x = pk2(s[0 * 33], s[1 * 33]); o.y = pk2(s[2 * 33], s[3 * 33]); o.z = pk2(s[4 * 33], s[5 * 33]); o.w = pk2(s[6 * 33], s[7 * 33]);
        *(v4u*)(WT + (size_t)(p0 + nn) * K + k0 + 8 * c) = o; }
    asm volatile("s_waitcnt lgkmcnt(0)" ::: "memory");
}
__device__ __forceinline__ void norm_row_to_h(const float* xrow, const float* wpre, bf16* hrow, int lane) {
    f32x4 v[4]; float s = 0.f;
#pragma unroll
    for (int j = 0; j < 4; ++j) { v[j] = *(const f32x4*)(xrow + 4 * lane + 256 * j); s += (v[j].x * v[j].x + v[j].y * v[j].y) + (v[j].z * v[j].z + v[j].w * v[j].w); }
    const float rs = rsqrtf(wave_sum(s) * (1.f / DM) + EPS);
#pragma unroll
    for (int j = 0; j < 4; ++j) { const f32x4 w = *(const f32x4*)(wpre + 4 * lane + 256 * j); v2u o; o.x = pk2(v[j].x * rs * w.x, v[j].y * rs * w.y); o.y = pk2(v[j].z * rs * w.z, v[j].w * rs * w.w);
        *(v2u*)(hrow + 4 * lane + 256 * j) = o; }
}
__device__ __forceinline__ void phase_prologue(const Args& a, unsigned char* lds, int wv_) {
    int tid_ = wv_ * 64 + mk_lane(); asm volatile("" : "+v"(tid_)); const int tid = tid_, lane = tid & 63, wave = tid >> 6;
    float* scr = (float*)(lds + wave * 16384);
    const int gw = blockIdx.x * NWAVES + wave, NGW = gridDim.x * NWAVES;
    constexpr int I_IN = (DM / 64) * (NPAD / 32), I_BR = (BW / 64) * (DM / 32), I_OUT = (DM / 64) * (DM / 32);
    constexpr int NITEMS = DEPTH * I_IN + DEPTH * 3 * I_BR + DEPTH * I_OUT;
    bf16* win = (bf16*)(a.ws + WS_WIN); bf16* wbr = (bf16*)(a.ws + WS_WBR); bf16* wout = (bf16*)(a.ws + WS_WOUT);
    for (int it = gw; it < NITEMS; it += NGW) {
        int r = it;
        if (r < DEPTH * I_IN) { const int l = r / I_IN; r %= I_IN; const int nb = NPAD / 32, kb = r / nb, pb = r % nb;
            tr_item(a.w_in + (size_t)l * DM * NIN, NIN, DM, win + (size_t)l * WIN_L, kb * 64, pb * 32, 1, scr, lane); continue; }
        r -= DEPTH * I_IN;
        if (r < DEPTH * 3 * I_BR) { const int lk = r / I_BR; r %= I_BR; const int nb = DM / 32, kb = r / nb, pb = r % nb;
            tr_item(a.w_branch + (size_t)lk * BW * DM, DM, BW, wbr + (size_t)lk * DM * BW, kb * 64, pb * 32, 0, scr, lane); continue; }
        r -= DEPTH * 3 * I_BR;
        { const int l = r / I_OUT; r %= I_OUT; const int nb = DM / 32, kb = r / nb, pb = r % nb;
            tr_item(a.w_out + (size_t)l * DM * DM, DM, DM, wout + (size_t)l * DM * DM, kb * 64, pb * 32, 0, scr, lane); }
    }
    if (blockIdx.x == 0 && tid < DEPTH) ((unsigned*)(a.ws + WS_CTL))[64 * tid] = 0u;
    bf16* H = (bf16*)(a.ws + WS_REGB);
    for (int m = gw; m < M; m += NGW) norm_row_to_h(a.x + (size_t)m * DM, a.norm_pre, H + (size_t)m * DM, lane);
}

typedef short bf16x8 __attribute__((ext_vector_type(8)));
typedef float f32x16 __attribute__((ext_vector_type(16)));
typedef float f32x2_t __attribute__((ext_vector_type(2))); typedef __bf16 bf16x2_t __attribute__((ext_vector_type(2)));
__device__ __forceinline__ unsigned cvtpk(float lo, float hi) { f32x2_t v = {lo, hi}; bf16x2_t bb = __builtin_convertvector(v, bf16x2_t); return __builtin_bit_cast(unsigned, bb); }
__device__ __forceinline__ int crow(int r, int hi) { return (r & 3) + 8 * (r >> 2) + 4 * hi; }
#define MFMA32(a, b, c) __builtin_amdgcn_mfma_f32_32x32x16_bf16((a), (b), (c), 0, 0, 0)
constexpr int AT_KS = 0, AT_VT = 64 * 144, AT_BUF = 32768, AT_FS = 65536, AT_CTR = AT_FS + 1024;
__device__ __forceinline__ void phase_attn(const Args& a, unsigned char* lds, int l, int wv_) {
    const bf16* P = (const bf16*)(a.ws + WS_PROJ); float* OATT = (float*)(a.ws + WS_REGC);
    int tid_ = wv_ * 64 + mk_lane(); asm volatile("" : "+v"(tid_)); const int tid = tid_, lane = tid & 63, r32 = lane & 31, hi = lane >> 5, wave = tid >> 6;
    float* fs = (float*)(lds + AT_FS) + wave * 32;
    unsigned* ctr = (unsigned*)(a.ws + WS_CTL) + 64 * l;
#pragma unroll 1
    for (;;) {
        __syncthreads();
        if (tid == 0) *(volatile unsigned*)(lds + AT_CTR) = atomicAdd(ctr, 1u);
        __syncthreads();
        const unsigned uidx = *(volatile unsigned*)(lds + AT_CTR);
        if (uidx >= 512u) break;
        const int stream = (int)(uidx & 15u), qb = 31 - (int)(uidx >> 4);
        const int bb = stream >> 3, h = (stream >> 1) & 3, mp = stream & 1;
        const float slope2 = exp2f(-2.f * (float)(h + 1)) * 1.4426950408889634f;
        const bf16* Kg = P + (size_t)bb * SEQ * NP + C_DK + h * 128 + mp * 64 + (size_t)(tid >> 3) * NP + (tid & 7) * 8;
        const int vp = tid & 31, vc = tid >> 5;
        const bf16* Vg = P + (size_t)bb * SEQ * NP + C_DV + h * 128 + (size_t)(2 * vp) * NP + vc * 8;
        const int vpos = ((2 * vp) & 48) | (((2 * vp) & 4) << 1) | (((2 * vp) & 8) >> 1) | ((2 * vp) & 3);
        {
            const int q0 = qb * 256 + wave * 32, t = q0 + r32;
            bf16x8 qr[4];
            { const bf16* qp = P + ((size_t)bb * SEQ + t) * NP + C_DQ + h * 128 + mp * 64 + hi * 8;
#pragma unroll
              for (int d0 = 0; d0 < 4; ++d0) qr[d0] = *(const bf16x8*)(qp + d0 * 16); }
            float cb[16];
#pragma unroll
            for (int r = 0; r < 16; ++r) cb[r] = slope2 * (float)crow(r, hi);
            f32x16 o[4];
#pragma unroll
            for (int db = 0; db < 4; ++db)
#pragma unroll
                for (int r = 0; r < 16; ++r) o[db][r] = 0.f;
            float m_ref = -1e30f, lsum = 0.f;
            const int ntile = 4 * qb + 4;
            v4u kreg, vreg0, vreg1;
#define AT_LOAD(tile) do { const size_t jo_ = (size_t)(tile) * 64 * NP; kreg = *(const v4u*)(Kg + jo_); vreg0 = *(const v4u*)(Vg + jo_); vreg1 = *(const v4u*)(Vg + jo_ + NP); } while (0)
#define AT_STORE(bufo) do { *(v4u*)(lds + (bufo) + AT_KS + (tid >> 3) * 144 + (tid & 7) * 16) = kreg; \
                unsigned* vt_ = (unsigned*)(lds + (bufo) + AT_VT + (vc * 8) * 144 + vpos * 2); \
                const unsigned a_[4] = {vreg0.x, vreg0.y, vreg0.z, vreg0.w}, b_[4] = {vreg1.x, vreg1.y, vreg1.z, vreg1.w}; \
                _Pragma("unroll") for (int x = 0; x < 4; ++x) { vt_[(2 * x) * 36] = (a_[x] & 0xffffu) | (b_[x] << 16); vt_[(2 * x + 1) * 36] = (a_[x] >> 16) | (b_[x] & 0xffff0000u); } } while (0)
            AT_LOAD(ntile - 1);
            __syncthreads();
            AT_STORE(0);
            AT_LOAD(ntile - 2);
            int bufo = 0;
#pragma unroll 1
            for (int tt = ntile - 1; tt >= 0; --tt) {
                __syncthreads();
                if (tt > 0) { AT_STORE(bufo ^ AT_BUF); if (tt > 1) AT_LOAD(tt - 2); }
                const unsigned char* lb = lds + bufo;
                const int j0 = tt * 64;
                if (j0 <= q0 + 31) {
                    const float base = slope2 * (float)(j0 - t), base1 = base + 32.f * slope2;
                    f32x16 p0, p1;
#pragma unroll
                    for (int r = 0; r < 16; ++r) { p0[r] = cb[r] + base; p1[r] = cb[r] + base1; }
                    { const unsigned char* kb = lb + AT_KS + r32 * 144 + hi * 16;
#pragma unroll
                      for (int d0 = 0; d0 < 4; ++d0) { const bf16x8 a0 = *(const bf16x8*)(kb + d0 * 32), a1 = *(const bf16x8*)(kb + 32 * 144 + d0 * 32);
                          p0 = MFMA32(a0, qr[d0], p0); p1 = MFMA32(a1, qr[d0], p1); } }
                    if (j0 + 63 > q0) {
#pragma unroll
                        for (int r = 0; r < 16; ++r) { const int kv = j0 + crow(r, hi); if (kv > t) p0[r] = -1e30f; if (kv + 32 > t) p1[r] = -1e30f; }
                    }
                    float mx = fmaxf(p0[0], p1[0]);
#pragma unroll
                    for (int r = 1; r < 16; ++r) mx = fmaxf(mx, fmaxf(p0[r], p1[r]));
                    mx = fmaxf(mx, __shfl_xor(mx, 32));
                    if (__any(mx > m_ref + 8.f)) {
                        const float m_new = fmaxf(m_ref, mx), f = __builtin_amdgcn_exp2f(m_ref - m_new); m_ref = m_new; lsum *= f;
                        if (hi == 0) fs[r32] = f;
                        __builtin_amdgcn_wave_barrier();
#pragma unroll
                        for (int g = 0; g < 4; ++g) { const f32x4 ff = *(const f32x4*)(fs + 8 * g + 4 * hi);
#pragma unroll
                            for (int db = 0; db < 4; ++db) { o[db][4 * g] *= ff.x; o[db][4 * g + 1] *= ff.y; o[db][4 * g + 2] *= ff.z; o[db][4 * g + 3] *= ff.w; } }
                        __builtin_amdgcn_wave_barrier();
                    }
                    float sacc = 0.f;
#pragma unroll
                    for (int r = 0; r < 16; ++r) { p0[r] = __builtin_amdgcn_exp2f(p0[r] - m_ref); p1[r] = __builtin_amdgcn_exp2f(p1[r] - m_ref); sacc += p0[r] + p1[r]; }
                    lsum += sacc;
                    bf16x8 pk[4];
#pragma unroll
                    for (int s = 0; s < 2; ++s) { v4u w0, w1;
                        w0.x = cvtpk(p0[8 * s], p0[8 * s + 1]); w0.y = cvtpk(p0[8 * s + 2], p0[8 * s + 3]); w0.z = cvtpk(p0[8 * s + 4], p0[8 * s + 5]); w0.w = cvtpk(p0[8 * s + 6], p0[8 * s + 7]);
                        w1.x = cvtpk(p1[8 * s], p1[8 * s + 1]); w1.y = cvtpk(p1[8 * s + 2], p1[8 * s + 3]); w1.z = cvtpk(p1[8 * s + 4], p1[8 * s + 5]); w1.w = cvtpk(p1[8 * s + 6], p1[8 * s + 7]);
                        pk[s] = __builtin_bit_cast(bf16x8, w0); pk[2 + s] = __builtin_bit_cast(bf16x8, w1); }
                    const unsigned char* vb = lb + AT_VT + r32 * 144 + hi * 16;
#pragma unroll
                    for (int s = 0; s < 4; ++s)
#pragma unroll
                        for (int db = 0; db < 4; ++db) o[db] = MFMA32(pk[s], *(const bf16x8*)(vb + db * 32 * 144 + s * 32), o[db]);
                }
                bufo ^= AT_BUF;
            }
#undef AT_LOAD
#undef AT_STORE
            lsum += __shfl_xor(lsum, 32);
            __builtin_amdgcn_wave_barrier();
            if (hi == 0) fs[r32] = 1.f / lsum;
            __builtin_amdgcn_wave_barrier();
#pragma unroll
            for (int g = 0; g < 4; ++g) { const f32x4 ff = *(const f32x4*)(fs + 8 * g + 4 * hi); const float fv[4] = {ff.x, ff.y, ff.z, ff.w};
#pragma unroll
                for (int x = 0; x < 4; ++x) { const size_t row = (size_t)bb * SEQ + q0 + 8 * g + 4 * hi + x; float* dst = OATT + ((row * 4 + h) * 2 + mp) * 128 + r32;
#pragma unroll
                    for (int db = 0; db < 4; ++db) dst[db * 32] = o[db][4 * g + x] * fv[x]; } }
            __builtin_amdgcn_wave_barrier();
        }
    }
    __syncthreads();
}

__device__ __forceinline__ int afrag_off(int row, int k, int nks) { const int rt = row >> 5, r = row & 31, ks = k >> 4, kk = k & 15, h = (kk >> 2) & 1, j = ((kk >> 3) << 2) | (kk & 3); return ((rt * nks + ks) * 64 + r + 32 * h) * 8 + j; }
__device__ __forceinline__ int clay_off(int c, int dv) { const int rt = c >> 5, cc = c & 31, hi = (cc >> 2) & 1, i = ((cc >> 3) << 2) | (cc & 3), sl = dv >> 5, r32 = dv & 31; return ((rt * 4 + sl) * 64 + r32 + 32 * hi) * 16 + i; }
__device__ __forceinline__ void phase_gdn_local_v1(const Args& a, unsigned char* lds, int l, int wv_) {
    const bf16* P = (const bf16*)(a.ws + WS_PROJ); const float* BA = (const float*)(a.ws + WS_BA);
    bf16* GD = (bf16*)(a.ws + WS_REGD); float* GL = (float*)(a.ws + WS_GL);
    float* qs = (float*)lds; float* ks = qs + 64 * 129; float* vs = ks + 64 * 129; float* KKs = vs + 64 * 129; float* QKs = KKs + 64 * 65;
    float* beta = QKs + 64 * 65; float* gc = beta + 64;
    int tid_ = wv_ * 64 + mk_lane(); asm volatile("" : "+v"(tid_)); const int tid = tid_, lane = tid & 63, wave = tid >> 6;
    const float* cw = a.gdn_conv_w + (size_t)l * 4 * 1536;
    for (int unit = blockIdx.x; unit < NUNIT; unit += gridDim.x) {
        const int bb = unit >> 9, h = (unit >> 7) & 3, n = unit & 127;
        __syncthreads();
#pragma unroll 1
        for (int idx = tid; idx < 3 * 64 * 128; idx += NTHR) {
            const int mat = idx >> 13, rem = idx & 8191, t = rem >> 7, c = rem & 127, col = mat * 512 + h * 128 + c;
            float acc = 0.f;
#pragma unroll
            for (int j = 0; j < 4; ++j) { const int tt = n * 64 + t - 3 + j; if (tt >= 0) acc += cw[j * 1536 + col] * bf2f(P[((size_t)bb * SEQ + tt) * NP + col]); }
            (mat == 0 ? qs : mat == 1 ? ks : vs)[t * 129 + c] = siluf_(acc);
        }
        if (tid < 64) {
            const size_t row = (size_t)bb * SEQ + n * 64 + tid;
            beta[tid] = sigmoidf_(BA[row * 8 + h]);
            const float xx = BA[row * 8 + 4 + h] + a.gdn_dt_bias[l * 4 + h];
            const float sp = xx > 20.f ? xx : log1pf(__expf(xx));
            gc[tid] = -__expf(a.gdn_a_log[l * 4 + h]) * sp;
        }
        __syncthreads();
        if (tid == 0) { float run = 0.f;
#pragma unroll 1
            for (int c = 0; c < 64; ++c) { run += gc[c]; gc[c] = run; } }
        __syncthreads();
#pragma unroll 1
        for (int r = wave * 8; r < wave * 8 + 8; ++r) {
            { float x0 = qs[r * 129 + lane], x1 = qs[r * 129 + 64 + lane]; const float sc = rsqrtf(wave_sum(x0 * x0 + x1 * x1) + 1e-6f) * 0.08838834764831845f; qs[r * 129 + lane] = x0 * sc; qs[r * 129 + 64 + lane] = x1 * sc; }
            { float x0 = ks[r * 129 + lane], x1 = ks[r * 129 + 64 + lane]; const float sc = rsqrtf(wave_sum(x0 * x0 + x1 * x1) + 1e-6f); ks[r * 129 + lane] = x0 * sc; ks[r * 129 + 64 + lane] = x1 * sc; }
        }
        __syncthreads();
#pragma unroll 1
        for (int i = 0; i < 8; ++i) { const int idx = tid + NTHR * i, c = idx >> 6, s = idx & 63; float kk = 0.f, qk = 0.f;
#pragma unroll 4
            for (int d = 0; d < 128; ++d) { const float kv = ks[s * 129 + d]; kk += ks[c * 129 + d] * kv; qk += qs[c * 129 + d] * kv; }
            const float dec = (s <= c) ? __expf(gc[c] - gc[s]) : 0.f;
            KKs[c * 65 + s] = (s < c) ? kk * beta[c] * dec : 0.f; QKs[c * 65 + s] = qk * dec; }
        __syncthreads();
        const size_t ub = (size_t)unit * UREC;
        { const float gl = gc[63];
          for (int idx = tid; idx < 8192; idx += NTHR) { const int c = idx >> 7, d = idx & 127;
              GD[ub + R_QD + afrag_off(c, d, 8)] = (bf16)f2bf(qs[c * 129 + d] * __expf(gc[c])); GD[ub + R_KD + afrag_off(d, c, 4)] = (bf16)f2bf(ks[c * 129 + d] * __expf(gl - gc[c])); }
          for (int idx = tid; idx < 4096; idx += NTHR) { const int c = idx >> 6, s = idx & 63; GD[ub + R_QK + afrag_off(c, s, 4)] = (bf16)f2bf(QKs[c * 65 + s]); }
          if (tid == 0) GL[unit] = __expf(gl); }
        __syncthreads();
        for (int idx = tid; idx < 8192; idx += NTHR) { const int c = idx >> 7, d = idx & 127; vs[c * 129 + d] *= beta[c]; ks[c * 129 + d] *= beta[c] * __expf(gc[c]); }
        __syncthreads();
        if (tid < 256) {
            float* X = (tid < 128 ? vs : ks) + (tid & 127);
#pragma unroll 1
            for (int c = 1; c < 64; ++c) { float acc = X[c * 129]; const float* Ar = KKs + c * 65;
#pragma unroll 4
                for (int s = 0; s < c; ++s) acc -= Ar[s] * X[s * 129];
                X[c * 129] = acc; }
            if (tid < 128) { for (int c = 0; c < 64; ++c) GD[ub + R_U + clay_off(c, tid)] = (bf16)f2bf(X[c * 129]); }
            else { for (int c = 0; c < 64; ++c) GD[ub + R_W + afrag_off(c, tid - 128, 8)] = (bf16)f2bf(-X[c * 129]); }
        }
    }
    __syncthreads();
}

constexpr int GL_QB = 0, GL_KB = 17408, GL_VB = 34816, GL_AM = 52224, GL_QK = 69632, GL_XT = 78848, GL_BETA = 115712, GL_GC = 115968, GL_EGC = 116224;
template <int ROFF> __device__ __forceinline__ void tri_solve32(float (&x)[32], const float* Am) {
#pragma unroll
    for (int c = 1; c < 32; ++c) { int off = (ROFF + c) * 68 + ROFF;
        if (c >= 2) asm volatile("" : "+v"(off), "+v"(x[c - 2])); else asm volatile("" : "+v"(off));
        const float* ar = Am + off; float acc = x[c];
#pragma unroll
        for (int s4 = 0; s4 < c; s4 += 4) { const f32x4 av = *(const f32x4*)(ar + s4);
            acc -= av.x * x[s4]; if (s4 + 1 < c) acc -= av.y * x[s4 + 1]; if (s4 + 2 < c) acc -= av.z * x[s4 + 2]; if (s4 + 3 < c) acc -= av.w * x[s4 + 3]; }
        x[c] = acc; }
}
__device__ __forceinline__ void phase_gdn_local(const Args& a, unsigned char* lds, int l, int wv_) {
    const bf16* P = (const bf16*)(a.ws + WS_PROJ); const float* BA = (const float*)(a.ws + WS_BA);
    bf16* GD = (bf16*)(a.ws + WS_REGD); float* GL = (float*)(a.ws + WS_GL);
    bf16* qb = (bf16*)(lds + GL_QB); bf16* kb = (bf16*)(lds + GL_KB); bf16* vb = (bf16*)(lds + GL_VB); float* Am = (float*)(lds + GL_AM); bf16* QKb = (bf16*)(lds + GL_QK); bf16* XT = (bf16*)(lds + GL_XT);
    float* beta = (float*)(lds + GL_BETA); float* gc = (float*)(lds + GL_GC); float* egc = (float*)(lds + GL_EGC);
    const float* cwp = a.gdn_conv_w + (size_t)l * 4 * 1536;
#pragma unroll 1
    for (int unit = blockIdx.x; unit < NUNIT; unit += gridDim.x) {
        const int bb = unit >> 9, h = (unit >> 7) & 3, n = unit & 127;
        const size_t ub = (size_t)unit * UREC;
        __syncthreads();
        { const int tid = wv_ * 64 + mk_lane(), lane = tid & 63, r32 = lane & 31, hi = lane >> 5, wave = tid >> 6; (void)r32; (void)hi; (void)wave; (void)lane;
        if (tid < 384) {
            const int g = tid >> 4, cg = tid & 15, mat = g >> 3, tg = g & 7, col = mat * 512 + h * 128 + cg * 8;
            float cw[4][8];
#pragma unroll
            for (int j = 0; j < 4; ++j) { const f32x4 w0 = *(const f32x4*)(cwp + j * 1536 + col), w1 = *(const f32x4*)(cwp + j * 1536 + col + 4);
                cw[j][0] = w0.x; cw[j][1] = w0.y; cw[j][2] = w0.z; cw[j][3] = w0.w; cw[j][4] = w1.x; cw[j][5] = w1.y; cw[j][6] = w1.z; cw[j][7] = w1.w; }
            v4u in[11];
#pragma unroll
            for (int r = 0; r < 11; ++r) { const int tt = n * 64 + tg * 8 - 3 + r; in[r] = (v4u){0u, 0u, 0u, 0u}; if (tt >= 0) in[r] = *(const v4u*)(P + ((size_t)bb * SEQ + tt) * NP + col); }
            bf16* dstm = (mat == 0 ? qb : mat == 1 ? kb : vb) + cg * 8;
#pragma unroll
            for (int i = 0; i < 8; ++i) { float o[8];
#pragma unroll
                for (int e = 0; e < 8; ++e) o[e] = 0.f;
#pragma unroll
                for (int j = 0; j < 4; ++j) { const v4u w = in[i + j]; const float f[8] = {bflo(w.x), bfhi(w.x), bflo(w.y), bfhi(w.y), bflo(w.z), bfhi(w.z), bflo(w.w), bfhi(w.w)};
#pragma unroll
                    for (int e = 0; e < 8; ++e) o[e] += cw[j][e] * f[e]; }
                float ss = 0.f;
#pragma unroll
                for (int e = 0; e < 8; ++e) { o[e] = siluf_(o[e]); ss += o[e] * o[e]; }
                ss += __shfl_xor(ss, 1); ss += __shfl_xor(ss, 2); ss += __shfl_xor(ss, 4); ss += __shfl_xor(ss, 8);
                const float sc = mat == 2 ? 1.f : rsqrtf(ss + 1e-6f) * (mat == 0 ? 0.08838834764831845f : 1.f);
#pragma unroll
                for (int e = 0; e < 8; ++e) o[e] *= sc;
                st8(dstm + (tg * 8 + i) * 136, o); }
        } else if (tid < 448) {
            const int t = tid - 384; const size_t row = (size_t)bb * SEQ + n * 64 + t;
            beta[t] = sigmoidf_(BA[row * 8 + h]);
            const float xx = BA[row * 8 + 4 + h] + a.gdn_dt_bias[l * 4 + h];
            const float sp = xx > 20.f ? xx : log1pf(__expf(xx));
            float gv = -__expf(a.gdn_a_log[l * 4 + h]) * sp;
#pragma unroll
            for (int o = 1; o < 64; o <<= 1) { const float v = __shfl_up(gv, o); if (t >= o) gv += v; }
            gc[t] = gv; egc[t] = __expf(gv);
        }
        }
        __syncthreads();
        { const int tid = wv_ * 64 + mk_lane(), lane = tid & 63, r32 = lane & 31, hi = lane >> 5, wave = tid >> 6; (void)r32; (void)hi; (void)wave; (void)lane;
        { const int mat = wave >> 2, rt = (wave >> 1) & 1, ct = wave & 1;
          if (mat == 1 || !(rt == 0 && ct == 1)) {
            f32x16 acc;
#pragma unroll
            for (int r = 0; r < 16; ++r) acc[r] = 0.f;
            const bf16* Ab = (mat == 0 ? kb : qb) + (32 * rt + r32) * 136 + 8 * hi; const bf16* Bb = kb + (32 * ct + r32) * 136 + 8 * hi;
            if (!(rt == 0 && ct == 1)) {
#pragma unroll
                for (int ks = 0; ks < 8; ++ks) acc = MFMA32(*(const bf16x8*)(Ab + 16 * ks), *(const bf16x8*)(Bb + 16 * ks), acc);
            }
            const int s = 32 * ct + r32; const float gs = gc[s];
#pragma unroll
            for (int i = 0; i < 16; ++i) { const int c = 32 * rt + crow(i, hi); const float dec = (s <= c) ? __expf(gc[c] - gs) : 0.f;
                if (mat == 0) Am[c * 68 + s] = (s < c) ? acc[i] * beta[c] * dec : 0.f;
                else QKb[c * 72 + s] = (bf16)f2bf(acc[i] * dec); }
          } }
        }
        __syncthreads();
        { const int tid = wv_ * 64 + mk_lane(), lane = tid & 63, r32 = lane & 31, hi = lane >> 5, wave = tid >> 6; (void)r32; (void)hi; (void)wave; (void)lane;
        if (tid < 256) {
            const int col = tid; float x[32];
#pragma unroll
            for (int c = 0; c < 32; ++c) x[c] = (col < 128) ? bf2f(vb[c * 136 + col]) * beta[c] : bf2f(kb[c * 136 + col - 128]) * beta[c] * egc[c];
            tri_solve32<0>(x, Am);
#pragma unroll
            for (int c = 0; c < 32; c += 8) st8(XT + col * 72 + c, x + c);
        } else {
            const int lt = tid - 256; const float gl = gc[63];
#pragma unroll 1
            for (int q = 0; q < 4; ++q) { const int item = lt + 256 * q, f = item >> 6, ln = item & 63, r = ln & 31, hh = ln >> 5;
                { const int rt = f >> 3, ks = f & 7, c = 32 * rt + r; const float e = egc[c]; const bf16* sp = qb + c * 136 + 16 * ks + 4 * hh;
                  const v2u lo = *(const v2u*)sp, hi8 = *(const v2u*)(sp + 8); v4u w;
                  w.x = pk2(bflo(lo.x) * e, bfhi(lo.x) * e); w.y = pk2(bflo(lo.y) * e, bfhi(lo.y) * e); w.z = pk2(bflo(hi8.x) * e, bfhi(hi8.x) * e); w.w = pk2(bflo(hi8.y) * e, bfhi(hi8.y) * e);
                  *(v4u*)(GD + ub + R_QD + item * 8) = w; }
                { const int rt = f >> 2, ks = f & 3, dk = 32 * rt + r; float v[8];
#pragma unroll
                  for (int j = 0; j < 8; ++j) { const int c = 16 * ks + 8 * (j >> 2) + 4 * hh + (j & 3); v[j] = bf2f(kb[c * 136 + dk]) * __expf(gl - gc[c]); }
                  st8(GD + ub + R_KD + item * 8, v); } }
#pragma unroll 1
            for (int q = 0; q < 2; ++q) { const int item = lt + 256 * q, f = item >> 6, ln = item & 63, r = ln & 31, hh = ln >> 5, rt = f >> 2, ks = f & 3, c = 32 * rt + r;
                const bf16* sp = QKb + c * 72 + 16 * ks + 4 * hh; const v2u lo = *(const v2u*)sp, hi8 = *(const v2u*)(sp + 8); v4u w; w.x = lo.x; w.y = lo.y; w.z = hi8.x; w.w = hi8.y;
                *(v4u*)(GD + ub + R_QK + item * 8) = w; }
            if (lt == 0) GL[unit] = __expf(gl);
        }
        }
        __syncthreads();
        { const int tid = wv_ * 64 + mk_lane(), lane = tid & 63, r32 = lane & 31, hi = lane >> 5, wave = tid >> 6; (void)r32; (void)hi; (void)wave; (void)lane;
        { const int col = 32 * wave + r32; f32x16 acc;
#pragma unroll
          for (int i = 0; i < 16; ++i) { const int c = 32 + crow(i, hi); acc[i] = (col < 128) ? bf2f(vb[c * 136 + col]) * beta[c] : bf2f(kb[c * 136 + col - 128]) * beta[c] * egc[c]; }
#pragma unroll
          for (int ks = 0; ks < 2; ++ks) { const float* ap = Am + (32 + r32) * 68 + 16 * ks + 8 * hi; const f32x4 a0 = *(const f32x4*)ap, a1 = *(const f32x4*)(ap + 4);
              v4u w; w.x = cvtpk(-a0.x, -a0.y); w.y = cvtpk(-a0.z, -a0.w); w.z = cvtpk(-a1.x, -a1.y); w.w = cvtpk(-a1.z, -a1.w);
              acc = MFMA32(__builtin_bit_cast(bf16x8, w), *(const bf16x8*)(XT + col * 72 + 16 * ks + 8 * hi), acc); }
#pragma unroll
          for (int g = 0; g < 4; ++g) { v2u w; w.x = cvtpk(acc[4 * g], acc[4 * g + 1]); w.y = cvtpk(acc[4 * g + 2], acc[4 * g + 3]); *(v2u*)(XT + col * 72 + 32 + 8 * g + 4 * hi) = w; } }
        }
        __syncthreads();
        { const int tid = wv_ * 64 + mk_lane(), lane = tid & 63, r32 = lane & 31, hi = lane >> 5, wave = tid >> 6; (void)r32; (void)hi; (void)wave; (void)lane;
        if (tid < 256) {
            const int col = tid; float x[32];
#pragma unroll
            for (int c = 0; c < 32; c += 8) ld8(XT + col * 72 + 32 + c, x + c);
            tri_solve32<32>(x, Am);
#pragma unroll
            for (int c = 0; c < 32; c += 8) st8(XT + col * 72 + 32 + c, x + c);
        }
        }
        __syncthreads();
        { const int tid = wv_ * 64 + mk_lane(), lane = tid & 63, r32 = lane & 31, hi = lane >> 5, wave = tid >> 6; (void)r32; (void)hi; (void)wave; (void)lane;
        { const int item = tid, tile = item >> 6, ln = item & 63, rr = ln & 31, hh = ln >> 5, rt = tile >> 2, sl = tile & 3, dv = sl * 32 + rr;
          const bf16* xp = XT + dv * 72 + 32 * rt + 4 * hh; const v2u g0 = *(const v2u*)xp, g1 = *(const v2u*)(xp + 8), g2 = *(const v2u*)(xp + 16), g3 = *(const v2u*)(xp + 24);
          v4u w0, w1; w0.x = g0.x; w0.y = g0.y; w0.z = g1.x; w0.w = g1.y; w1.x = g2.x; w1.y = g2.y; w1.z = g3.x; w1.w = g3.y;
          *(v4u*)(GD + ub + R_U + item * 16) = w0; *(v4u*)(GD + ub + R_U + item * 16 + 8) = w1; }
#pragma unroll 1
        for (int q = 0; q < 2; ++q) { const int item = tid + 512 * q, f = item >> 6, ln = item & 63, r = ln & 31, hh = ln >> 5, rt = f >> 3, ks = f & 7, c = 32 * rt + r;
            unsigned short v[8];
#pragma unroll
            for (int j = 0; j < 8; ++j) { const int kc = 16 * ks + 8 * (j >> 2) + 4 * hh + (j & 3); v[j] = XT[(128 + kc) * 72 + c] ^ 0x8000u; }
            v4u w; w.x = v[0] | ((unsigned)v[1] << 16); w.y = v[2] | ((unsigned)v[3] << 16); w.z = v[4] | ((unsigned)v[5] << 16); w.w = v[6] | ((unsigned)v[7] << 16);
            *(v4u*)(GD + ub + R_W + item * 8) = w; }
        }
    }
    __syncthreads();
}

constexpr int SC_WN = 0, SC_QD = 16384, SC_KDT = 32768, SC_QK = 49152, SC_U = 57344, SC_GL = 61440, SC_BUF = 61504;
__device__ __forceinline__ bf16x8 pack8(const f32x16& x, int s) { v4u w; w.x = cvtpk(x[8 * s], x[8 * s + 1]); w.y = cvtpk(x[8 * s + 2], x[8 * s + 3]); w.z = cvtpk(x[8 * s + 4], x[8 * s + 5]); w.w = cvtpk(x[8 * s + 6], x[8 * s + 7]); return __builtin_bit_cast(bf16x8, w); }
__device__ __forceinline__ void phase_gdn_scan(const Args& a, unsigned char* lds, int l, int wv_) {
    const bf16* GD = (const bf16*)(a.ws + WS_REGD); const float* GL = (const float*)(a.ws + WS_GL); float* OG = (float*)(a.ws + WS_REGB);
    int tid_ = wv_ * 64 + mk_lane(); asm volatile("" : "+v"(tid_)); const int tid = tid_, lane = tid & 63, r32 = lane & 31, hi = lane >> 5, wave = tid >> 6;
#pragma unroll 1
    for (int job = blockIdx.x; job < 32; job += gridDim.x) {
        const int bh = job >> 2, sl = job & 3, bb = bh >> 2, h = bh & 3;
        f32x16 S[4];
#pragma unroll
        for (int b4 = 0; b4 < 4; ++b4)
#pragma unroll
            for (int r = 0; r < 16; ++r) S[b4][r] = 0.f;
        __syncthreads();
#pragma unroll 1
        for (int n = -1; n < 128; ++n) {
            if (wave != 0 && n + 1 < 128) {
                const int unit = bh * 128 + n + 1; unsigned char* dstb = lds + ((n + 1) & 1) * SC_BUF + (tid - 64) * 16;
                const unsigned char* rec = (const unsigned char*)(GD + (size_t)unit * UREC) + (tid - 64) * 16;
                v4u lr[9];
#pragma unroll
                for (int q = 0; q < 8; ++q) lr[q] = *(const v4u*)(rec + q * 7168);
                const int lt = tid - 64; const bool hasu = lt < 256;
                if (hasu) lr[8] = *(const v4u*)((const unsigned char*)(GD + (size_t)unit * UREC + R_U) + ((lt >> 7) * 512 + sl * 128 + (lt & 127)) * 16);
#pragma unroll
                for (int q = 0; q < 8; ++q) *(v4u*)(dstb + q * 7168) = lr[q];
                if (hasu) *(v4u*)(dstb + 8 * 7168) = lr[8];
                dstb -= (tid - 64) * 16;
                if (tid == 64) *(float*)(dstb + SC_GL) = GL[unit];
            }
            if (wave == 0 && n >= 0) {
                const unsigned char* base = lds + (n & 1) * SC_BUF;
#define SFRAG(off, f) (*(const bf16x8*)(base + (off) + (f) * 1024 + lane * 16))
                bf16x8 Spk[8];
#pragma unroll
                for (int ks = 0; ks < 8; ++ks) Spk[ks] = pack8(S[ks >> 1], ks & 1);
                f32x16 Vn[2];
#pragma unroll
                for (int rt = 0; rt < 2; ++rt) { const v4u u0 = *(const v4u*)(base + SC_U + (rt * 64 + lane) * 32), u1 = *(const v4u*)(base + SC_U + (rt * 64 + lane) * 32 + 16);
                    const unsigned uw[8] = {u0.x, u0.y, u0.z, u0.w, u1.x, u1.y, u1.z, u1.w};
#pragma unroll
                    for (int x = 0; x < 8; ++x) { Vn[rt][2 * x] = bflo(uw[x]); Vn[rt][2 * x + 1] = bfhi(uw[x]); }
#pragma unroll
                    for (int ks = 0; ks < 8; ++ks) Vn[rt] = MFMA32(SFRAG(SC_WN, rt * 8 + ks), Spk[ks], Vn[rt]); }
                bf16x8 Vpk[4];
#pragma unroll
                for (int ks = 0; ks < 4; ++ks) Vpk[ks] = pack8(Vn[ks >> 1], ks & 1);
#pragma unroll
                for (int rt = 0; rt < 2; ++rt) { f32x16 O;
#pragma unroll
                    for (int r = 0; r < 16; ++r) O[r] = 0.f;
#pragma unroll
                    for (int ks = 0; ks < 8; ++ks) O = MFMA32(SFRAG(SC_QD, rt * 8 + ks), Spk[ks], O);
#pragma unroll
                    for (int ks = 0; ks < 4; ++ks) O = MFMA32(SFRAG(SC_QK, rt * 4 + ks), Vpk[ks], O);
                    float* op = OG + ((size_t)bb * SEQ + n * 64 + rt * 32) * BW + h * 128 + sl * 32 + r32;
#pragma unroll
                    for (int i = 0; i < 16; ++i) op[(size_t)crow(i, hi) * BW] = O[i]; }
                const float g = *(const float*)(base + SC_GL);
#pragma unroll
                for (int b4 = 0; b4 < 4; ++b4) {
#pragma unroll
                    for (int r = 0; r < 16; ++r) S[b4][r] *= g;
#pragma unroll
                    for (int ks = 0; ks < 4; ++ks) S[b4] = MFMA32(SFRAG(SC_KDT, b4 * 4 + ks), Vpk[ks], S[b4]); }
#undef SFRAG
            }
            __syncthreads();
        }
    }
    __syncthreads();
}

__device__ __forceinline__ void phase_finalize(const Args& a, int l, int wv_) {
    const bf16* P = (const bf16*)(a.ws + WS_PROJ); const float* OG = (const float*)(a.ws + WS_REGB); const float* OATT = (const float*)(a.ws + WS_REGC);
    bf16* Y = (bf16*)(a.ws + WS_REGD);
    int tid_ = wv_ * 64 + mk_lane(); asm volatile("" : "+v"(tid_)); const int tid = tid_, lane = tid & 63, wave = tid >> 6;
    const int gw = blockIdx.x * NWAVES + wave, NGW = gridDim.x * NWAVES;
    const float lam_init = 0.8f - 0.6f * expf(-0.3f * (float)l);
    const float* lv = a.diff_lambda + (size_t)l * 256;
    const float lam = expf(wave_sum(lv[lane] * lv[64 + lane])) - expf(wave_sum(lv[128 + lane] * lv[192 + lane])) + lam_init;
    const int e0 = (lane & 15) * 8, hh = lane >> 4, c0 = lane * 8;
    float gnw[8], dnw[8], scw[3][8];
#pragma unroll
    for (int j = 0; j < 8; ++j) { gnw[j] = a.gdn_norm_w[l * 128 + e0 + j]; dnw[j] = a.diff_norm_w[l * 128 + e0 + j] * (1.f - lam_init);
#pragma unroll
        for (int k = 0; k < 3; ++k) scw[k][j] = a.sc_conv_w[((size_t)l * 3 + k) * BW + c0 + j]; }
    for (int row = gw; row < M; row += NGW) {
        const int t = row & (SEQ - 1);
        const bf16* pr = P + (size_t)row * NP;
        float y[8], z[8];
        { const f32x4 o0 = *(const f32x4*)(OG + (size_t)row * BW + c0), o1 = *(const f32x4*)(OG + (size_t)row * BW + c0 + 4);
          float o[8] = {o0.x, o0.y, o0.z, o0.w, o1.x, o1.y, o1.z, o1.w}; float ss = 0.f;
#pragma unroll
          for (int j = 0; j < 8; ++j) ss += o[j] * o[j];
          ss += __shfl_xor(ss, 1); ss += __shfl_xor(ss, 2); ss += __shfl_xor(ss, 4); ss += __shfl_xor(ss, 8);
          const float rs = rsqrtf(ss * (1.f / 128.f) + EPS); ld8(pr + C_GZ + c0, z);
#pragma unroll
          for (int j = 0; j < 8; ++j) y[j] = o[j] * rs * gnw[j] * siluf_(z[j]);
          st8(Y + (size_t)row * BW + c0, y); }
        { const float* op = OATT + (((size_t)row * 4 + hh) * 2) * 128 + e0;
          const f32x4 a0 = *(const f32x4*)op, a1 = *(const f32x4*)(op + 4), b0 = *(const f32x4*)(op + 128), b1 = *(const f32x4*)(op + 132);
          float d[8] = {a0.x - lam * b0.x, a0.y - lam * b0.y, a0.z - lam * b0.z, a0.w - lam * b0.w, a1.x - lam * b1.x, a1.y - lam * b1.y, a1.z - lam * b1.z, a1.w - lam * b1.w}; float ss = 0.f;
#pragma unroll
          for (int j = 0; j < 8; ++j) ss += d[j] * d[j];
          ss += __shfl_xor(ss, 1); ss += __shfl_xor(ss, 2); ss += __shfl_xor(ss, 4); ss += __shfl_xor(ss, 8);
          const float rs = rsqrtf(ss * (1.f / 128.f) + EPS); ld8(pr + C_DZ + c0, z);
#pragma unroll
          for (int j = 0; j < 8; ++j) y[j] = d[j] * rs * dnw[j] * siluf_(z[j]);
          st8(Y + (size_t)M * BW + (size_t)row * BW + c0, y); }
        { float acc[8];
#pragma unroll
          for (int j = 0; j < 8; ++j) acc[j] = 0.f;
#pragma unroll
          for (int k = 0; k < 3; ++k) { const int tt = t - 2 + k; if (tt >= 0) { float cc[8], xx[8]; const bf16* p2 = P + (size_t)(row - 2 + k) * NP; ld8(p2 + C_SC + c0, cc); ld8(p2 + C_SX + c0, xx);
#pragma unroll
              for (int j = 0; j < 8; ++j) acc[j] += scw[k][j] * (cc[j] * xx[j]); } }
          float sb[8]; ld8(pr + C_SB + c0, sb); ld8(pr + C_SZ + c0, z);
#pragma unroll
          for (int j = 0; j < 8; ++j) y[j] = sb[j] * acc[j] * siluf_(z[j]);
          st8(Y + 2 * (size_t)M * BW + (size_t)row * BW + c0, y); }
    }
}

__device__ __forceinline__ void phase_postnorm(const Args& a, int l, int wv_) {
    const float* OUT = (const float*)(a.ws + WS_REGC); bf16* H = (bf16*)(a.ws + WS_REGB);
    const float* xin = (l == 0) ? a.x : a.out;
    int tid_ = wv_ * 64 + mk_lane(); asm volatile("" : "+v"(tid_)); const int tid = tid_, lane = tid & 63, wave = tid >> 6;
    const int gw = blockIdx.x * NWAVES + wave, NGW = gridDim.x * NWAVES;
    const float* wpost = a.norm_post + (size_t)l * DM; const float* wpre = a.norm_pre + (size_t)(l + 1 < DEPTH ? l + 1 : l) * DM;
    for (int row = gw; row < M; row += NGW) {
        f32x4 o[4], x[4]; float s = 0.f;
#pragma unroll
        for (int j = 0; j < 4; ++j) { o[j] = *(const f32x4*)(OUT + (size_t)row * DM + 4 * lane + 256 * j); x[j] = *(const f32x4*)(xin + (size_t)row * DM + 4 * lane + 256 * j);
            s += (o[j].x * o[j].x + o[j].y * o[j].y) + (o[j].z * o[j].z + o[j].w * o[j].w); }
        const float rs = rsqrtf(wave_sum(s) * (1.f / DM) + EPS); float s2 = 0.f;
#pragma unroll
        for (int j = 0; j < 4; ++j) { const f32x4 w = *(const f32x4*)(wpost + 4 * lane + 256 * j); x[j] = x[j] + o[j] * rs * w; *(f32x4*)(a.out + (size_t)row * DM + 4 * lane + 256 * j) = x[j];
            s2 += (x[j].x * x[j].x + x[j].y * x[j].y) + (x[j].z * x[j].z + x[j].w * x[j].w); }
        if (l + 1 < DEPTH) { const float rs2 = rsqrtf(wave_sum(s2) * (1.f / DM) + EPS);
#pragma unroll
            for (int j = 0; j < 4; ++j) { const f32x4 w = *(const f32x4*)(wpre + 4 * lane + 256 * j); v2u ob; ob.x = pk2(x[j].x * rs2 * w.x, x[j].y * rs2 * w.y); ob.y = pk2(x[j].z * rs2 * w.z, x[j].w * rs2 * w.w);
                *(v2u*)(H + (size_t)row * DM + 4 * lane + 256 * j) = ob; } }
    }
}

#define XB_TMO      128
#define XB_XCNT(j)  (256  + 64 * (j))
#define XB_XSUB(j)  (1280 + 64 * (j))
#define XB_XGEN(j)  (2304 + 64 * (j))
#define XB_TOP      3328
#define XB_TOPGEN   3392
#define XCD_BAR_WORDS 3456
#define XB_SPIN_CAP (1u << 18)

__device__ __forceinline__ unsigned xb_ld(unsigned* p)              { return __hip_atomic_load(p, __ATOMIC_RELAXED, __HIP_MEMORY_SCOPE_AGENT); }
__device__ __forceinline__ unsigned xb_add(unsigned* p, unsigned v) { return __hip_atomic_fetch_add(p, v, __ATOMIC_RELAXED, __HIP_MEMORY_SCOPE_AGENT); }
__device__ __forceinline__ unsigned xb_xcc_id() { return (unsigned)__builtin_amdgcn_s_getreg((3 << 11) | 20) & 0xFu; }
#define XB_SPIN(cond, bar) do { unsigned _sp = 0; while (cond) { __builtin_amdgcn_s_sleep(1); \
    if ((++_sp & 255u) == 0u) { if (xb_ld(&(bar)[XB_TMO])) break; if (_sp > XB_SPIN_CAP) { atomicAdd(&(bar)[XB_TMO], 1u); break; } } } } while (0)

struct XcdBarrier {
    unsigned* bar; unsigned x;
    volatile LAS unsigned* st;
};

__device__ __forceinline__ XcdBarrier xcd_barrier_post(unsigned* bar, volatile LAS unsigned* st) {
    XcdBarrier b; b.bar = bar; b.x = xb_xcc_id(); b.st = st;
    if (threadIdx.x == 0) (void)xb_add(&bar[XB_XCNT(b.x)], 1u);
    return b;
}
__device__ __forceinline__ void xcd_barrier_complete(unsigned* bar, unsigned x, unsigned& nloc, unsigned& nx) {
    const unsigned G = gridDim.x * gridDim.y * gridDim.z;
    unsigned sum, cnt, mine, sp = 0u;
    for (;;) {
        sum = 0u; cnt = 0u; mine = 0u;
#pragma unroll
        for (unsigned j = 0; j < 16; ++j) { const unsigned c = xb_ld(&bar[XB_XCNT(j)]); sum += c; cnt += (c > 0u) ? 1u : 0u; mine = (j == x) ? c : mine; }
        if (sum == G) break;
        __builtin_amdgcn_s_sleep(1);
        if ((++sp & 255u) == 0u) { if (xb_ld(&bar[XB_TMO])) break; if (sp > XB_SPIN_CAP) { atomicAdd(&bar[XB_TMO], 1u); break; } }
    }
    nloc = mine > 0u ? mine : 1u; nx = cnt > 0u ? cnt : 1u;
}

__device__ __forceinline__ void xcd_barrier(const XcdBarrier& b) {
    asm volatile("s_waitcnt vmcnt(0)" ::: "memory");
    __syncthreads();
    if (threadIdx.x == 0) {
        unsigned* bar = b.bar;
        __builtin_amdgcn_s_waitcnt(0);
        unsigned nloc = b.st[0], nx = b.st[1];
        if (nloc == 0u) { xcd_barrier_complete(bar, b.x, nloc, nx); b.st[0] = nloc; b.st[1] = nx; }
        const unsigned old = xb_add(&bar[XB_XSUB(b.x)], 1u);
        const unsigned gen = old / nloc;
        if (old + 1u == (gen + 1u) * nloc) {
            __builtin_amdgcn_fence(__ATOMIC_RELEASE, "agent");
            asm volatile("s_waitcnt vmcnt(0)" ::: "memory");
            const unsigned og = xb_add(&bar[XB_TOP], 1u);
            const unsigned tg = og / nx;
            if (og + 1u == (tg + 1u) * nx) xb_add(&bar[XB_TOPGEN], 1u);
            else XB_SPIN(xb_ld(&bar[XB_TOPGEN]) == tg, bar);
            __builtin_amdgcn_fence(__ATOMIC_ACQUIRE, "agent");
            xb_add(&bar[XB_XGEN(b.x)], 1u);
            asm volatile("s_waitcnt vmcnt(0)" ::: "memory");
        } else {
            XB_SPIN(xb_ld(&bar[XB_XGEN(b.x)]) == gen, bar);
            __builtin_amdgcn_fence(__ATOMIC_ACQUIRE, "agent");
            asm volatile("s_waitcnt vmcnt(0)" ::: "memory");
        }
    }
    __syncthreads();
}

constexpr int XB_ST_OFF = 143360 + 1024;
constexpr int XB_WORD0 = 4096;
constexpr int ARGS_OFF = 143360;
constexpr int ARGS_WORDS = (int)(sizeof(Args) / 4);
#ifndef PROBE_SEL
#define PROBE_SEL -1
#endif
constexpr int TS_OFF = ARGS_OFF + 512;
__device__ __forceinline__ void ts_mark(unsigned char* lds, int k) {
    if (PROBE_SEL >= 0 && blockIdx.x == 0 && threadIdx.x == 0) { volatile LAS unsigned long long* p = (volatile LAS unsigned long long*)((LAS unsigned char*)lds + TS_OFF);
        const unsigned long long t = __builtin_amdgcn_s_memrealtime(); p[1 + k] += t - p[0]; p[0] = t; }
}
__device__ __forceinline__ void load_args(Args& b, unsigned char* lds) {
    volatile LAS unsigned* s = (volatile LAS unsigned*)((LAS unsigned char*)lds + ARGS_OFF); unsigned w[ARGS_WORDS];
#pragma unroll
    for (int i = 0; i < ARGS_WORDS; ++i) w[i] = (unsigned)__builtin_amdgcn_readfirstlane((int)s[i]);
    __builtin_memcpy(&b, w, sizeof(Args));
}
__device__ __forceinline__ void grid_bar(unsigned char* lds) {
    Args a; load_args(a, lds);
    XcdBarrier b; b.bar = (unsigned*)(a.ws + WS_CTL) + XB_WORD0; b.x = xb_xcc_id(); b.st = (volatile LAS unsigned*)((LAS unsigned char*)lds + XB_ST_OFF);
    xcd_barrier(b);
}
template <int L> __device__ __forceinline__ void run_layer(unsigned char* lds, cg::grid_group& grid, int wv) {
    PG8_LAS unsigned char* lds3 = (PG8_LAS unsigned char*)lds;
    constexpr int l = L;
    {
        Args a; load_args(a, lds); const int G = gridDim.x;
        bf16* WIN = (bf16*)(a.ws + WS_WIN); bf16* PROJ = (bf16*)(a.ws + WS_PROJ); float* BA = (float*)(a.ws + WS_BA); bf16* REGB = (bf16*)(a.ws + WS_REGB);
        pg8::Gemm g{REGB, WIN + (size_t)l * WIN_L, M, NPAD, DM}; pg8::StaticOrder S; S.init(M, NPAD, G, (int)blockIdx.x);
        EpiProj E{PROJ, BA};
        pg8::gemm_phase<EpiProj, pg8::StaticOrder, true, true>(lds3, g, S, E, wv);
    }
    grid_bar(lds);
    ts_mark(lds, 1);
    { Args a; load_args(a, lds); phase_gdn_local(a, lds, l, wv); }
    grid_bar(lds);
    ts_mark(lds, 2);
    { Args a; load_args(a, lds); phase_gdn_scan(a, lds, l, wv); }
    ts_mark(lds, 4);
    { Args a; load_args(a, lds); phase_attn(a, lds, l, wv); }
    grid_bar(lds);
    ts_mark(lds, 3);
    { Args a; load_args(a, lds); phase_finalize(a, l, wv); }
    grid_bar(lds);
    ts_mark(lds, 5);
    {
        Args a; load_args(a, lds); const int G = gridDim.x;
        bf16* WBR = (bf16*)(a.ws + WS_WBR); bf16* PROJ = (bf16*)(a.ws + WS_PROJ); bf16* REGB = (bf16*)(a.ws + WS_REGB); float* REGC = (float*)(a.ws + WS_REGC); bf16* Y = (bf16*)(a.ws + WS_REGD);
        pg8::StaticOrder S0; S0.init(M, DM, G, (int)blockIdx.x); pg8::Unit u0; BranchOrder S{0, 0};
        if (S0.next(0, u0)) { S.pm0 = u0.pm; S.pn0 = u0.pn; }
        pg8::Gemm g{Y, WBR + (size_t)l * 3 * DM * BW, 3 * M, 3 * DM, BW}; EpiBranch E{PROJ, REGC, REGB};
        pg8::gemm_phase<EpiBranch, BranchOrder, true, true>(lds3, g, S, E, wv);
    }
    grid_bar(lds);
    ts_mark(lds, 6);
    {
        Args a; load_args(a, lds); const int G = gridDim.x;
        bf16* WOUT = (bf16*)(a.ws + WS_WOUT); bf16* REGB = (bf16*)(a.ws + WS_REGB); float* REGC = (float*)(a.ws + WS_REGC);
        pg8::Gemm g{REGB, WOUT + (size_t)l * DM * DM, M, DM, DM}; pg8::StaticOrder S; S.init(M, DM, G, (int)blockIdx.x);
        EpiOutF32 E{REGC};
        pg8::gemm_phase<EpiOutF32, pg8::StaticOrder, true, true>(lds3, g, S, E, wv);
    }
    grid_bar(lds);
    ts_mark(lds, 7);
    { Args a; load_args(a, lds); phase_postnorm(a, l, wv); }
    if (L + 1 < DEPTH) grid_bar(lds);
    ts_mark(lds, 8);
}
__global__ void __launch_bounds__(NTHR, 2) fwd(Args a0) {
    extern __shared__ __attribute__((aligned(16))) unsigned char lds[];
    cg::grid_group grid = cg::this_grid();
    const int wv = __builtin_amdgcn_readfirstlane((int)threadIdx.x >> 6);
    if (threadIdx.x < 2) ((volatile LAS unsigned*)((LAS unsigned char*)lds + XB_ST_OFF))[threadIdx.x] = 0u;
    __syncthreads();
    (void)xcd_barrier_post((unsigned*)(a0.ws + WS_CTL) + XB_WORD0, (volatile LAS unsigned*)((LAS unsigned char*)lds + XB_ST_OFF));
    if (threadIdx.x == 0) { unsigned w[ARGS_WORDS]; __builtin_memcpy(w, &a0, sizeof(Args));
#pragma unroll
        for (int i = 0; i < ARGS_WORDS; ++i) ((volatile LAS unsigned*)((LAS unsigned char*)lds + ARGS_OFF))[i] = w[i]; }
    if (PROBE_SEL >= 0 && threadIdx.x == 0) { volatile LAS unsigned long long* p = (volatile LAS unsigned long long*)((LAS unsigned char*)lds + TS_OFF); for (int i = 1; i < 17; ++i) p[i] = 0; p[0] = __builtin_amdgcn_s_memrealtime(); }
    __syncthreads();
    { Args a; load_args(a, lds); phase_prologue(a, lds, wv); }
    grid.sync();
    ts_mark(lds, 0);
    run_layer<0>(lds, grid, wv);
    run_layer<1>(lds, grid, wv);
    run_layer<2>(lds, grid, wv);
    run_layer<3>(lds, grid, wv);
    if (PROBE_SEL >= 0 && blockIdx.x == 0 && threadIdx.x == 0) { volatile LAS unsigned long long* p = (volatile LAS unsigned long long*)((LAS unsigned char*)lds + TS_OFF);
        Args a; load_args(a, lds); a.out[0] = floorf((float)p[1 + PROBE_SEL] * 0.01f * 0.02f + 0.5f) * 50.f; }
}

extern "C" void kernel_launch(void* const* d_in, const int* in_sizes, int n_in, void* d_out, int out_size, void* d_ws, size_t ws_size, hipStream_t stream) {
    static int grid = 0;
    if (grid == 0) {
        if (n_in != 13 || ws_size < WS_END) { fprintf(stderr, "kernel_launch: unexpected n_in %d or ws %zu\n", n_in, ws_size); grid = -1; return; }
        int dev = 0, cus = 0, per_cu = 0;
        hipGetDevice(&dev); hipDeviceGetAttribute(&cus, hipDeviceAttributeMultiprocessorCount, dev);
        hipFuncSetAttribute((const void*)fwd, hipFuncAttributeMaxDynamicSharedMemorySize, LDS_BYTES);
        hipOccupancyMaxActiveBlocksPerMultiprocessor(&per_cu, (const void*)fwd, NTHR, LDS_BYTES);
        (void)hipGetLastError();
        if (per_cu < 1) { fprintf(stderr, "kernel_launch: occupancy query says %d\n", per_cu); per_cu = 1; }
        grid = cus;
    }
    if (grid < 0) return;
    Args a{};
    a.x = (const float*)d_in[0]; a.norm_pre = (const float*)d_in[1]; a.norm_post = (const float*)d_in[2]; a.w_in = (const float*)d_in[3]; a.gdn_conv_w = (const float*)d_in[4];
    a.gdn_a_log = (const float*)d_in[5]; a.gdn_dt_bias = (const float*)d_in[6]; a.gdn_norm_w = (const float*)d_in[7]; a.diff_lambda = (const float*)d_in[8]; a.diff_norm_w = (const float*)d_in[9];
    a.sc_conv_w = (const float*)d_in[10]; a.w_branch = (const float*)d_in[11]; a.w_out = (const float*)d_in[12];
    a.out = (float*)d_out; a.ws = (unsigned char*)d_ws; a.ph_lo = 0; a.ph_hi = 0; a.coop = 1; a.pad = 0;
    if (hipMemsetAsync((char*)d_ws + WS_CTL, 0, 65536, stream) != hipSuccess) { fprintf(stderr, "kernel_launch: memset of the control words failed\n"); return; }
    void* args[] = {&a};
    hipError_t e = hipLaunchCooperativeKernel((const void*)fwd, dim3(grid), dim3(NTHR), args, LDS_BYTES, stream);
    if (e != hipSuccess) fprintf(stderr, "cooperative launch failed: %s (grid %d)\n", hipGetErrorString(e), grid);
}
```

```cpp
#include <hip/hip_runtime.h>
#include <hip/hip_cooperative_groups.h>
#include <cstdio>
#include <cstdint>
namespace cg = cooperative_groups;
__device__ __forceinline__ int mk_lane() { int r; asm volatile("v_mbcnt_lo_u32_b32 %0, -1, 0\n\tv_mbcnt_hi_u32_b32 %0, -1, %0" : "=v"(r)); return r; }
namespace pg8 {
#define PG8_LAS __attribute__((address_space(3)))
typedef unsigned short bf16_t;
typedef short bf16x8 __attribute__((ext_vector_type(8)));
typedef float f32x4 __attribute__((ext_vector_type(4)));
typedef unsigned u32x4 __attribute__((ext_vector_type(4)));
constexpr int BM = 256, BK = 64, HALF = 128, HTB = HALF * BK * 2  , STAGE_BYTES = 8 * HTB, NXCD = 8, WGM = 8;

__host__ __device__ __forceinline__ int lds_byte(int r, int c) { const int st = (r >> 4) * 2 + (c >> 5), rr = r & 15, cc = c & 31, ob = rr * 64 + cc * 2; return st * 1024 + (ob ^ (((ob >> 9) & 1) << 5)); }
__host__ __device__ __forceinline__ void stage_rc(int b, int& R, int& C) { const int st = b / 1024, sb = b % 1024, swz = sb ^ (((sb >> 9) & 1) << 5); R = (st >> 1) * 16 + swz / 64; C = (st & 1) * 32 + (swz % 64) / 2; }
__host__ __device__ __forceinline__ int perm32(int rho) { const int n = rho >> 4, i = rho & 15; return 8 * (i >> 2) + 4 * n + (i & 3); }

struct Unit { int pm, pn; };
struct Gemm { const bf16_t* A; const bf16_t* Bt; int M, N, K; };

struct StaticOrder {
    int nM, nN, nwg, G, c;
    __host__ __device__ void init(int M, int N, int G_, int c_) { nM = M / BM; nN = N / BM; nwg = nM * nN; G = G_; c = c_; }
    __host__ __device__ bool next(int i, Unit& u) const {
        const long L = (long)i * G + c; if (L >= nwg) return false;
        int wgid = (int)L; { const int q = nwg / NXCD, r = nwg % NXCD, xcd = wgid % NXCD, off = wgid / NXCD; wgid = (xcd < r ? xcd * (q + 1) : r * (q + 1) + (xcd - r) * q) + off; }
        const int nig = WGM * nN, gid = wgid / nig, fm = gid * WGM, gsz = (nM - fm) < WGM ? (nM - fm) : WGM;
        u.pm = fm + ((wgid % nig) % gsz); u.pn = (wgid % nig) / gsz; return true;
    }
    __device__ __forceinline__ void a_ready(const Unit&) const {}
    __device__ __forceinline__ void done(const Unit&) const {}
};
__device__ __forceinline__ unsigned cvt_pk_bf16(float lo, float hi) { unsigned r; asm volatile("v_cvt_pk_bf16_f32 %0, %1, %2" : "=v"(r) : "v"(lo), "v"(hi)); return r; }
typedef float f32x2 __attribute__((ext_vector_type(2)));
template <class Epi, class Sched, bool ALIGN_EPI = false, bool SP2 = false>
__device__ __forceinline__ void gemm_phase(PG8_LAS unsigned char* lds, const Gemm g, const Sched& S, const Epi& E, int wv_) {
    int tid_ = wv_ * 64 + mk_lane(); asm volatile("" : "+v"(tid_)); const int tid = tid_, wid = __builtin_amdgcn_readfirstlane(tid >> 6), lane = tid & 63, wr = wid >> 2, wc = wid & 3, fr = lane & 15, fq = lane >> 4;
    const int K = g.K, nt = K / BK;
    unsigned voffA[2], voffB[2];
#pragma unroll
    for (int i = 0; i < 2; ++i) { int R, C; stage_rc(tid * 16 + i * 8192, R, C); const int Rb = Epi::PERM ? ((R & ~31) + perm32(R & 31)) : R;
        voffA[i] = (unsigned)(R * K + C) * 2u; voffB[i] = (unsigned)(Rb * K + C) * 2u; }
    const size_t kstep = (size_t)(BK * 2);
    const size_t hstep = (size_t)HALF * K * 2;
    const size_t tstep = 2 * hstep;
    const unsigned ldsw = (unsigned)wid * 1024u;
    const int aoff = lds_byte(wr * 64 + fr, fq * 8), boff = lds_byte(wc * 32 + fr, fq * 8);
#define PG8_SA(b, h) (((b) * 2 + (h)) * HTB)
#define PG8_SB(b, h) ((4 + (b) * 2 + (h)) * HTB)
#define PG8_STAGE(bufoff, gbase, voff) do { _Pragma("unroll") for (int _i = 0; _i < 2; ++_i) \
        __builtin_amdgcn_global_load_lds((const unsigned*)((const char*)(gbase) + (voff)[_i]), (PG8_LAS unsigned*)(lds + (bufoff) + ldsw + _i * 8192), 16, 0, 0); } while (0)
#define PG8_LDA(dst, b, h) do { _Pragma("unroll") for (int m = 0; m < 4; ++m) _Pragma("unroll") for (int k = 0; k < 2; ++k) dst[m][k] = *(const PG8_LAS bf16x8*)(lds + PG8_SA(b, h) + aoff + m * 2048 + k * 1024); } while (0)
#define PG8_LDB(dst, b, h) do { _Pragma("unroll") for (int n = 0; n < 2; ++n) _Pragma("unroll") for (int k = 0; k < 2; ++k) dst[n][k] = *(const PG8_LAS bf16x8*)(lds + PG8_SB(b, h) + boff + n * 2048 + k * 1024); } while (0)
#define PG8_MMA(ai, bj, At, Bt) do { __builtin_amdgcn_s_setprio(1); _Pragma("unroll") for (int m = 0; m < 4; ++m) _Pragma("unroll") for (int n = 0; n < 2; ++n) _Pragma("unroll") for (int k = 0; k < 2; ++k) \
        acc[ai][bj][m][n] = __builtin_amdgcn_mfma_f32_16x16x32_bf16(Bt[n][k], At[m][k], acc[ai][bj][m][n], 0, 0, 0); __builtin_amdgcn_s_setprio(0); } while (0)
#define PG8_WAIT_V(n) asm volatile("s_waitcnt vmcnt(" #n ")" ::: "memory")
#define PG8_WAIT_L(n) asm volatile("s_waitcnt lgkmcnt(" #n ")" ::: "memory")
#define PG8_BAR __builtin_amdgcn_s_barrier()
#define PG8_SCHED __builtin_amdgcn_sched_barrier(0)
    Unit cur, nxt; int ui = 0;
    if (!S.next(0, cur)) return;
    f32x4 acc[2][2][4][2];
#pragma unroll
    for (int a = 0; a < 2; ++a)
#pragma unroll
        for (int b = 0; b < 2; ++b)
#pragma unroll
            for (int m = 0; m < 4; ++m)
#pragma unroll
                for (int n = 0; n < 2; ++n) acc[a][b][m][n] = (f32x4){0.f, 0.f, 0.f, 0.f};
    bf16x8 At[4][2], B0[2][2], B1[2][2];
    const char* cA = (const char*)g.A + (size_t)cur.pm * tstep; const char* cB = (const char*)g.Bt + (size_t)cur.pn * tstep;
    S.a_ready(cur);
    if constexpr (SP2) {
        PG8_STAGE(PG8_SB(0, 0), cB, voffB); PG8_STAGE(PG8_SB(0, 1), cB + hstep, voffB); PG8_STAGE(PG8_SA(0, 0), cA, voffA); PG8_STAGE(PG8_SA(0, 1), cA + hstep, voffA);
        if (wr == 1) PG8_BAR;
        PG8_WAIT_V(2); PG8_BAR;
        PG8_STAGE(PG8_SB(1, 0), cB + kstep, voffB); PG8_STAGE(PG8_SA(1, 0), cA + kstep, voffA); PG8_STAGE(PG8_SB(1, 1), cB + hstep + kstep, voffB);
        PG8_WAIT_V(6); PG8_BAR;
    } else {
        PG8_STAGE(PG8_SB(0, 0), cB, voffB); PG8_STAGE(PG8_SA(0, 0), cA, voffA); PG8_STAGE(PG8_SB(0, 1), cB + hstep, voffB); PG8_STAGE(PG8_SA(0, 1), cA + hstep, voffA);
        if (wr == 1) PG8_BAR;
        PG8_WAIT_V(4); PG8_BAR;
        PG8_STAGE(PG8_SB(1, 0), cB + kstep, voffB); PG8_STAGE(PG8_SA(1, 0), cA + kstep, voffA); PG8_STAGE(PG8_SB(1, 1), cB + hstep + kstep, voffB);
        PG8_WAIT_V(6); PG8_BAR;
    }
    for (;;) {
        const bool has_next = S.next(ui + 1, nxt);
        const char* nA = has_next ? (const char*)g.A + (size_t)nxt.pm * tstep : cA; const char* nB = has_next ? (const char*)g.Bt + (size_t)nxt.pn * tstep : cB;
        for (int t = 0; t < nt; t += 2) {
            const bool last = (t == nt - 2);
            const char* a1 = cA + (size_t)(t + 1) * kstep;
            const char* a2 = last ? nA : cA + (size_t)(t + 2) * kstep; const char* b2 = last ? nB : cB + (size_t)(t + 2) * kstep;
            const char* a3 = a2 + kstep; const char* b3 = b2 + kstep;
            if (last && has_next) S.a_ready(nxt);
            if constexpr (SP2) {
            PG8_LDB(B0, 0, 0); PG8_LDB(B1, 0, 1); PG8_SCHED; PG8_LDA(At, 0, 0); PG8_STAGE(PG8_SA(1, 1), a1 + hstep, voffA);
            PG8_WAIT_V(8); PG8_WAIT_L(0); PG8_BAR; PG8_MMA(0, 0, At, B0); PG8_MMA(0, 1, At, B1); PG8_BAR; PG8_SCHED;
            PG8_LDA(At, 0, 1); PG8_STAGE(PG8_SB(0, 0), b2, voffB); PG8_STAGE(PG8_SB(0, 1), b2 + hstep, voffB); PG8_STAGE(PG8_SA(0, 0), a2, voffA);
            PG8_WAIT_V(8); PG8_WAIT_L(0); PG8_BAR; PG8_MMA(1, 0, At, B0); PG8_MMA(1, 1, At, B1); PG8_BAR; PG8_SCHED;
            PG8_LDB(B0, 1, 0); PG8_LDB(B1, 1, 1); PG8_SCHED; PG8_LDA(At, 1, 0); PG8_STAGE(PG8_SA(0, 1), a2 + hstep, voffA);
            PG8_WAIT_V(8); PG8_WAIT_L(0); PG8_BAR; PG8_MMA(0, 0, At, B0); PG8_MMA(0, 1, At, B1); PG8_BAR; PG8_SCHED;
            PG8_LDA(At, 1, 1); PG8_STAGE(PG8_SB(1, 0), b3, voffB); PG8_STAGE(PG8_SB(1, 1), b3 + hstep, voffB); PG8_STAGE(PG8_SA(1, 0), a3, voffA);
            PG8_WAIT_V(8); PG8_WAIT_L(0); PG8_BAR; PG8_MMA(1, 0, At, B0); PG8_MMA(1, 1, At, B1); PG8_BAR; PG8_SCHED;
            } else {
            PG8_LDB(B0, 0, 0); PG8_SCHED; PG8_LDA(At, 0, 0); PG8_STAGE(PG8_SA(1, 1), a1 + hstep, voffA);
            PG8_WAIT_L(8); PG8_BAR; PG8_WAIT_L(0); PG8_MMA(0, 0, At, B0); PG8_BAR; PG8_SCHED;
            PG8_LDB(B1, 0, 1); PG8_STAGE(PG8_SB(0, 0), b2, voffB);
            PG8_BAR; PG8_WAIT_L(0); PG8_MMA(0, 1, At, B1); PG8_BAR;
            PG8_LDA(At, 0, 1); PG8_STAGE(PG8_SA(0, 0), a2, voffA);
            PG8_BAR; PG8_WAIT_L(0); PG8_MMA(1, 0, At, B0); PG8_BAR; PG8_SCHED;
            PG8_STAGE(PG8_SB(0, 1), b2 + hstep, voffB);
            PG8_WAIT_V(6); PG8_BAR; PG8_MMA(1, 1, At, B1); PG8_BAR;
            PG8_LDB(B0, 1, 0); PG8_SCHED; PG8_LDA(At, 1, 0); PG8_STAGE(PG8_SA(0, 1), a2 + hstep, voffA);
            PG8_WAIT_L(8); PG8_BAR; PG8_WAIT_L(0); PG8_MMA(0, 0, At, B0); PG8_BAR; PG8_SCHED;
            PG8_LDB(B1, 1, 1); PG8_STAGE(PG8_SB(1, 0), b3, voffB);
            PG8_BAR; PG8_WAIT_L(0); PG8_MMA(0, 1, At, B1); PG8_BAR;
            PG8_LDA(At, 1, 1); PG8_STAGE(PG8_SA(1, 0), a3, voffA);
            PG8_BAR; PG8_WAIT_L(0); PG8_MMA(1, 0, At, B0); PG8_BAR; PG8_SCHED;
            PG8_STAGE(PG8_SB(1, 1), b3 + hstep, voffB);
            PG8_WAIT_V(6); PG8_BAR; PG8_MMA(1, 1, At, B1); PG8_BAR;
            }
        }
        if constexpr (ALIGN_EPI) { if (wr == 0) PG8_BAR; }
        if constexpr (!Epi::AFTER_DRAIN) { E(acc, cur, wr, wc, fr, fq); S.done(cur); }
        if (!has_next) break;
#pragma unroll
        for (int a = 0; a < 2; ++a)
#pragma unroll
            for (int b = 0; b < 2; ++b)
#pragma unroll
                for (int m = 0; m < 4; ++m)
#pragma unroll
                    for (int n = 0; n < 2; ++n) acc[a][b][m][n] = (f32x4){0.f, 0.f, 0.f, 0.f};
        cur = nxt; cA = nA; cB = nB; ++ui;
        if constexpr (ALIGN_EPI) { if (wr == 1) PG8_BAR; }
    }
    PG8_WAIT_V(0);
    if constexpr (!ALIGN_EPI) { if (wr == 0) PG8_BAR; }
    PG8_BAR;
    if constexpr (Epi::AFTER_DRAIN) { E.fused(acc, cur, wr, wc, fr, fq, lds, wid, lane); S.done(cur); }
#undef PG8_SA
#undef PG8_SB
#undef PG8_STAGE
#undef PG8_LDA
#undef PG8_LDB
#undef PG8_MMA
#undef PG8_WAIT_V
#undef PG8_WAIT_L
#undef PG8_BAR
#undef PG8_SCHED
}
}
constexpr int BATCH = 2, SEQ = 8192, DM = 1024, DEPTH = 4, M = BATCH * SEQ;
constexpr int NIN = 9224, NP = 9216, NPAD = 9472, BW = 512;
constexpr int C_GQ = 0, C_GK = 512, C_GV = 1024, C_GZ = 1536, C_DQ = 2048, C_DK = 2560, C_DV = 3072, C_DZ = 3584,
              C_SB = 4096, C_SC = 4608, C_SX = 5120, C_SZ = 5632, C_MG = 6144;
constexpr float EPS = 1e-6f;
constexpr int NWAVES = 8, NTHR = 512;
constexpr int LDS_BYTES = 147456;
constexpr size_t MiB = 1u << 20;
constexpr size_t WS_CTL = 0;
constexpr size_t WS_WIN = 2 * MiB;
constexpr size_t WIN_L = (size_t)NPAD * DM;
constexpr size_t WS_WBR = 76 * MiB;
constexpr size_t WS_WOUT = 88 * MiB;
constexpr size_t WS_PROJ = 96 * MiB;
constexpr size_t WS_BA = 384 * MiB;
constexpr size_t WS_REGB = 386 * MiB;
constexpr size_t WS_REGC = 418 * MiB;
constexpr size_t WS_REGD = 482 * MiB;
constexpr size_t WS_GL = 554 * MiB;
constexpr size_t WS_END = 555 * MiB;
constexpr int NUNIT = BATCH * 4 * 128;
constexpr size_t UREC = 36864, R_W = 0, R_QD = 8192, R_KD = 16384, R_QK = 24576, R_U = 28672;

typedef unsigned short bf16;
typedef unsigned v4u __attribute__((ext_vector_type(4)));
typedef unsigned v2u __attribute__((ext_vector_type(2)));
typedef float f32x4 __attribute__((ext_vector_type(4)));
#define LAS __attribute__((address_space(3)))

__device__ __forceinline__ unsigned f2bf(float f) { unsigned u = __builtin_bit_cast(unsigned, f); return (u + 0x7fffu + ((u >> 16) & 1u)) >> 16; }
__device__ __forceinline__ unsigned pk2(float lo, float hi) { return f2bf(lo) | (f2bf(hi) << 16); }
__device__ __forceinline__ float bf2f(unsigned short b) { return __builtin_bit_cast(float, (unsigned)b << 16); }
__device__ __forceinline__ float bflo(unsigned w) { return __builtin_bit_cast(float, w << 16); }
__device__ __forceinline__ float bfhi(unsigned w) { return __builtin_bit_cast(float, w & 0xffff0000u); }
__device__ __forceinline__ void ld8(const bf16* p, float* f) { const v4u w = *(const v4u*)p; f[0] = bflo(w.x); f[1] = bfhi(w.x); f[2] = bflo(w.y); f[3] = bfhi(w.y); f[4] = bflo(w.z); f[5] = bfhi(w.z); f[6] = bflo(w.w); f[7] = bfhi(w.w); }
__device__ __forceinline__ void st8(bf16* p, const float* f) { v4u w; w.x = pk2(f[0], f[1]); w.y = pk2(f[2], f[3]); w.z = pk2(f[4], f[5]); w.w = pk2(f[6], f[7]); *(v4u*)p = w; }
__device__ __forceinline__ float wave_sum(float v) {
#pragma unroll
    for (int o = 1; o < 64; o <<= 1) v += __shfl_xor(v, o);
    return v;
}
__device__ __forceinline__ float sigmoidf_(float x) { return 1.f / (1.f + __expf(-x)); }
__device__ __forceinline__ float siluf_(float x) { return x / (1.f + __expf(-x)); }
__device__ __forceinline__ int srccol(int p) { return p < 2048 ? p : (p < 9216 ? p + 8 : (p < 9224 ? 2048 + (p - 9216) : -1)); }

struct Args {
    const float* x; const float* norm_pre; const float* norm_post; const float* w_in; const float* gdn_conv_w; const float* gdn_a_log; const float* gdn_dt_bias;
    const float* gdn_norm_w; const float* diff_lambda; const float* diff_norm_w; const float* sc_conv_w; const float* w_branch; const float* w_out;
    float* out; unsigned char* ws; int ph_lo, ph_hi, coop, pad;
};

struct EpiProj {
    static constexpr bool PERM = true, AFTER_DRAIN = false;
    bf16* P; float* BA;
    __device__ __forceinline__ void operator()(const pg8::f32x4 (&acc)[2][2][4][2], const pg8::Unit& u, int wr, int wc, int fr, int fq) const {
        const int row0 = u.pm * 256 + wr * 64 + fr;
        if (u.pn == 36) {
            if (wc == 0 && fq == 0) {
#pragma unroll
                for (int ai = 0; ai < 2; ++ai)
#pragma unroll
                    for (int m = 0; m < 4; ++m) { float* o = BA + (size_t)(row0 + ai * 128 + m * 16) * 8; *(pg8::f32x4*)o = acc[ai][0][m][0]; *(pg8::f32x4*)(o + 4) = acc[ai][0][m][1]; }
            }
            return;
        }
        const int colt = u.pn * 256; const float sc = (colt >= C_DQ && colt < C_DK) ? 0.18033688011112042f : 1.f;
        const int col0 = colt + wc * 32 + 8 * fq;
#pragma unroll
        for (int ai = 0; ai < 2; ++ai)
#pragma unroll
            for (int m = 0; m < 4; ++m) { bf16* rowp = P + (size_t)(row0 + ai * 128 + m * 16) * NP + col0;
#pragma unroll
                for (int bj = 0; bj < 2; ++bj) { const pg8::f32x4 v0 = acc[ai][bj][m][0] * sc, v1 = acc[ai][bj][m][1] * sc; v4u w;
                    w.x = pg8::cvt_pk_bf16(v0[0], v0[1]); w.y = pg8::cvt_pk_bf16(v0[2], v0[3]); w.z = pg8::cvt_pk_bf16(v1[0], v1[1]); w.w = pg8::cvt_pk_bf16(v1[2], v1[3]);
                    *(v4u*)(rowp + bj * 128) = w; } }
    }
};
struct BranchOrder {
    int pm0, pn0;
    __device__ __forceinline__ bool next(int i, pg8::Unit& u) const { if (i >= 3) return false; u.pm = i * 64 + pm0; u.pn = i * 4 + pn0; return true; }
    __device__ __forceinline__ void a_ready(const pg8::Unit&) const {}
    __device__ __forceinline__ void done(const pg8::Unit&) const {}
};
struct EpiBranch {
    static constexpr bool PERM = true, AFTER_DRAIN = false;
    const bf16* P; float* MG; bf16* MB;
    __device__ __forceinline__ void operator()(const pg8::f32x4 (&acc)[2][2][4][2], const pg8::Unit& u, int wr, int wc, int fr, int fq) const {
        const int kb = u.pn >> 2;
        const int row0 = (u.pm & 63) * 256 + wr * 64 + fr; const int col0 = (u.pn & 3) * 256 + wc * 32 + 8 * fq;
#pragma unroll
        for (int ai = 0; ai < 2; ++ai)
#pragma unroll
            for (int m = 0; m < 4; ++m) { const size_t row = (size_t)(row0 + ai * 128 + m * 16);
#pragma unroll
                for (int bj = 0; bj < 2; ++bj) { const int col = col0 + bj * 128; float lg[8]; ld8(P + row * NP + C_MG + kb * 1024 + col, lg);
                    float v[8];
#pragma unroll
                    for (int j = 0; j < 4; ++j) { v[j] = acc[ai][bj][m][0][j] * sigmoidf_(lg[j]); v[4 + j] = acc[ai][bj][m][1][j] * sigmoidf_(lg[4 + j]); }
                    bf16* mp = MB + row * DM + col;
                    if (kb > 0) { float pv[8]; ld8(mp, pv);
#pragma unroll
                        for (int j = 0; j < 8; ++j) v[j] += pv[j]; }
                    st8(mp, v); } }
    }
};
struct EpiOutBf16 {
    static constexpr bool PERM = true, AFTER_DRAIN = false;
    bf16* O;
    __device__ __forceinline__ void operator()(const pg8::f32x4 (&acc)[2][2][4][2], const pg8::Unit& u, int wr, int wc, int fr, int fq) const {
        const int row0 = u.pm * 256 + wr * 64 + fr; const int col0 = u.pn * 256 + wc * 32 + 8 * fq;
#pragma unroll
        for (int ai = 0; ai < 2; ++ai)
#pragma unroll
            for (int m = 0; m < 4; ++m) { bf16* rowp = O + (size_t)(row0 + ai * 128 + m * 16) * DM + col0;
#pragma unroll
                for (int bj = 0; bj < 2; ++bj) { const pg8::f32x4 v0 = acc[ai][bj][m][0], v1 = acc[ai][bj][m][1]; v4u w;
                    w.x = pg8::cvt_pk_bf16(v0[0], v0[1]); w.y = pg8::cvt_pk_bf16(v0[2], v0[3]); w.z = pg8::cvt_pk_bf16(v1[0], v1[1]); w.w = pg8::cvt_pk_bf16(v1[2], v1[3]);
                    *(v4u*)(rowp + bj * 128) = w; } }
    }
};

__device__ __forceinline__ void tr_item(const float* W, int ldw, int K, bf16* WT, int k0, int p0, int mode, float* scr, int lane) {
    const int n = lane & 31; const int p = p0 + n; const int sc = mode ? srccol(p) : p;
#pragma unroll 8
    for (int i = 0; i < 32; ++i) { const int kk = 2 * i + (lane >> 5); scr[kk * 33 + n] = sc >= 0 ? W[(size_t)(k0 + kk) * ldw + sc] : 0.f; }
    asm volatile("s_waitcnt lgkmcnt(0)" ::: "memory");
    const int c = lane & 7;
#pragma unroll
    for (int j = 0; j < 4; ++j) { const int nn = (lane >> 3) + 8 * j; const float* s = scr + (8 * c) * 33 + nn;
        v4u o; o.x = pk2(s[0 * 33], s[1 * 33]); o.y = pk2(s[2 * 33], s[3 * 33]); o.z = pk2(s[4 * 33], s[5 * 33]); o.w = pk2(s[6 * 33], s[7 * 33]);
        *(v4u*)(WT + (size_t)(p0 + nn) * K + k0 + 8 * c) = o; }
    asm volatile("s_waitcnt lgkmcnt(0)" ::: "memory");
}
__device__ __forceinline__ void norm_row_to_h(const float* xrow, const float* wpre, bf16* hrow, int lane) {
    f32x4 v[4]; float s = 0.f;
#pragma unroll
    for (int j = 0; j < 4; ++j) { v[j] = *(const f32x4*)(xrow + 4 * lane + 256 * j); s += (v[j].x * v[j].x + v[j].y * v[j].y) + (v[j].z * v[j].z + v[j].w * v[j].w); }
    const float rs = rsqrtf(wave_sum(s) * (1.f / DM) + EPS);
#pragma unroll
    for (int j = 0; j < 4; ++j) { const f32x4 w = *(const f32x4*)(wpre + 4 * lane + 256 * j); v2u o; o.x = pk2(v[j].x * rs * w.x, v[j].y * rs * w.y); o.y = pk2(v[j].z * rs * w.z, v[j].w * rs * w.w);
        *(v2u*)(hrow + 4 * lane + 256 * j) = o; }
}
__device__ __forceinline__ void phase_prologue(const Args& a, unsigned char* lds, int wv_) {
    int tid_ = wv_ * 64 + mk_lane(); asm volatile("" : "+v"(tid_)); const int tid = tid_, lane = tid & 63, wave = tid >> 6;
    float* scr = (float*)(lds + wave * 16384);
    const int gw = blockIdx.x * NWAVES + wave, NGW = gridDim.x * NWAVES;
    constexpr int I_IN = (DM / 64) * (NPAD / 32), I_BR = (BW / 64) * (DM / 32), I_OUT = (DM / 64) * (DM / 32);
    constexpr int NITEMS = DEPTH * I_IN + DEPTH * 3 * I_BR + DEPTH * I_OUT;
    bf16* win = (bf16*)(a.ws + WS_WIN); bf16* wbr = (bf16*)(a.ws + WS_WBR); bf16* wout = (bf16*)(a.ws + WS_WOUT);
    for (int it = gw; it < NITEMS; it += NGW) {
        int r = it;
        if (r < DEPTH * I_IN) { const int l = r / I_IN; r %= I_IN; const int nb = NPAD / 32, kb = r / nb, pb = r % nb;
            tr_item(a.w_in + (size_t)l * DM * NIN, NIN, DM, win + (size_t)l * WIN_L, kb * 64, pb * 32, 1, scr, lane); continue; }
        r -= DEPTH * I_IN;
        if (r < DEPTH * 3 * I_BR) { const int lk = r / I_BR; r %= I_BR; const int nb = DM / 32, kb = r / nb, pb = r % nb;
            tr_item(a.w_branch + (size_t)lk * BW * DM, DM, BW, wbr + (size_t)lk * DM * BW, kb * 64, pb * 32, 0, scr, lane); continue; }
        r -= DEPTH * 3 * I_BR;
        { const int l = r / I_OUT; r %= I_OUT; const int nb = DM / 32, kb = r / nb, pb = r % nb;
            tr_item(a.w_out + (size_t)l * DM * DM, DM, DM, wout + (size_t)l * DM * DM, kb * 64, pb * 32, 0, scr, lane); }
    }
    if (blockIdx.x == 0 && tid < DEPTH) ((unsigned*)(a.ws + WS_CTL))[64 * tid] = 0u;
    bf16* H = (bf16*)(a.ws + WS_REGB);
    for (int m = gw; m < M; m += NGW) norm_row_to_h(a.x + (size_t)m * DM, a.norm_pre, H + (size_t)m * DM, lane);
}

typedef short bf16x8 __attribute__((ext_vector_type(8)));
typedef float f32x16 __attribute__((ext_vector_type(16)));
typedef float f32x2_t __attribute__((ext_vector_type(2))); typedef __bf16 bf16x2_t __attribute__((ext_vector_type(2)));
__device__ __forceinline__ unsigned cvtpk(float lo, float hi) { f32x2_t v = {lo, hi}; bf16x2_t bb = __builtin_convertvector(v, bf16x2_t); return __builtin_bit_cast(unsigned, bb); }
__device__ __forceinline__ int crow(int r, int hi) { return (r & 3) + 8 * (r >> 2) + 4 * hi; }
#define MFMA32(a, b, c) __builtin_amdgcn_mfma_f32_32x32x16_bf16((a), (b), (c), 0, 0, 0)
constexpr int AT_KS = 0, AT_VT = 64 * 144, AT_BUF = 32768, AT_FS = 65536, AT_CTR = AT_FS + 1024;
__device__ __forceinline__ void phase_attn(const Args& a, unsigned char* lds, int l, int wv_) {
    const bf16* P = (const bf16*)(a.ws + WS_PROJ); float* OATT = (float*)(a.ws + WS_REGC);
    int tid_ = wv_ * 64 + mk_lane(); asm volatile("" : "+v"(tid_)); const int tid = tid_, lane = tid & 63, r32 = lane & 31, hi = lane >> 5, wave = tid >> 6;
    float* fs = (float*)(lds + AT_FS) + wave * 32;
    unsigned* ctr = (unsigned*)(a.ws + WS_CTL) + 64 * l;
#pragma unroll 1
    for (;;) {
        __syncthreads();
        if (tid == 0) *(volatile unsigned*)(lds + AT_CTR) = atomicAdd(ctr, 1u);
        __syncthreads();
        const unsigned uidx = *(volatile unsigned*)(lds + AT_CTR);
        if (uidx >= 576u) break;
        int h, rows0, nw; const int bb = (int)((uidx >> 1) & 1u), mp = (int)(uidx & 1u);
        if (uidx < 128u) { h = 3; rows0 = (63 - (int)(uidx >> 2)) * 128; nw = 4; }
        else if (uidx < 192u) { h = 3; rows0 = (15 - (int)((uidx - 128u) >> 2)) * 256; nw = 8; }
        else { const unsigned v = uidx - 192u; h = 2 - (int)(v >> 7); rows0 = (31 - (int)((v & 127u) >> 2)) * 256; nw = 8; }
        const int stream = bb * 8 + h * 2 + mp; const bool act = wave < nw;
        const float slope2 = exp2f(-2.f * (float)(h + 1)) * 1.4426950408889634f;
        const bf16* Kg = P + (size_t)bb * SEQ * NP + C_DK + h * 128 + mp * 64 + (size_t)(tid >> 3) * NP + (tid & 7) * 8;
        const int vp = tid & 31, vc = tid >> 5;
        const bf16* Vg = P + (size_t)bb * SEQ * NP + C_DV + h * 128 + (size_t)(2 * vp) * NP + vc * 8;
        const int vpos = ((2 * vp) & 48) | (((2 * vp) & 4) << 1) | (((2 * vp) & 8) >> 1) | ((2 * vp) & 3);
        {
            const int q0 = rows0 + (act ? wave : 0) * 32, t = q0 + r32;
            bf16x8 qr[4];
            { const bf16* qp = P + ((size_t)bb * SEQ + t) * NP + C_DQ + h * 128 + mp * 64 + hi * 8;
#pragma unroll
              for (int d0 = 0; d0 < 4; ++d0) qr[d0] = *(const bf16x8*)(qp + d0 * 16); }
            float cb[16];
#pragma unroll
            for (int r = 0; r < 16; ++r) cb[r] = slope2 * (float)crow(r, hi);
            float qkb;
            { float qs = 0.f;
#pragma unroll
              for (int d0 = 0; d0 < 4; ++d0)
#pragma unroll
                  for (int j = 0; j < 8; ++j) { const float v = bf2f((unsigned short)qr[d0][j]); qs += v * v; }
              qs += __shfl_xor(qs, 32);
              const float km = __uint_as_float(__hip_atomic_load((unsigned*)(a.ws + WS_CTL) + 1024 + 16 * l + stream, __ATOMIC_RELAXED, __HIP_MEMORY_SCOPE_AGENT));
              qkb = sqrtf(qs * km) * 1.01f + 0.01f; }
            bool wdone = !act;
            f32x16 o[4];
#pragma unroll
            for (int db = 0; db < 4; ++db)
#pragma unroll
                for (int r = 0; r < 16; ++r) o[db][r] = 0.f;
            float m_ref = -1e30f, lsum = 0.f;
            const int ntile = (rows0 + nw * 32) >> 6;
            v4u kreg, vreg0, vreg1;
#define AT_LOAD(tile) do { const size_t jo_ = (size_t)(tile) * 64 * NP; kreg = *(const v4u*)(Kg + jo_); vreg0 = *(const v4u*)(Vg + jo_); vreg1 = *(const v4u*)(Vg + jo_ + NP); } while (0)
#define AT_STORE(bufo) do { *(v4u*)(lds + (bufo) + AT_KS + (tid >> 3) * 144 + (tid & 7) * 16) = kreg; \
                unsigned* vt_ = (unsigned*)(lds + (bufo) + AT_VT + (vc * 8) * 144 + vpos * 2); \
                const unsigned a_[4] = {vreg0.x, vreg0.y, vreg0.z, vreg0.w}, b_[4] = {vreg1.x, vreg1.y, vreg1.z, vreg1.w}; \
                _Pragma("unroll") for (int x = 0; x < 4; ++x) { vt_[(2 * x) * 36] = (a_[x] & 0xffffu) | (b_[x] << 16); vt_[(2 * x + 1) * 36] = (a_[x] >> 16) | (b_[x] & 0xffff0000u); } } while (0)
            AT_LOAD(ntile - 1);
            __syncthreads();
            AT_STORE(0);
            AT_LOAD(ntile - 2);
            int bufo = 0;
#pragma unroll 1
            for (int tt = ntile - 1; tt >= 0; --tt) {
                if (__syncthreads_and(wdone ? 1 : 0)) break;
                if (tt > 0) { AT_STORE(bufo ^ AT_BUF); if (tt > 1) AT_LOAD(tt - 2); }
                const unsigned char* lb = lds + bufo;
                const int j0 = tt * 64;
                if (!wdone && j0 <= q0 + 31) {
                    const float base = slope2 * (float)(j0 - t), base1 = base + 32.f * slope2;
                    f32x16 p0, p1;
#pragma unroll
                    for (int r = 0; r < 16; ++r) { p0[r] = cb[r] + base; p1[r] = cb[r] + base1; }
                    { const unsigned char* kb = lb + AT_KS + r32 * 144 + hi * 16;
#pragma unroll
                      for (int d0 = 0; d0 < 4; ++d0) { const bf16x8 a0 = *(const bf16x8*)(kb + d0 * 32), a1 = *(const bf16x8*)(kb + 32 * 144 + d0 * 32);
                          p0 = MFMA32(a0, qr[d0], p0); p1 = MFMA32(a1, qr[d0], p1); } }
                    if (j0 + 63 > q0) {
#pragma unroll
                        for (int r = 0; r < 16; ++r) { const int kv = j0 + crow(r, hi); if (kv > t) p0[r] = -1e30f; if (kv + 32 > t) p1[r] = -1e30f; }
                    }
                    float mx = fmaxf(p0[0], p1[0]);
#pragma unroll
                    for (int r = 1; r < 16; ++r) mx = fmaxf(mx, fmaxf(p0[r], p1[r]));
                    mx = fmaxf(mx, __shfl_xor(mx, 32));
                    if (__any(mx > m_ref + 8.f)) {
                        const float m_new = fmaxf(m_ref, mx), f = __builtin_amdgcn_exp2f(m_ref - m_new); m_ref = m_new; lsum *= f;
                        if (hi == 0) fs[r32] = f;
                        __builtin_amdgcn_wave_barrier();
#pragma unroll
                        for (int g = 0; g < 4; ++g) { const f32x4 ff = *(const f32x4*)(fs + 8 * g + 4 * hi);
#pragma unroll
                            for (int db = 0; db < 4; ++db) { o[db][4 * g] *= ff.x; o[db][4 * g + 1] *= ff.y; o[db][4 * g + 2] *= ff.z; o[db][4 * g + 3] *= ff.w; } }
                        __builtin_amdgcn_wave_barrier();
                    }
                    float sacc = 0.f;
#pragma unroll
                    for (int r = 0; r < 16; ++r) { p0[r] = __builtin_amdgcn_exp2f(p0[r] - m_ref); p1[r] = __builtin_amdgcn_exp2f(p1[r] - m_ref); sacc += p0[r] + p1[r]; }
                    lsum += sacc;
                    bf16x8 pk[4];
#pragma unroll
                    for (int s = 0; s < 2; ++s) { v4u w0, w1;
                        w0.x = cvtpk(p0[8 * s], p0[8 * s + 1]); w0.y = cvtpk(p0[8 * s + 2], p0[8 * s + 3]); w0.z = cvtpk(p0[8 * s + 4], p0[8 * s + 5]); w0.w = cvtpk(p0[8 * s + 6], p0[8 * s + 7]);
                        w1.x = cvtpk(p1[8 * s], p1[8 * s + 1]); w1.y = cvtpk(p1[8 * s + 2], p1[8 * s + 3]); w1.z = cvtpk(p1[8 * s + 4], p1[8 * s + 5]); w1.w = cvtpk(p1[8 * s + 6], p1[8 * s + 7]);
                        pk[s] = __builtin_bit_cast(bf16x8, w0); pk[2 + s] = __builtin_bit_cast(bf16x8, w1); }
                    const unsigned char* vb = lb + AT_VT + r32 * 144 + hi * 16;
#pragma unroll
                    for (int s = 0; s < 4; ++s)
#pragma unroll
                        for (int db = 0; db < 4; ++db) o[db] = MFMA32(pk[s], *(const bf16x8*)(vb + db * 32 * 144 + s * 32), o[db]);
                    if (__all(qkb + slope2 * (float)(j0 - 1 - t) - m_ref < -40.f)) wdone = true;
                }
                bufo ^= AT_BUF;
            }
#undef AT_LOAD
#undef AT_STORE
            if (act) {
            lsum += __shfl_xor(lsum, 32);
            __builtin_amdgcn_wave_barrier();
            if (hi == 0) fs[r32] = 1.f / lsum;
            __builtin_amdgcn_wave_barrier();
#pragma unroll
            for (int g = 0; g < 4; ++g) { const f32x4 ff = *(const f32x4*)(fs + 8 * g + 4 * hi); const float fv[4] = {ff.x, ff.y, ff.z, ff.w};
#pragma unroll
                for (int x = 0; x < 4; ++x) { const size_t row = (size_t)bb * SEQ + q0 + 8 * g + 4 * hi + x; float* dst = OATT + ((row * 4 + h) * 2 + mp) * 128 + r32;
#pragma unroll
                    for (int db = 0; db < 4; ++db) dst[db * 32] = o[db][4 * g + x] * fv[x]; } }
            }
            __builtin_amdgcn_wave_barrier();
        }
    }
    __syncthreads();
}

__device__ __forceinline__ int afrag_off(int row, int k, int nks) { const int rt = row >> 5, r = row & 31, ks = k >> 4, kk = k & 15, h = (kk >> 2) & 1, j = ((kk >> 3) << 2) | (kk & 3); return ((rt * nks + ks) * 64 + r + 32 * h) * 8 + j; }
__device__ __forceinline__ int clay_off(int c, int dv) { const int rt = c >> 5, cc = c & 31, hi = (cc >> 2) & 1, i = ((cc >> 3) << 2) | (cc & 3), sl = dv >> 5, r32 = dv & 31; return ((rt * 4 + sl) * 64 + r32 + 32 * hi) * 16 + i; }
__device__ __forceinline__ void phase_gdn_local_v1(const Args& a, unsigned char* lds, int l, int wv_) {
    const bf16* P = (const bf16*)(a.ws + WS_PROJ); const float* BA = (const float*)(a.ws + WS_BA);
    bf16* GD = (bf16*)(a.ws + WS_REGD); float* GL = (float*)(a.ws + WS_GL);
    float* qs = (float*)lds; float* ks = qs + 64 * 129; float* vs = ks + 64 * 129; float* KKs = vs + 64 * 129; float* QKs = KKs + 64 * 65;
    float* beta = QKs + 64 * 65; float* gc = beta + 64;
    int tid_ = wv_ * 64 + mk_lane(); asm volatile("" : "+v"(tid_)); const int tid = tid_, lane = tid & 63, wave = tid >> 6;
    const float* cw = a.gdn_conv_w + (size_t)l * 4 * 1536;
    for (int unit = blockIdx.x; unit < NUNIT; unit += gridDim.x) {
        const int bb = unit >> 9, h = (unit >> 7) & 3, n = unit & 127;
        __syncthreads();
#pragma unroll 1
        for (int idx = tid; idx < 3 * 64 * 128; idx += NTHR) {
            const int mat = idx >> 13, rem = idx & 8191, t = rem >> 7, c = rem & 127, col = mat * 512 + h * 128 + c;
            float acc = 0.f;
#pragma unroll
            for (int j = 0; j < 4; ++j) { const int tt = n * 64 + t - 3 + j; if (tt >= 0) acc += cw[j * 1536 + col] * bf2f(P[((size_t)bb * SEQ + tt) * NP + col]); }
            (mat == 0 ? qs : mat == 1 ? ks : vs)[t * 129 + c] = siluf_(acc);
        }
        if (tid < 64) {
            const size_t row = (size_t)bb * SEQ + n * 64 + tid;
            beta[tid] = sigmoidf_(BA[row * 8 + h]);
            const float xx = BA[row * 8 + 4 + h] + a.gdn_dt_bias[l * 4 + h];
            const float sp = xx > 20.f ? xx : log1pf(__expf(xx));
            gc[tid] = -__expf(a.gdn_a_log[l * 4 + h]) * sp;
        }
        __syncthreads();
        if (tid == 0) { float run = 0.f;
#pragma unroll 1
            for (int c = 0; c < 64; ++c) { run += gc[c]; gc[c] = run; } }
        __syncthreads();
#pragma unroll 1
        for (int r = wave * 8; r < wave * 8 + 8; ++r) {
            { float x0 = qs[r * 129 + lane], x1 = qs[r * 129 + 64 + lane]; const float sc = rsqrtf(wave_sum(x0 * x0 + x1 * x1) + 1e-6f) * 0.08838834764831845f; qs[r * 129 + lane] = x0 * sc; qs[r * 129 + 64 + lane] = x1 * sc; }
            { float x0 = ks[r * 129 + lane], x1 = ks[r * 129 + 64 + lane]; const float sc = rsqrtf(wave_sum(x0 * x0 + x1 * x1) + 1e-6f); ks[r * 129 + lane] = x0 * sc; ks[r * 129 + 64 + lane] = x1 * sc; }
        }
        __syncthreads();
#pragma unroll 1
        for (int i = 0; i < 8; ++i) { const int idx = tid + NTHR * i, c = idx >> 6, s = idx & 63; float kk = 0.f, qk = 0.f;
#pragma unroll 4
            for (int d = 0; d < 128; ++d) { const float kv = ks[s * 129 + d]; kk += ks[c * 129 + d] * kv; qk += qs[c * 129 + d] * kv; }
            const float dec = (s <= c) ? __expf(gc[c] - gc[s]) : 0.f;
            KKs[c * 65 + s] = (s < c) ? kk * beta[c] * dec : 0.f; QKs[c * 65 + s] = qk * dec; }
        __syncthreads();
        const size_t ub = (size_t)unit * UREC;
        { const float gl = gc[63];
          for (int idx = tid; idx < 8192; idx += NTHR) { const int c = idx >> 7, d = idx & 127;
              GD[ub + R_QD + afrag_off(c, d, 8)] = (bf16)f2bf(qs[c * 129 + d] * __expf(gc[c])); GD[ub + R_KD + afrag_off(d, c, 4)] = (bf16)f2bf(ks[c * 129 + d] * __expf(gl - gc[c])); }
          for (int idx = tid; idx < 4096; idx += NTHR) { const int c = idx >> 6, s = idx & 63; GD[ub + R_QK + afrag_off(c, s, 4)] = (bf16)f2bf(QKs[c * 65 + s]); }
          if (tid == 0) GL[unit] = __expf(gl); }
        __syncthreads();
        for (int idx = tid; idx < 8192; idx += NTHR) { const int c = idx >> 7, d = idx & 127; vs[c * 129 + d] *= beta[c]; ks[c * 129 + d] *= beta[c] * __expf(gc[c]); }
        __syncthreads();
        if (tid < 256) {
            float* X = (tid < 128 ? vs : ks) + (tid & 127);
#pragma unroll 1
            for (int c = 1; c < 64; ++c) { float acc = X[c * 129]; const float* Ar = KKs + c * 65;
#pragma unroll 4
                for (int s = 0; s < c; ++s) acc -= Ar[s] * X[s * 129];
                X[c * 129] = acc; }
            if (tid < 128) { for (int c = 0; c < 64; ++c) GD[ub + R_U + clay_off(c, tid)] = (bf16)f2bf(X[c * 129]); }
            else { for (int c = 0; c < 64; ++c) GD[ub + R_W + afrag_off(c, tid - 128, 8)] = (bf16)f2bf(-X[c * 129]); }
        }
    }
    __syncthreads();
}

constexpr int GL_QB = 0, GL_KB = 17408, GL_VB = 34816, GL_AM = 52224, GL_QK = 69632, GL_XT = 78848, GL_BETA = 115712, GL_GC = 115968, GL_EGC = 116224;
template <int ROFF> __device__ __forceinline__ void tri_solve32(float (&x)[32], const float* Am) {
#pragma unroll
    for (int c = 1; c < 32; ++c) { int off = (ROFF + c) * 68 + ROFF;
        if (c >= 2) asm volatile("" : "+v"(off), "+v"(x[c - 2])); else asm volatile("" : "+v"(off));
        const float* ar = Am + off; float acc = x[c];
#pragma unroll
        for (int s4 = 0; s4 < c; s4 += 4) { const f32x4 av = *(const f32x4*)(ar + s4);
            acc -= av.x * x[s4]; if (s4 + 1 < c) acc -= av.y * x[s4 + 1]; if (s4 + 2 < c) acc -= av.z * x[s4 + 2]; if (s4 + 3 < c) acc -= av.w * x[s4 + 3]; }
        x[c] = acc; }
}
__device__ __forceinline__ void phase_gdn_local(const Args& a, unsigned char* lds, int l, int wv_) {
    const bf16* P = (const bf16*)(a.ws + WS_PROJ); const float* BA = (const float*)(a.ws + WS_BA);
    bf16* GD = (bf16*)(a.ws + WS_REGD); float* GL = (float*)(a.ws + WS_GL);
    bf16* qb = (bf16*)(lds + GL_QB); bf16* kb = (bf16*)(lds + GL_KB); bf16* vb = (bf16*)(lds + GL_VB); float* Am = (float*)(lds + GL_AM); bf16* QKb = (bf16*)(lds + GL_QK); bf16* XT = (bf16*)(lds + GL_XT);
    float* beta = (float*)(lds + GL_BETA); float* gc = (float*)(lds + GL_GC); float* egc = (float*)(lds + GL_EGC);
    const float* cwp = a.gdn_conv_w + (size_t)l * 4 * 1536;
#pragma unroll 1
    for (int unit = blockIdx.x; unit < NUNIT; unit += gridDim.x) {
        const int bb = unit >> 9, h = (unit >> 7) & 3, n = unit & 127;
        const size_t ub = (size_t)unit * UREC;
        __syncthreads();
        { const int tid = wv_ * 64 + mk_lane(), lane = tid & 63, r32 = lane & 31, hi = lane >> 5, wave = tid >> 6; (void)r32; (void)hi; (void)wave; (void)lane;
        if (tid < 384) {
            const int g = tid >> 4, cg = tid & 15, mat = g >> 3, tg = g & 7, col = mat * 512 + h * 128 + cg * 8;
            float cw[4][8];
#pragma unroll
            for (int j = 0; j < 4; ++j) { const f32x4 w0 = *(const f32x4*)(cwp + j * 1536 + col), w1 = *(const f32x4*)(cwp + j * 1536 + col + 4);
                cw[j][0] = w0.x; cw[j][1] = w0.y; cw[j][2] = w0.z; cw[j][3] = w0.w; cw[j][4] = w1.x; cw[j][5] = w1.y; cw[j][6] = w1.z; cw[j][7] = w1.w; }
            v4u in[11];
#pragma unroll
            for (int r = 0; r < 11; ++r) { const int tt = n * 64 + tg * 8 - 3 + r; in[r] = (v4u){0u, 0u, 0u, 0u}; if (tt >= 0) in[r] = *(const v4u*)(P + ((size_t)bb * SEQ + tt) * NP + col); }
            bf16* dstm = (mat == 0 ? qb : mat == 1 ? kb : vb) + cg * 8;
#pragma unroll
            for (int i = 0; i < 8; ++i) { float o[8];
#pragma unroll
                for (int e = 0; e < 8; ++e) o[e] = 0.f;
#pragma unroll
                for (int j = 0; j < 4; ++j) { const v4u w = in[i + j]; const float f[8] = {bflo(w.x), bfhi(w.x), bflo(w.y), bfhi(w.y), bflo(w.z), bfhi(w.z), bflo(w.w), bfhi(w.w)};
#pragma unroll
                    for (int e = 0; e < 8; ++e) o[e] += cw[j][e] * f[e]; }
                float ss = 0.f;
#pragma unroll
                for (int e = 0; e < 8; ++e) { o[e] = siluf_(o[e]); ss += o[e] * o[e]; }
                ss += __shfl_xor(ss, 1); ss += __shfl_xor(ss, 2); ss += __shfl_xor(ss, 4); ss += __shfl_xor(ss, 8);
                const float sc = mat == 2 ? 1.f : rsqrtf(ss + 1e-6f) * (mat == 0 ? 0.08838834764831845f : 1.f);
#pragma unroll
                for (int e = 0; e < 8; ++e) o[e] *= sc;
                st8(dstm + (tg * 8 + i) * 136, o); }
        } else if (tid < 448) {
            const int t = tid - 384; const size_t row = (size_t)bb * SEQ + n * 64 + t;
            beta[t] = sigmoidf_(BA[row * 8 + h]);
            const float xx = BA[row * 8 + 4 + h] + a.gdn_dt_bias[l * 4 + h];
            const float sp = xx > 20.f ? xx : log1pf(__expf(xx));
            float gv = -__expf(a.gdn_a_log[l * 4 + h]) * sp;
#pragma unroll
            for (int o = 1; o < 64; o <<= 1) { const float v = __shfl_up(gv, o); if (t >= o) gv += v; }
            gc[t] = gv; egc[t] = __expf(gv);
        }
        }
        __syncthreads();
        { const int tid = wv_ * 64 + mk_lane(), lane = tid & 63, r32 = lane & 31, hi = lane >> 5, wave = tid >> 6; (void)r32; (void)hi; (void)wave; (void)lane;
        { const int mat = wave >> 2, rt = (wave >> 1) & 1, ct = wave & 1;
          if (mat == 1 || !(rt == 0 && ct == 1)) {
            f32x16 acc;
#pragma unroll
            for (int r = 0; r < 16; ++r) acc[r] = 0.f;
            const bf16* Ab = (mat == 0 ? kb : qb) + (32 * rt + r32) * 136 + 8 * hi; const bf16* Bb = kb + (32 * ct + r32) * 136 + 8 * hi;
            if (!(rt == 0 && ct == 1)) {
#pragma unroll
                for (int ks = 0; ks < 8; ++ks) acc = MFMA32(*(const bf16x8*)(Ab + 16 * ks), *(const bf16x8*)(Bb + 16 * ks), acc);
            }
            const int s = 32 * ct + r32; const float gs = gc[s];
#pragma unroll
            for (int i = 0; i < 16; ++i) { const int c = 32 * rt + crow(i, hi); const float dec = (s <= c) ? __expf(gc[c] - gs) : 0.f;
                if (mat == 0) Am[c * 68 + s] = (s < c) ? acc[i] * beta[c] * dec : 0.f;
                else QKb[c * 72 + s] = (bf16)f2bf(acc[i] * dec); }
          } }
        }
        __syncthreads();
        { const int tid = wv_ * 64 + mk_lane(), lane = tid & 63, r32 = lane & 31, hi = lane >> 5, wave = tid >> 6; (void)r32; (void)hi; (void)wave; (void)lane;
        if (tid < 256) {
            const int col = tid; float x[32];
#pragma unroll
            for (int c = 0; c < 32; ++c) x[c] = (col < 128) ? bf2f(vb[c * 136 + col]) * beta[c] : bf2f(kb[c * 136 + col - 128]) * beta[c] * egc[c];
            tri_solve32<0>(x, Am);
#pragma unroll
            for (int c = 0; c < 32; c += 8) st8(XT + col * 72 + c, x + c);
        } else {
            const int lt = tid - 256; const float gl = gc[63];
#pragma unroll 1
            for (int q = 0; q < 4; ++q) { const int item = lt + 256 * q, f = item >> 6, ln = item & 63, r = ln & 31, hh = ln >> 5;
                { const int rt = f >> 3, ks = f & 7, c = 32 * rt + r; const float e = egc[c]; const bf16* sp = qb + c * 136 + 16 * ks + 4 * hh;
                  const v2u lo = *(const v2u*)sp, hi8 = *(const v2u*)(sp + 8); v4u w;
                  w.x = pk2(bflo(lo.x) * e, bfhi(lo.x) * e); w.y = pk2(bflo(lo.y) * e, bfhi(lo.y) * e); w.z = pk2(bflo(hi8.x) * e, bfhi(hi8.x) * e); w.w = pk2(bflo(hi8.y) * e, bfhi(hi8.y) * e);
                  *(v4u*)(GD + ub + R_QD + item * 8) = w; }
                { const int rt = f >> 2, ks = f & 3, dk = 32 * rt + r; float v[8];
#pragma unroll
                  for (int j = 0; j < 8; ++j) { const int c = 16 * ks + 8 * (j >> 2) + 4 * hh + (j & 3); v[j] = bf2f(kb[c * 136 + dk]) * __expf(gl - gc[c]); }
                  st8(GD + ub + R_KD + item * 8, v); } }
#pragma unroll 1
            for (int q = 0; q < 2; ++q) { const int item = lt + 256 * q, f = item >> 6, ln = item & 63, r = ln & 31, hh = ln >> 5, rt = f >> 2, ks = f & 3, c = 32 * rt + r;
                const bf16* sp = QKb + c * 72 + 16 * ks + 4 * hh; const v2u lo = *(const v2u*)sp, hi8 = *(const v2u*)(sp + 8); v4u w; w.x = lo.x; w.y = lo.y; w.z = hi8.x; w.w = hi8.y;
                *(v4u*)(GD + ub + R_QK + item * 8) = w; }
            if (lt == 0) GL[unit] = __expf(gl);
        }
        }
        __syncthreads();
        { const int tid = wv_ * 64 + mk_lane(), lane = tid & 63, r32 = lane & 31, hi = lane >> 5, wave = tid >> 6; (void)r32; (void)hi; (void)wave; (void)lane;
        { const int col = 32 * wave + r32; f32x16 acc;
#pragma unroll
          for (int i = 0; i < 16; ++i) { const int c = 32 + crow(i, hi); acc[i] = (col < 128) ? bf2f(vb[c * 136 + col]) * beta[c] : bf2f(kb[c * 136 + col - 128]) * beta[c] * egc[c]; }
#pragma unroll
          for (int ks = 0; ks < 2; ++ks) { const float* ap = Am + (32 + r32) * 68 + 16 * ks + 8 * hi; const f32x4 a0 = *(const f32x4*)ap, a1 = *(const f32x4*)(ap + 4);
              v4u w; w.x = cvtpk(-a0.x, -a0.y); w.y = cvtpk(-a0.z, -a0.w); w.z = cvtpk(-a1.x, -a1.y); w.w = cvtpk(-a1.z, -a1.w);
              acc = MFMA32(__builtin_bit_cast(bf16x8, w), *(const bf16x8*)(XT + col * 72 + 16 * ks + 8 * hi), acc); }
#pragma unroll
          for (int g = 0; g < 4; ++g) { v2u w; w.x = cvtpk(acc[4 * g], acc[4 * g + 1]); w.y = cvtpk(acc[4 * g + 2], acc[4 * g + 3]); *(v2u*)(XT + col * 72 + 32 + 8 * g + 4 * hi) = w; } }
        }
        __syncthreads();
        { const int tid = wv_ * 64 + mk_lane(), lane = tid & 63, r32 = lane & 31, hi = lane >> 5, wave = tid >> 6; (void)r32; (void)hi; (void)wave; (void)lane;
        if (tid < 256) {
            const int col = tid; float x[32];
#pragma unroll
            for (int c = 0; c < 32; c += 8) ld8(XT + col * 72 + 32 + c, x + c);
            tri_solve32<32>(x, Am);
#pragma unroll
            for (int c = 0; c < 32; c += 8) st8(XT + col * 72 + 32 + c, x + c);
        }
        }
        __syncthreads();
        { const int tid = wv_ * 64 + mk_lane(), lane = tid & 63, r32 = lane & 31, hi = lane >> 5, wave = tid >> 6; (void)r32; (void)hi; (void)wave; (void)lane;
        { const int item = tid, tile = item >> 6, ln = item & 63, rr = ln & 31, hh = ln >> 5, rt = tile >> 2, sl = tile & 3, dv = sl * 32 + rr;
          const bf16* xp = XT + dv * 72 + 32 * rt + 4 * hh; const v2u g0 = *(const v2u*)xp, g1 = *(const v2u*)(xp + 8), g2 = *(const v2u*)(xp + 16), g3 = *(const v2u*)(xp + 24);
          v4u w0, w1; w0.x = g0.x; w0.y = g0.y; w0.z = g1.x; w0.w = g1.y; w1.x = g2.x; w1.y = g2.y; w1.z = g3.x; w1.w = g3.y;
          *(v4u*)(GD + ub + R_U + item * 16) = w0; *(v4u*)(GD + ub + R_U + item * 16 + 8) = w1; }
#pragma unroll 1
        for (int q = 0; q < 2; ++q) { const int item = tid + 512 * q, f = item >> 6, ln = item & 63, r = ln & 31, hh = ln >> 5, rt = f >> 3, ks = f & 7, c = 32 * rt + r;
            unsigned short v[8];
#pragma unroll
            for (int j = 0; j < 8; ++j) { const int kc = 16 * ks + 8 * (j >> 2) + 4 * hh + (j & 3); v[j] = XT[(128 + kc) * 72 + c] ^ 0x8000u; }
            v4u w; w.x = v[0] | ((unsigned)v[1] << 16); w.y = v[2] | ((unsigned)v[3] << 16); w.z = v[4] | ((unsigned)v[5] << 16); w.w = v[6] | ((unsigned)v[7] << 16);
            *(v4u*)(GD + ub + R_W + item * 8) = w; }
        }
    }
    { const int tid = wv_ * 64 + mk_lane(), lane = tid & 63, wave = tid >> 6; const int gw = blockIdx.x * NWAVES + wave, NGW = gridDim.x * NWAVES;
      float mx0 = 0.f, mx1 = 0.f;
#pragma unroll 1
      for (int row = gw; row < M; row += NGW) { float f[8]; ld8(P + (size_t)row * NP + C_DK + lane * 8, f); float ss = 0.f;
#pragma unroll
          for (int j = 0; j < 8; ++j) ss += f[j] * f[j];
          ss += __shfl_xor(ss, 1); ss += __shfl_xor(ss, 2); ss += __shfl_xor(ss, 4);
          if (row < SEQ) mx0 = fmaxf(mx0, ss); else mx1 = fmaxf(mx1, ss); }
      unsigned* KM = (unsigned*)(a.ws + WS_CTL) + 1024 + 16 * l;
      if ((lane & 7) == 0) { atomicMax(KM + (lane >> 3), __float_as_uint(mx0)); atomicMax(KM + 8 + (lane >> 3), __float_as_uint(mx1)); } }
    __syncthreads();
}

constexpr int SC_WN = 0, SC_QD = 16384, SC_KDT = 32768, SC_QK = 49152, SC_U = 57344, SC_GL = 61440, SC_BUF = 61504;
__device__ __forceinline__ bf16x8 pack8(const f32x16& x, int s) { v4u w; w.x = cvtpk(x[8 * s], x[8 * s + 1]); w.y = cvtpk(x[8 * s + 2], x[8 * s + 3]); w.z = cvtpk(x[8 * s + 4], x[8 * s + 5]); w.w = cvtpk(x[8 * s + 6], x[8 * s + 7]); return __builtin_bit_cast(bf16x8, w); }
__device__ __forceinline__ void phase_gdn_scan(const Args& a, unsigned char* lds, int l, int wv_) {
    const bf16* GD = (const bf16*)(a.ws + WS_REGD); const float* GL = (const float*)(a.ws + WS_GL); float* OG = (float*)(a.ws + WS_REGB);
    int tid_ = wv_ * 64 + mk_lane(); asm volatile("" : "+v"(tid_)); const int tid = tid_, lane = tid & 63, r32 = lane & 31, hi = lane >> 5, wave = tid >> 6;
#pragma unroll 1
    for (int job = blockIdx.x; job < 32; job += gridDim.x) {
        const int bh = job >> 2, sl = job & 3, bb = bh >> 2, h = bh & 3;
        f32x16 S[4];
#pragma unroll
        for (int b4 = 0; b4 < 4; ++b4)
#pragma unroll
            for (int r = 0; r < 16; ++r) S[b4][r] = 0.f;
        __syncthreads();
        v4u lr[9]; float lgl = 0.f;
#define SC_FETCH(nn) do { const int unit_ = bh * 128 + (nn); const unsigned char* rec_ = (const unsigned char*)(GD + (size_t)unit_ * UREC) + (tid - 64) * 16; \
            _Pragma("unroll") for (int q = 0; q < 8; ++q) lr[q] = *(const v4u*)(rec_ + q * 7168); \
            if (tid - 64 < 256) lr[8] = *(const v4u*)((const unsigned char*)(GD + (size_t)unit_ * UREC + R_U) + (((tid - 64) >> 7) * 512 + sl * 128 + ((tid - 64) & 127)) * 16); \
            if (tid == 64) lgl = GL[unit_]; } while (0)
        if (wave != 0) SC_FETCH(0);
#pragma unroll 1
        for (int n = -1; n < 128; ++n) {
            if (wave != 0 && n + 1 < 128) {
                unsigned char* dstb = lds + ((n + 1) & 1) * SC_BUF + (tid - 64) * 16;
#pragma unroll
                for (int q = 0; q < 8; ++q) *(v4u*)(dstb + q * 7168) = lr[q];
                if (tid - 64 < 256) *(v4u*)(dstb + 8 * 7168) = lr[8];
                if (tid == 64) *(float*)(lds + ((n + 1) & 1) * SC_BUF + SC_GL) = lgl;
                if (n + 2 < 128) SC_FETCH(n + 2);
            }
            if (wave == 0 && n >= 0) {
                const unsigned char* base = lds + (n & 1) * SC_BUF;
#define SFRAG(off, f) (*(const bf16x8*)(base + (off) + (f) * 1024 + lane * 16))
                bf16x8 Spk[8];
#pragma unroll
                for (int ks = 0; ks < 8; ++ks) Spk[ks] = pack8(S[ks >> 1], ks & 1);
                f32x16 Vn[2];
#pragma unroll
                for (int rt = 0; rt < 2; ++rt) { const v4u u0 = *(const v4u*)(base + SC_U + (rt * 64 + lane) * 32), u1 = *(const v4u*)(base + SC_U + (rt * 64 + lane) * 32 + 16);
                    const unsigned uw[8] = {u0.x, u0.y, u0.z, u0.w, u1.x, u1.y, u1.z, u1.w};
#pragma unroll
                    for (int x = 0; x < 8; ++x) { Vn[rt][2 * x] = bflo(uw[x]); Vn[rt][2 * x + 1] = bfhi(uw[x]); }
#pragma unroll
                    for (int ks = 0; ks < 8; ++ks) Vn[rt] = MFMA32(SFRAG(SC_WN, rt * 8 + ks), Spk[ks], Vn[rt]); }
                bf16x8 Vpk[4];
#pragma unroll
                for (int ks = 0; ks < 4; ++ks) Vpk[ks] = pack8(Vn[ks >> 1], ks & 1);
#pragma unroll
                for (int rt = 0; rt < 2; ++rt) { f32x16 O;
#pragma unroll
                    for (int r = 0; r < 16; ++r) O[r] = 0.f;
#pragma unroll
                    for (int ks = 0; ks < 8; ++ks) O = MFMA32(SFRAG(SC_QD, rt * 8 + ks), Spk[ks], O);
#pragma unroll
                    for (int ks = 0; ks < 4; ++ks) O = MFMA32(SFRAG(SC_QK, rt * 4 + ks), Vpk[ks], O);
                    float* op = OG + ((size_t)bb * SEQ + n * 64 + rt * 32) * BW + h * 128 + sl * 32 + r32;
#pragma unroll
                    for (int i = 0; i < 16; ++i) op[(size_t)crow(i, hi) * BW] = O[i]; }
                const float g = *(const float*)(base + SC_GL);
#pragma unroll
                for (int b4 = 0; b4 < 4; ++b4) {
#pragma unroll
                    for (int r = 0; r < 16; ++r) S[b4][r] *= g;
#pragma unroll
                    for (int ks = 0; ks < 4; ++ks) S[b4] = MFMA32(SFRAG(SC_KDT, b4 * 4 + ks), Vpk[ks], S[b4]); }
#undef SFRAG
            }
            __syncthreads();
        }
#undef SC_FETCH
    }
    __syncthreads();
}

__device__ __forceinline__ void phase_finalize(const Args& a, int l, int wv_) {
    const bf16* P = (const bf16*)(a.ws + WS_PROJ); const float* OG = (const float*)(a.ws + WS_REGB); const float* OATT = (const float*)(a.ws + WS_REGC);
    bf16* Y = (bf16*)(a.ws + WS_REGD);
    int tid_ = wv_ * 64 + mk_lane(); asm volatile("" : "+v"(tid_)); const int tid = tid_, lane = tid & 63, wave = tid >> 6;
    const int gw = blockIdx.x * NWAVES + wave, NGW = gridDim.x * NWAVES;
    const float lam_init = 0.8f - 0.6f * expf(-0.3f * (float)l);
    const float* lv = a.diff_lambda + (size_t)l * 256;
    const float lam = expf(wave_sum(lv[lane] * lv[64 + lane])) - expf(wave_sum(lv[128 + lane] * lv[192 + lane])) + lam_init;
    const int e0 = (lane & 15) * 8, hh = lane >> 4, c0 = lane * 8;
    float gnw[8], dnw[8], scw[3][8];
#pragma unroll
    for (int j = 0; j < 8; ++j) { gnw[j] = a.gdn_norm_w[l * 128 + e0 + j]; dnw[j] = a.diff_norm_w[l * 128 + e0 + j] * (1.f - lam_init);
#pragma unroll
        for (int k = 0; k < 3; ++k) scw[k][j] = a.sc_conv_w[((size_t)l * 3 + k) * BW + c0 + j]; }
    for (int row = gw; row < M; row += NGW) {
        const int t = row & (SEQ - 1);
        const bf16* pr = P + (size_t)row * NP;
        float y[8], z[8];
        { const f32x4 o0 = *(const f32x4*)(OG + (size_t)row * BW + c0), o1 = *(const f32x4*)(OG + (size_t)row * BW + c0 + 4);
          float o[8] = {o0.x, o0.y, o0.z, o0.w, o1.x, o1.y, o1.z, o1.w}; float ss = 0.f;
#pragma unroll
          for (int j = 0; j < 8; ++j) ss += o[j] * o[j];
          ss += __shfl_xor(ss, 1); ss += __shfl_xor(ss, 2); ss += __shfl_xor(ss, 4); ss += __shfl_xor(ss, 8);
          const float rs = rsqrtf(ss * (1.f / 128.f) + EPS); ld8(pr + C_GZ + c0, z);
#pragma unroll
          for (int j = 0; j < 8; ++j) y[j] = o[j] * rs * gnw[j] * siluf_(z[j]);
          st8(Y + (size_t)row * BW + c0, y); }
        { const float* op = OATT + (((size_t)row * 4 + hh) * 2) * 128 + e0;
          const f32x4 a0 = *(const f32x4*)op, a1 = *(const f32x4*)(op + 4), b0 = *(const f32x4*)(op + 128), b1 = *(const f32x4*)(op + 132);
          float d[8] = {a0.x - lam * b0.x, a0.y - lam * b0.y, a0.z - lam * b0.z, a0.w - lam * b0.w, a1.x - lam * b1.x, a1.y - lam * b1.y, a1.z - lam * b1.z, a1.w - lam * b1.w}; float ss = 0.f;
#pragma unroll
          for (int j = 0; j < 8; ++j) ss += d[j] * d[j];
          ss += __shfl_xor(ss, 1); ss += __shfl_xor(ss, 2); ss += __shfl_xor(ss, 4); ss += __shfl_xor(ss, 8);
          const float rs = rsqrtf(ss * (1.f / 128.f) + EPS); ld8(pr + C_DZ + c0, z);
#pragma unroll
          for (int j = 0; j < 8; ++j) y[j] = d[j] * rs * dnw[j] * siluf_(z[j]);
          st8(Y + (size_t)M * BW + (size_t)row * BW + c0, y); }
        { float acc[8];
#pragma unroll
          for (int j = 0; j < 8; ++j) acc[j] = 0.f;
#pragma unroll
          for (int k = 0; k < 3; ++k) { const int tt = t - 2 + k; if (tt >= 0) { float cc[8], xx[8]; const bf16* p2 = P + (size_t)(row - 2 + k) * NP; ld8(p2 + C_SC + c0, cc); ld8(p2 + C_SX + c0, xx);
#pragma unroll
              for (int j = 0; j < 8; ++j) acc[j] += scw[k][j] * (cc[j] * xx[j]); } }
          float sb[8]; ld8(pr + C_SB + c0, sb); ld8(pr + C_SZ + c0, z);
#pragma unroll
          for (int j = 0; j < 8; ++j) y[j] = sb[j] * acc[j] * siluf_(z[j]);
          st8(Y + 2 * (size_t)M * BW + (size_t)row * BW + c0, y); }
    }
}

__device__ __forceinline__ void phase_postnorm(const Args& a, int l, int wv_) {
    const bf16* OUT = (const bf16*)(a.ws + WS_REGC); bf16* H = (bf16*)(a.ws + WS_REGB);
    const float* xin = (l == 0) ? a.x : a.out;
    int tid_ = wv_ * 64 + mk_lane(); asm volatile("" : "+v"(tid_)); const int tid = tid_, lane = tid & 63, wave = tid >> 6;
    const int gw = blockIdx.x * NWAVES + wave, NGW = gridDim.x * NWAVES;
    const float* wpost = a.norm_post + (size_t)l * DM; const float* wpre = a.norm_pre + (size_t)(l + 1 < DEPTH ? l + 1 : l) * DM;
    for (int row = gw; row < M; row += NGW) {
        f32x4 o[4], x[4]; float s = 0.f;
#pragma unroll
        for (int j = 0; j < 4; ++j) { { const v2u ow = *(const v2u*)(OUT + (size_t)row * DM + 4 * lane + 256 * j); o[j] = (f32x4){bflo(ow.x), bfhi(ow.x), bflo(ow.y), bfhi(ow.y)}; } x[j] = *(const f32x4*)(xin + (size_t)row * DM + 4 * lane + 256 * j);
            s += (o[j].x * o[j].x + o[j].y * o[j].y) + (o[j].z * o[j].z + o[j].w * o[j].w); }
        const float rs = rsqrtf(wave_sum(s) * (1.f / DM) + EPS); float s2 = 0.f;
#pragma unroll
        for (int j = 0; j < 4; ++j) { const f32x4 w = *(const f32x4*)(wpost + 4 * lane + 256 * j); x[j] = x[j] + o[j] * rs * w; *(f32x4*)(a.out + (size_t)row * DM + 4 * lane + 256 * j) = x[j];
            s2 += (x[j].x * x[j].x + x[j].y * x[j].y) + (x[j].z * x[j].z + x[j].w * x[j].w); }
        if (l + 1 < DEPTH) { const float rs2 = rsqrtf(wave_sum(s2) * (1.f / DM) + EPS);
#pragma unroll
            for (int j = 0; j < 4; ++j) { const f32x4 w = *(const f32x4*)(wpre + 4 * lane + 256 * j); v2u ob; ob.x = pk2(x[j].x * rs2 * w.x, x[j].y * rs2 * w.y); ob.y = pk2(x[j].z * rs2 * w.z, x[j].w * rs2 * w.w);
                *(v2u*)(H + (size_t)row * DM + 4 * lane + 256 * j) = ob; } }
    }
}

#define XB_TMO      128
#define XB_XCNT(j)  (256  + 64 * (j))
#define XB_XSUB(j)  (1280 + 64 * (j))
#define XB_XGEN(j)  (2304 + 64 * (j))
#define XB_TOP      3328
#define XB_TOPGEN   3392
#define XCD_BAR_WORDS 3456
#define XB_SPIN_CAP (1u << 18)

__device__ __forceinline__ unsigned xb_ld(unsigned* p)              { return __hip_atomic_load(p, __ATOMIC_RELAXED, __HIP_MEMORY_SCOPE_AGENT); }
__device__ __forceinline__ unsigned xb_add(unsigned* p, unsigned v) { return __hip_atomic_fetch_add(p, v, __ATOMIC_RELAXED, __HIP_MEMORY_SCOPE_AGENT); }
__device__ __forceinline__ unsigned xb_xcc_id() { return (unsigned)__builtin_amdgcn_s_getreg((3 << 11) | 20) & 0xFu; }
#define XB_SPIN(cond, bar) do { unsigned _sp = 0; while (cond) { __builtin_amdgcn_s_sleep(1); \
    if ((++_sp & 255u) == 0u) { if (xb_ld(&(bar)[XB_TMO])) break; if (_sp > XB_SPIN_CAP) { atomicAdd(&(bar)[XB_TMO], 1u); break; } } } } while (0)

struct XcdBarrier {
    unsigned* bar; unsigned x;
    volatile LAS unsigned* st;
};

__device__ __forceinline__ XcdBarrier xcd_barrier_post(unsigned* bar, volatile LAS unsigned* st) {
    XcdBarrier b; b.bar = bar; b.x = xb_xcc_id(); b.st = st;
    if (threadIdx.x == 0) (void)xb_add(&bar[XB_XCNT(b.x)], 1u);
    return b;
}
__device__ __forceinline__ void xcd_barrier_complete(unsigned* bar, unsigned x, unsigned& nloc, unsigned& nx) {
    const unsigned G = gridDim.x * gridDim.y * gridDim.z;
    unsigned sum, cnt, mine, sp = 0u;
    for (;;) {
        sum = 0u; cnt = 0u; mine = 0u;
#pragma unroll
        for (unsigned j = 0; j < 16; ++j) { const unsigned c = xb_ld(&bar[XB_XCNT(j)]); sum += c; cnt += (c > 0u) ? 1u : 0u; mine = (j == x) ? c : mine; }
        if (sum == G) break;
        __builtin_amdgcn_s_sleep(1);
        if ((++sp & 255u) == 0u) { if (xb_ld(&bar[XB_TMO])) break; if (sp > XB_SPIN_CAP) { atomicAdd(&bar[XB_TMO], 1u); break; } }
    }
    nloc = mine > 0u ? mine : 1u; nx = cnt > 0u ? cnt : 1u;
}

__device__ __forceinline__ void xcd_barrier(const XcdBarrier& b) {
    asm volatile("s_waitcnt vmcnt(0)" ::: "memory");
    __syncthreads();
    if (threadIdx.x == 0) {
        unsigned* bar = b.bar;
        __builtin_amdgcn_s_waitcnt(0);
        unsigned nloc = b.st[0], nx = b.st[1];
        if (nloc == 0u) { xcd_barrier_complete(bar, b.x, nloc, nx); b.st[0] = nloc; b.st[1] = nx; }
        const unsigned old = xb_add(&bar[XB_XSUB(b.x)], 1u);
        const unsigned gen = old / nloc;
        if (old + 1u == (gen + 1u) * nloc) {
            __builtin_amdgcn_fence(__ATOMIC_RELEASE, "agent");
            asm volatile("s_waitcnt vmcnt(0)" ::: "memory");
            const unsigned og = xb_add(&bar[XB_TOP], 1u);
            const unsigned tg = og / nx;
            if (og + 1u == (tg + 1u) * nx) xb_add(&bar[XB_TOPGEN], 1u);
            else XB_SPIN(xb_ld(&bar[XB_TOPGEN]) == tg, bar);
            __builtin_amdgcn_fence(__ATOMIC_ACQUIRE, "agent");
            xb_add(&bar[XB_XGEN(b.x)], 1u);
            asm volatile("s_waitcnt vmcnt(0)" ::: "memory");
        } else {
            XB_SPIN(xb_ld(&bar[XB_XGEN(b.x)]) == gen, bar);
            __builtin_amdgcn_fence(__ATOMIC_ACQUIRE, "agent");
            asm volatile("s_waitcnt vmcnt(0)" ::: "memory");
        }
    }
    __syncthreads();
}

constexpr int XB_ST_OFF = 143360 + 1024;
constexpr int XB_WORD0 = 4096;
constexpr int ARGS_OFF = 143360;
constexpr int ARGS_WORDS = (int)(sizeof(Args) / 4);
#ifndef PROBE_SEL
#define PROBE_SEL -1
#endif
constexpr int TS_OFF = ARGS_OFF + 512;
__device__ __forceinline__ void ts_mark(unsigned char* lds, int k) {
    if (PROBE_SEL >= 0 && blockIdx.x == 0 && threadIdx.x == 0) { volatile LAS unsigned long long* p = (volatile LAS unsigned long long*)((LAS unsigned char*)lds + TS_OFF);
        const unsigned long long t = __builtin_amdgcn_s_memrealtime(); p[1 + k] += t - p[0]; p[0] = t; }
}
__device__ __forceinline__ void load_args(Args& b, unsigned char* lds) {
    volatile LAS unsigned* s = (volatile LAS unsigned*)((LAS unsigned char*)lds + ARGS_OFF); unsigned w[ARGS_WORDS];
#pragma unroll
    for (int i = 0; i < ARGS_WORDS; ++i) w[i] = (unsigned)__builtin_amdgcn_readfirstlane((int)s[i]);
    __builtin_memcpy(&b, w, sizeof(Args));
}
__device__ __forceinline__ void grid_bar(unsigned char* lds) {
    Args a; load_args(a, lds);
    XcdBarrier b; b.bar = (unsigned*)(a.ws + WS_CTL) + XB_WORD0; b.x = xb_xcc_id(); b.st = (volatile LAS unsigned*)((LAS unsigned char*)lds + XB_ST_OFF);
    xcd_barrier(b);
}
template <int L> __device__ __forceinline__ void run_layer(unsigned char* lds, cg::grid_group& grid, int wv) {
    PG8_LAS unsigned char* lds3 = (PG8_LAS unsigned char*)lds;
    constexpr int l = L;
    {
        Args a; load_args(a, lds); const int G = gridDim.x;
        bf16* WIN = (bf16*)(a.ws + WS_WIN); bf16* PROJ = (bf16*)(a.ws + WS_PROJ); float* BA = (float*)(a.ws + WS_BA); bf16* REGB = (bf16*)(a.ws + WS_REGB);
        pg8::Gemm g{REGB, WIN + (size_t)l * WIN_L, M, NPAD, DM}; pg8::StaticOrder S; S.init(M, NPAD, G, (int)blockIdx.x);
        EpiProj E{PROJ, BA};
        pg8::gemm_phase<EpiProj, pg8::StaticOrder, true, true>(lds3, g, S, E, wv);
    }
    grid_bar(lds);
    ts_mark(lds, 1);
    { Args a; load_args(a, lds); phase_gdn_local(a, lds, l, wv); }
    grid_bar(lds);
    ts_mark(lds, 2);
    { Args a; load_args(a, lds); phase_gdn_scan(a, lds, l, wv); }
    ts_mark(lds, 4);
    { Args a; load_args(a, lds); phase_attn(a, lds, l, wv); }
    grid_bar(lds);
    ts_mark(lds, 3);
    { Args a; load_args(a, lds); phase_finalize(a, l, wv); }
    grid_bar(lds);
    ts_mark(lds, 5);
    {
        Args a; load_args(a, lds); const int G = gridDim.x;
        bf16* WBR = (bf16*)(a.ws + WS_WBR); bf16* PROJ = (bf16*)(a.ws + WS_PROJ); bf16* REGB = (bf16*)(a.ws + WS_REGB); float* REGC = (float*)(a.ws + WS_REGC); bf16* Y = (bf16*)(a.ws + WS_REGD);
        pg8::StaticOrder S0; S0.init(M, DM, G, (int)blockIdx.x); pg8::Unit u0; BranchOrder S{0, 0};
        if (S0.next(0, u0)) { S.pm0 = u0.pm; S.pn0 = u0.pn; }
        pg8::Gemm g{Y, WBR + (size_t)l * 3 * DM * BW, 3 * M, 3 * DM, BW}; EpiBranch E{PROJ, REGC, REGB};
        pg8::gemm_phase<EpiBranch, BranchOrder, true, true>(lds3, g, S, E, wv);
    }
    grid_bar(lds);
    ts_mark(lds, 6);
    {
        Args a; load_args(a, lds); const int G = gridDim.x;
        bf16* WOUT = (bf16*)(a.ws + WS_WOUT); bf16* REGB = (bf16*)(a.ws + WS_REGB); float* REGC = (float*)(a.ws + WS_REGC);
        pg8::Gemm g{REGB, WOUT + (size_t)l * DM * DM, M, DM, DM}; pg8::StaticOrder S; S.init(M, DM, G, (int)blockIdx.x);
        EpiOutBf16 E{(bf16*)REGC};
        pg8::gemm_phase<EpiOutBf16, pg8::StaticOrder, true, true>(lds3, g, S, E, wv);
    }
    grid_bar(lds);
    ts_mark(lds, 7);
    { Args a; load_args(a, lds); phase_postnorm(a, l, wv); }
    if (L + 1 < DEPTH) grid_bar(lds);
    ts_mark(lds, 8);
}
__global__ void __launch_bounds__(NTHR, 2) fwd(Args a0) {
    extern __shared__ __attribute__((aligned(16))) unsigned char lds[];
    cg::grid_group grid = cg::this_grid();
    const int wv = __builtin_amdgcn_readfirstlane((int)threadIdx.x >> 6);
    if (threadIdx.x < 2) ((volatile LAS unsigned*)((LAS unsigned char*)lds + XB_ST_OFF))[threadIdx.x] = 0u;
    __syncthreads();
    (void)xcd_barrier_post((unsigned*)(a0.ws + WS_CTL) + XB_WORD0, (volatile LAS unsigned*)((LAS unsigned char*)lds + XB_ST_OFF));
    if (threadIdx.x == 0) { unsigned w[ARGS_WORDS]; __builtin_memcpy(w, &a0, sizeof(Args));
#pragma unroll
        for (int i = 0; i < ARGS_WORDS; ++i) ((volatile LAS unsigned*)((LAS unsigned char*)lds + ARGS_OFF))[i] = w[i]; }
    if (PROBE_SEL >= 0 && threadIdx.x == 0) { volatile LAS unsigned long long* p = (volatile LAS unsigned long long*)((LAS unsigned char*)lds + TS_OFF); for (int i = 1; i < 17; ++i) p[i] = 0; p[0] = __builtin_amdgcn_s_memrealtime(); }
    __syncthreads();
    { Args a; load_args(a, lds); phase_prologue(a, lds, wv); }
    grid.sync();
    ts_mark(lds, 0);
    run_layer<0>(lds, grid, wv);
    run_layer<1>(lds, grid, wv);
    run_layer<2>(lds, grid, wv);
    run_layer<3>(lds, grid, wv);
    if (PROBE_SEL >= 0 && blockIdx.x == 0 && threadIdx.x == 0) { volatile LAS unsigned long long* p = (volatile LAS unsigned long long*)((LAS unsigned char*)lds + TS_OFF);
        Args a; load_args(a, lds); a.out[0] = floorf((float)p[1 + PROBE_SEL] * 0.01f * 0.02f + 0.5f) * 50.f; }
}

extern "C" void kernel_launch(void* const* d_in, const int* in_sizes, int n_in, void* d_out, int out_size, void* d_ws, size_t ws_size, hipStream_t stream) {
    static int grid = 0;
    if (grid == 0) {
        if (n_in != 13 || ws_size < WS_END) { fprintf(stderr, "kernel_launch: unexpected n_in %d or ws %zu\n", n_in, ws_size); grid = -1; return; }
        int dev = 0, cus = 0, per_cu = 0;
        hipGetDevice(&dev); hipDeviceGetAttribute(&cus, hipDeviceAttributeMultiprocessorCount, dev);
        hipFuncSetAttribute((const void*)fwd, hipFuncAttributeMaxDynamicSharedMemorySize, LDS_BYTES);
        hipOccupancyMaxActiveBlocksPerMultiprocessor(&per_cu, (const void*)fwd, NTHR, LDS_BYTES);
        (void)hipGetLastError();
        if (per_cu < 1) { fprintf(stderr, "kernel_launch: occupancy query says %d\n", per_cu); per_cu = 1; }
        grid = cus;
    }
    if (grid < 0) return;
    Args a{};
    a.x = (const float*)d_in[0]; a.norm_pre = (const float*)d_in[1]; a.norm_post = (const float*)d_in[2]; a.w_in = (const float*)d_in[3]; a.gdn_conv_w = (const float*)d_in[4];
    a.gdn_a_log = (const float*)d_in[5]; a.gdn_dt_bias = (const float*)d_in[6]; a.gdn_norm_w = (const float*)d_in[7]; a.diff_lambda = (const float*)d_in[8]; a.diff_norm_w = (const float*)d_in[9];
    a.sc_conv_w = (const float*)d_in[10]; a.w_branch = (const float*)d_in[11]; a.w_out = (const float*)d_in[12];
    a.out = (float*)d_out; a.ws = (unsigned char*)d_ws; a.ph_lo = 0; a.ph_hi = 0; a.coop = 1; a.pad = 0;
    if (hipMemsetAsync((char*)d_ws + WS_CTL, 0, 65536, stream) != hipSuccess) { fprintf(stderr, "kernel_launch: memset of the control words failed\n"); return; }
    void* args[] = {&a};
    hipError_t e = hipLaunchCooperativeKernel((const void*)fwd, dim3(grid), dim3(NTHR), args, LDS_BYTES, stream);
    if (e != hipSuccess) fprintf(stderr, "cooperative launch failed: %s (grid %d)\n", hipGetErrorString(e), grid);
}
```

```cpp
#include <hip/hip_runtime.h>
#include <hip/hip_cooperative_groups.h>
#include <cstdio>
#include <cstdint>
namespace cg = cooperative_groups;
__device__ __forceinline__ int mk_lane() { int r; asm volatile("v_mbcnt_lo_u32_b32 %0, -1, 0\n\tv_mbcnt_hi_u32_b32 %0, -1, %0" : "=v"(r)); return r; }
namespace pg8 {
#define PG8_LAS __attribute__((address_space(3)))
typedef unsigned short bf16_t;
typedef short bf16x8 __attribute__((ext_vector_type(8)));
typedef float f32x4 __attribute__((ext_vector_type(4)));
typedef unsigned u32x4 __attribute__((ext_vector_type(4)));
constexpr int BM = 256, BK = 64, HALF = 128, HTB = HALF * BK * 2  , STAGE_BYTES = 8 * HTB, NXCD = 8, WGM = 8;

__host__ __device__ __forceinline__ int lds_byte(int r, int c) { const int st = (r >> 4) * 2 + (c >> 5), rr = r & 15, cc = c & 31, ob = rr * 64 + cc * 2; return st * 1024 + (ob ^ (((ob >> 9) & 1) << 5)); }
__host__ __device__ __forceinline__ void stage_rc(int b, int& R, int& C) { const int st = b / 1024, sb = b % 1024, swz = sb ^ (((sb >> 9) & 1) << 5); R = (st >> 1) * 16 + swz / 64; C = (st & 1) * 32 + (swz % 64) / 2; }
__host__ __device__ __forceinline__ int perm32(int rho) { const int n = rho >> 4, i = rho & 15; return 8 * (i >> 2) + 4 * n + (i & 3); }

struct Unit { int pm, pn; };
struct Gemm { const bf16_t* A; const bf16_t* Bt; int M, N, K; };

struct StaticOrder {
    int nM, nN, nwg, G, c;
    __host__ __device__ void init(int M, int N, int G_, int c_) { nM = M / BM; nN = N / BM; nwg = nM * nN; G = G_; c = c_; }
    __host__ __device__ bool next(int i, Unit& u) const {
        const long L = (long)i * G + c; if (L >= nwg) return false;
        int wgid = (int)L; { const int q = nwg / NXCD, r = nwg % NXCD, xcd = wgid % NXCD, off = wgid / NXCD; wgid = (xcd < r ? xcd * (q + 1) : r * (q + 1) + (xcd - r) * q) + off; }
        const int nig = WGM * nN, gid = wgid / nig, fm = gid * WGM, gsz = (nM - fm) < WGM ? (nM - fm) : WGM;
        u.pm = fm + ((wgid % nig) % gsz); u.pn = (wgid % nig) / gsz; return true;
    }
    __device__ __forceinline__ void a_ready(const Unit&) const {}
    __device__ __forceinline__ void done(const Unit&) const {}
};
__device__ __forceinline__ unsigned cvt_pk_bf16(float lo, float hi) { unsigned r; asm volatile("v_cvt_pk_bf16_f32 %0, %1, %2" : "=v"(r) : "v"(lo), "v"(hi)); return r; }
typedef float f32x2 __attribute__((ext_vector_type(2)));
template <class Epi, class Sched, bool ALIGN_EPI = false, bool SP2 = false>
__device__ __forceinline__ void gemm_phase(PG8_LAS unsigned char* lds, const Gemm g, const Sched& S, const Epi& E, int wv_) {
    int tid_ = wv_ * 64 + mk_lane(); asm volatile("" : "+v"(tid_)); const int tid = tid_, wid = __builtin_amdgcn_readfirstlane(tid >> 6), lane = tid & 63, wr = wid >> 2, wc = wid & 3, fr = lane & 15, fq = lane >> 4;
    const int K = g.K, nt = K / BK;
    unsigned voffA[2], voffB[2];
#pragma unroll
    for (int i = 0; i < 2; ++i) { int R, C; stage_rc(tid * 16 + i * 8192, R, C); const int Rb = Epi::PERM ? ((R & ~31) + perm32(R & 31)) : R;
        voffA[i] = (unsigned)(R * K + C) * 2u; voffB[i] = (unsigned)(Rb * K + C) * 2u; }
    const size_t kstep = (size_t)(BK * 2);
    const size_t hstep = (size_t)HALF * K * 2;
    const size_t tstep = 2 * hstep;
    const unsigned ldsw = (unsigned)wid * 1024u;
    const int aoff = lds_byte(wr * 64 + fr, fq * 8), boff = lds_byte(wc * 32 + fr, fq * 8);
#define PG8_SA(b, h) (((b) * 2 + (h)) * HTB)
#define PG8_SB(b, h) ((4 + (b) * 2 + (h)) * HTB)
#define PG8_STAGE(bufoff, gbase, voff) do { _Pragma("unroll") for (int _i = 0; _i < 2; ++_i) \
        __builtin_amdgcn_global_load_lds((const unsigned*)((const char*)(gbase) + (voff)[_i]), (PG8_LAS unsigned*)(lds + (bufoff) + ldsw + _i * 8192), 16, 0, 0); } while (0)
#define PG8_LDA(dst, b, h) do { _Pragma("unroll") for (int m = 0; m < 4; ++m) _Pragma("unroll") for (int k = 0; k < 2; ++k) dst[m][k] = *(const PG8_LAS bf16x8*)(lds + PG8_SA(b, h) + aoff + m * 2048 + k * 1024); } while (0)
#define PG8_LDB(dst, b, h) do { _Pragma("unroll") for (int n = 0; n < 2; ++n) _Pragma("unroll") for (int k = 0; k < 2; ++k) dst[n][k] = *(const PG8_LAS bf16x8*)(lds + PG8_SB(b, h) + boff + n * 2048 + k * 1024); } while (0)
#define PG8_MMA(ai, bj, At, Bt) do { __builtin_amdgcn_s_setprio(1); _Pragma("unroll") for (int m = 0; m < 4; ++m) _Pragma("unroll") for (int n = 0; n < 2; ++n) _Pragma("unroll") for (int k = 0; k < 2; ++k) \
        acc[ai][bj][m][n] = __builtin_amdgcn_mfma_f32_16x16x32_bf16(Bt[n][k], At[m][k], acc[ai][bj][m][n], 0, 0, 0); __builtin_amdgcn_s_setprio(0); } while (0)
#define PG8_WAIT_V(n) asm volatile("s_waitcnt vmcnt(" #n ")" ::: "memory")
#define PG8_WAIT_L(n) asm volatile("s_waitcnt lgkmcnt(" #n ")" ::: "memory")
#define PG8_BAR __builtin_amdgcn_s_barrier()
#define PG8_SCHED __builtin_amdgcn_sched_barrier(0)
    Unit cur, nxt; int ui = 0;
    if (!S.next(0, cur)) return;
    f32x4 acc[2][2][4][2];
#pragma unroll
    for (int a = 0; a < 2; ++a)
#pragma unroll
        for (int b = 0; b < 2; ++b)
#pragma unroll
            for (int m = 0; m < 4; ++m)
#pragma unroll
                for (int n = 0; n < 2; ++n) acc[a][b][m][n] = (f32x4){0.f, 0.f, 0.f, 0.f};
    bf16x8 At[4][2], B0[2][2], B1[2][2];
    const char* cA = (const char*)g.A + (size_t)cur.pm * tstep; const char* cB = (const char*)g.Bt + (size_t)cur.pn * tstep;
    S.a_ready(cur);
    if constexpr (SP2) {
        PG8_STAGE(PG8_SB(0, 0), cB, voffB); PG8_STAGE(PG8_SB(0, 1), cB + hstep, voffB); PG8_STAGE(PG8_SA(0, 0), cA, voffA); PG8_STAGE(PG8_SA(0, 1), cA + hstep, voffA);
        if (wr == 1) PG8_BAR;
        PG8_WAIT_V(2); PG8_BAR;
        PG8_STAGE(PG8_SB(1, 0), cB + kstep, voffB); PG8_STAGE(PG8_SA(1, 0), cA + kstep, voffA); PG8_STAGE(PG8_SB(1, 1), cB + hstep + kstep, voffB);
        PG8_WAIT_V(6); PG8_BAR;
    } else {
        PG8_STAGE(PG8_SB(0, 0), cB, voffB); PG8_STAGE(PG8_SA(0, 0), cA, voffA); PG8_STAGE(PG8_SB(0, 1), cB + hstep, voffB); PG8_STAGE(PG8_SA(0, 1), cA + hstep, voffA);
        if (wr == 1) PG8_BAR;
        PG8_WAIT_V(4); PG8_BAR;
        PG8_STAGE(PG8_SB(1, 0), cB + kstep, voffB); PG8_STAGE(PG8_SA(1, 0), cA + kstep, voffA); PG8_STAGE(PG8_SB(1, 1), cB + hstep + kstep, voffB);
        PG8_WAIT_V(6); PG8_BAR;
    }
    for (;;) {
        const bool has_next = S.next(ui + 1, nxt);
        const char* nA = has_next ? (const char*)g.A + (size_t)nxt.pm * tstep : cA; const char* nB = has_next ? (const char*)g.Bt + (size_t)nxt.pn * tstep : cB;
        for (int t = 0; t < nt; t += 2) {
            const bool last = (t == nt - 2);
            const char* a1 = cA + (size_t)(t + 1) * kstep;
            const char* a2 = last ? nA : cA + (size_t)(t + 2) * kstep; const char* b2 = last ? nB : cB + (size_t)(t + 2) * kstep;
            const char* a3 = a2 + kstep; const char* b3 = b2 + kstep;
            if (last && has_next) S.a_ready(nxt);
            if constexpr (SP2) {
            PG8_LDB(B0, 0, 0); PG8_LDB(B1, 0, 1); PG8_SCHED; PG8_LDA(At, 0, 0); PG8_STAGE(PG8_SA(1, 1), a1 + hstep, voffA);
            PG8_WAIT_V(8); PG8_WAIT_L(0); PG8_BAR; PG8_MMA(0, 0, At, B0); PG8_MMA(0, 1, At, B1); PG8_BAR; PG8_SCHED;
            PG8_LDA(At, 0, 1); PG8_STAGE(PG8_SB(0, 0), b2, voffB); PG8_STAGE(PG8_SB(0, 1), b2 + hstep, voffB); PG8_STAGE(PG8_SA(0, 0), a2, voffA);
            PG8_WAIT_V(8); PG8_WAIT_L(0); PG8_BAR; PG8_MMA(1, 0, At, B0); PG8_MMA(1, 1, At, B1); PG8_BAR; PG8_SCHED;
            PG8_LDB(B0, 1, 0); PG8_LDB(B1, 1, 1); PG8_SCHED; PG8_LDA(At, 1, 0); PG8_STAGE(PG8_SA(0, 1), a2 + hstep, voffA);
            PG8_WAIT_V(8); PG8_WAIT_L(0); PG8_BAR; PG8_MMA(0, 0, At, B0); PG8_MMA(0, 1, At, B1); PG8_BAR; PG8_SCHED;
            PG8_LDA(At, 1, 1); PG8_STAGE(PG8_SB(1, 0), b3, voffB); PG8_STAGE(PG8_SB(1, 1), b3 + hstep, voffB); PG8_STAGE(PG8_SA(1, 0), a3, voffA);
            PG8_WAIT_V(8); PG8_WAIT_L(0); PG8_BAR; PG8_MMA(1, 0, At, B0); PG8_MMA(1, 1, At, B1); PG8_BAR; PG8_SCHED;
            } else {
            PG8_LDB(B0, 0, 0); PG8_SCHED; PG8_LDA(At, 0, 0); PG8_STAGE(PG8_SA(1, 1), a1 + hstep, voffA);
            PG8_WAIT_L(8); PG8_BAR; PG8_WAIT_L(0); PG8_MMA(0, 0, At, B0); PG8_BAR; PG8_SCHED;
            PG8_LDB(B1, 0, 1); PG8_STAGE(PG8_SB(0, 0), b2, voffB);
            PG8_BAR; PG8_WAIT_L(0); PG8_MMA(0, 1, At, B1); PG8_BAR;
            PG8_LDA(At, 0, 1); PG8_STAGE(PG8_SA(0, 0), a2, voffA);
            PG8_BAR; PG8_WAIT_L(0); PG8_MMA(1, 0, At, B0); PG8_BAR; PG8_SCHED;
            PG8_STAGE(PG8_SB(0, 1), b2 + hstep, voffB);
            PG8_WAIT_V(6); PG8_BAR; PG8_MMA(1, 1, At, B1); PG8_BAR;
            PG8_LDB(B0, 1, 0); PG8_SCHED; PG8_LDA(At, 1, 0); PG8_STAGE(PG8_SA(0, 1), a2 + hstep, voffA);
            PG8_WAIT_L(8); PG8_BAR; PG8_WAIT_L(0); PG8_MMA(0, 0, At, B0); PG8_BAR; PG8_SCHED;
            PG8_LDB(B1, 1, 1); PG8_STAGE(PG8_SB(1, 0), b3, voffB);
            PG8_BAR; PG8_WAIT_L(0); PG8_MMA(0, 1, At, B1); PG8_BAR;
            PG8_LDA(At, 1, 1); PG8_STAGE(PG8_SA(1, 0), a3, voffA);
            PG8_BAR; PG8_WAIT_L(0); PG8_MMA(1, 0, At, B0); PG8_BAR; PG8_SCHED;
            PG8_STAGE(PG8_SB(1, 1), b3 + hstep, voffB);
            PG8_WAIT_V(6); PG8_BAR; PG8_MMA(1, 1, At, B1); PG8_BAR;
            }
        }
        if constexpr (ALIGN_EPI) { if (wr == 0) PG8_BAR; }
        if constexpr (!Epi::AFTER_DRAIN) { E(acc, cur, wr, wc, fr, fq); S.done(cur); }
        if (!has_next) break;
#pragma unroll
        for (int a = 0; a < 2; ++a)
#pragma unroll
            for (int b = 0; b < 2; ++b)
#pragma unroll
                for (int m = 0; m < 4; ++m)
#pragma unroll
                    for (int n = 0; n < 2; ++n) acc[a][b][m][n] = (f32x4){0.f, 0.f, 0.f, 0.f};
        cur = nxt; cA = nA; cB = nB; ++ui;
        if constexpr (ALIGN_EPI) { if (wr == 1) PG8_BAR; }
    }
    PG8_WAIT_V(0);
    if constexpr (!ALIGN_EPI) { if (wr == 0) PG8_BAR; }
    PG8_BAR;
    if constexpr (Epi::AFTER_DRAIN) { E.fused(acc, cur, wr, wc, fr, fq, lds, wid, lane); S.done(cur); }
#undef PG8_SA
#undef PG8_SB
#undef PG8_STAGE
#undef PG8_LDA
#undef PG8_LDB
#undef PG8_MMA
#undef PG8_WAIT_V
#undef PG8_WAIT_L
#undef PG8_BAR
#undef PG8_SCHED
}
}
constexpr int BATCH = 2, SEQ = 8192, DM = 1024, DEPTH = 4, M = BATCH * SEQ;
constexpr int NIN = 9224, NP = 9216, NPAD = 9216, BW = 512;
constexpr int C_GQ = 0, C_GK = 512, C_GV = 1024, C_GZ = 1536, C_DQ = 2048, C_DK = 2560, C_DV = 3072, C_DZ = 3584,
              C_SB = 4096, C_SC = 4608, C_SX = 5120, C_SZ = 5632, C_MG = 6144;
constexpr float EPS = 1e-6f;
constexpr int NWAVES = 8, NTHR = 512;
constexpr int LDS_BYTES = 147456;
constexpr size_t MiB = 1u << 20;
constexpr size_t WS_CTL = 0;
constexpr size_t WS_WIN = 2 * MiB;
constexpr size_t WIN_L = (size_t)NPAD * DM;
constexpr size_t WS_WBR = 76 * MiB;
constexpr size_t WS_WOUT = 88 * MiB;
constexpr size_t WS_PROJ = 96 * MiB;
constexpr size_t WS_BA = 384 * MiB;
constexpr size_t WS_REGB = 386 * MiB;
constexpr size_t WS_REGC = 418 * MiB;
constexpr size_t WS_REGD = 482 * MiB;
constexpr size_t WS_GL = 554 * MiB;
constexpr size_t WS_WBA = 554 * MiB + 65536;
constexpr size_t WS_END = 555 * MiB;
constexpr int NUNIT = BATCH * 4 * 128;
constexpr size_t UREC = 36864, R_W = 0, R_QD = 8192, R_KD = 16384, R_QK = 24576, R_U = 28672;

typedef unsigned short bf16;
typedef unsigned v4u __attribute__((ext_vector_type(4)));
typedef unsigned v2u __attribute__((ext_vector_type(2)));
typedef float f32x4 __attribute__((ext_vector_type(4)));
#define LAS __attribute__((address_space(3)))

__device__ __forceinline__ unsigned f2bf(float f) { unsigned u = __builtin_bit_cast(unsigned, f); return (u + 0x7fffu + ((u >> 16) & 1u)) >> 16; }
typedef float f32x2_t __attribute__((ext_vector_type(2))); typedef __bf16 bf16x2_t __attribute__((ext_vector_type(2)));
__device__ __forceinline__ unsigned cvtpk(float lo, float hi) { f32x2_t v = {lo, hi}; bf16x2_t bb = __builtin_convertvector(v, bf16x2_t); return __builtin_bit_cast(unsigned, bb); }
__device__ __forceinline__ unsigned pk2(float lo, float hi) { return cvtpk(lo, hi); }
__device__ __forceinline__ float bf2f(unsigned short b) { return __builtin_bit_cast(float, (unsigned)b << 16); }
__device__ __forceinline__ float bflo(unsigned w) { return __builtin_bit_cast(float, w << 16); }
__device__ __forceinline__ float bfhi(unsigned w) { return __builtin_bit_cast(float, w & 0xffff0000u); }
__device__ __forceinline__ void ld8(const bf16* p, float* f) { const v4u w = *(const v4u*)p; f[0] = bflo(w.x); f[1] = bfhi(w.x); f[2] = bflo(w.y); f[3] = bfhi(w.y); f[4] = bflo(w.z); f[5] = bfhi(w.z); f[6] = bflo(w.w); f[7] = bfhi(w.w); }
__device__ __forceinline__ void st8(bf16* p, const float* f) { v4u w; w.x = pk2(f[0], f[1]); w.y = pk2(f[2], f[3]); w.z = pk2(f[4], f[5]); w.w = pk2(f[6], f[7]); *(v4u*)p = w; }
__device__ __forceinline__ float wave_sum(float v) {
#pragma unroll
    for (int o = 1; o < 64; o <<= 1) v += __shfl_xor(v, o);
    return v;
}
__device__ __forceinline__ float sigmoidf_(float x) { return 1.f / (1.f + __expf(-x)); }
__device__ __forceinline__ float siluf_(float x) { return x / (1.f + __expf(-x)); }
__device__ __forceinline__ int srccol(int p) { return p < 2048 ? p : (p < 9216 ? p + 8 : (p < 9224 ? 2048 + (p - 9216) : -1)); }

struct Args {
    const float* x; const float* norm_pre; const float* norm_post; const float* w_in; const float* gdn_conv_w; const float* gdn_a_log; const float* gdn_dt_bias;
    const float* gdn_norm_w; const float* diff_lambda; const float* diff_norm_w; const float* sc_conv_w; const float* w_branch; const float* w_out;
    float* out; unsigned char* ws; int ph_lo, ph_hi, coop, pad;
};

struct EpiProj {
    static constexpr bool PERM = true, AFTER_DRAIN = false;
    bf16* P; float* BA;
    __device__ __forceinline__ void operator()(const pg8::f32x4 (&acc)[2][2][4][2], const pg8::Unit& u, int wr, int wc, int fr, int fq) const {
        const int row0 = u.pm * 256 + wr * 64 + fr;
        const int colt = u.pn * 256; const float sc = (colt >= C_DQ && colt < C_DK) ? 0.18033688011112042f : 1.f;
        const int col0 = colt + wc * 32 + 8 * fq;
#pragma unroll
        for (int ai = 0; ai < 2; ++ai)
#pragma unroll
            for (int m = 0; m < 4; ++m) { bf16* rowp = P + (size_t)(row0 + ai * 128 + m * 16) * NP + col0;
#pragma unroll
                for (int bj = 0; bj < 2; ++bj) { const pg8::f32x4 v0 = acc[ai][bj][m][0] * sc, v1 = acc[ai][bj][m][1] * sc; v4u w;
                    w.x = pg8::cvt_pk_bf16(v0[0], v0[1]); w.y = pg8::cvt_pk_bf16(v0[2], v0[3]); w.z = pg8::cvt_pk_bf16(v1[0], v1[1]); w.w = pg8::cvt_pk_bf16(v1[2], v1[3]);
                    *(v4u*)(rowp + bj * 128) = w; } }
    }
};
struct BranchOrder {
    int pm0, pn0;
    __device__ __forceinline__ bool next(int i, pg8::Unit& u) const { if (i >= 3) return false; u.pm = i * 64 + pm0; u.pn = i * 4 + pn0; return true; }
    __device__ __forceinline__ void a_ready(const pg8::Unit&) const {}
    __device__ __forceinline__ void done(const pg8::Unit&) const {}
};
struct EpiBranch {
    static constexpr bool PERM = true, AFTER_DRAIN = false;
    const bf16* P; float* MG; bf16* MB;
    __device__ __forceinline__ void operator()(const pg8::f32x4 (&acc)[2][2][4][2], const pg8::Unit& u, int wr, int wc, int fr, int fq) const {
        const int kb = u.pn >> 2;
        const int row0 = (u.pm & 63) * 256 + wr * 64 + fr; const int col0 = (u.pn & 3) * 256 + wc * 32 + 8 * fq;
#pragma unroll
        for (int ai = 0; ai < 2; ++ai)
#pragma unroll
            for (int m = 0; m < 4; ++m) { const size_t row = (size_t)(row0 + ai * 128 + m * 16);
#pragma unroll
                for (int bj = 0; bj < 2; ++bj) { const int col = col0 + bj * 128; float lg[8]; ld8(P + row * NP + C_MG + kb * 1024 + col, lg);
                    float v[8];
#pragma unroll
                    for (int j = 0; j < 4; ++j) { v[j] = acc[ai][bj][m][0][j] * sigmoidf_(lg[j]); v[4 + j] = acc[ai][bj][m][1][j] * sigmoidf_(lg[4 + j]); }
                    bf16* mp = MB + row * DM + col;
                    if (kb > 0) { float pv[8]; ld8(mp, pv);
#pragma unroll
                        for (int j = 0; j < 8; ++j) v[j] += pv[j]; }
                    st8(mp, v); } }
    }
};
struct EpiOutBf16 {
    static constexpr bool PERM = true, AFTER_DRAIN = false;
    bf16* O;
    __device__ __forceinline__ void operator()(const pg8::f32x4 (&acc)[2][2][4][2], const pg8::Unit& u, int wr, int wc, int fr, int fq) const {
        const int row0 = u.pm * 256 + wr * 64 + fr; const int col0 = u.pn * 256 + wc * 32 + 8 * fq;
#pragma unroll
        for (int ai = 0; ai < 2; ++ai)
#pragma unroll
            for (int m = 0; m < 4; ++m) { bf16* rowp = O + (size_t)(row0 + ai * 128 + m * 16) * DM + col0;
#pragma unroll
                for (int bj = 0; bj < 2; ++bj) { const pg8::f32x4 v0 = acc[ai][bj][m][0], v1 = acc[ai][bj][m][1]; v4u w;
                    w.x = pg8::cvt_pk_bf16(v0[0], v0[1]); w.y = pg8::cvt_pk_bf16(v0[2], v0[3]); w.z = pg8::cvt_pk_bf16(v1[0], v1[1]); w.w = pg8::cvt_pk_bf16(v1[2], v1[3]);
                    *(v4u*)(rowp + bj * 128) = w; } }
    }
};

__device__ __forceinline__ void tr_item(const float* W, int ldw, int K, bf16* WT, int k0, int p0, int mode, float* scr, int lane) {
    const int p = p0 + lane; const int sc = mode ? srccol(p) : p;
    const float* src = W + (size_t)k0 * ldw + (sc >= 0 ? sc : 0);
#pragma unroll 16
    for (int kk = 0; kk < 64; ++kk) { const float v = src[(size_t)kk * ldw]; scr[kk * 65 + lane] = sc >= 0 ? v : 0.f; }
    asm volatile("s_waitcnt lgkmcnt(0)" ::: "memory");
    const int c = lane & 7;
#pragma unroll
    for (int j = 0; j < 8; ++j) { const int nn = (lane >> 3) + 8 * j; const float* s = scr + (8 * c) * 65 + nn;
        v4u o; o.x = pk2(s[0 * 65], s[1 * 65]); o.y = pk2(s[2 * 65], s[3 * 65]); o.z = pk2(s[4 * 65], s[5 * 65]); o.w = pk2(s[6 * 65], s[7 * 65]);
        *(v4u*)(WT + (size_t)(p0 + nn) * K + k0 + 8 * c) = o; }
    asm volatile("s_waitcnt lgkmcnt(0)" ::: "memory");
}
__device__ __forceinline__ void norm_row_to_h(const float* xrow, const float* wpre, bf16* hrow, int lane) {
    f32x4 v[4]; float s = 0.f;
#pragma unroll
    for (int j = 0; j < 4; ++j) { v[j] = *(const f32x4*)(xrow + 4 * lane + 256 * j); s += (v[j].x * v[j].x + v[j].y * v[j].y) + (v[j].z * v[j].z + v[j].w * v[j].w); }
    const float rs = rsqrtf(wave_sum(s) * (1.f / DM) + EPS);
#pragma unroll
    for (int j = 0; j < 4; ++j) { const f32x4 w = *(const f32x4*)(wpre + 4 * lane + 256 * j); v2u o; o.x = pk2(v[j].x * rs * w.x, v[j].y * rs * w.y); o.y = pk2(v[j].z * rs * w.z, v[j].w * rs * w.w);
        *(v2u*)(hrow + 4 * lane + 256 * j) = o; }
}
__device__ __forceinline__ void phase_prologue(const Args& a, unsigned char* lds, int wv_) {
    int tid_ = wv_ * 64 + mk_lane(); asm volatile("" : "+v"(tid_)); const int tid = tid_, lane = tid & 63, wave = tid >> 6;
    float* scr = (float*)(lds + wave * 16896);
    const int gw = blockIdx.x * NWAVES + wave, NGW = gridDim.x * NWAVES;
    constexpr int I_IN = (DM / 64) * (NPAD / 64), I_BR = (BW / 64) * (DM / 64), I_OUT = (DM / 64) * (DM / 64);
    constexpr int NITEMS = DEPTH * I_IN + DEPTH * 3 * I_BR + DEPTH * I_OUT;
    bf16* win = (bf16*)(a.ws + WS_WIN); bf16* wbr = (bf16*)(a.ws + WS_WBR); bf16* wout = (bf16*)(a.ws + WS_WOUT);
    for (int it = gw; it < NITEMS; it += NGW) {
        int r = it;
        if (r < DEPTH * I_IN) { const int l = r / I_IN; r %= I_IN; const int nb = NPAD / 64, kb = r / nb, pb = r % nb;
            tr_item(a.w_in + (size_t)l * DM * NIN, NIN, DM, win + (size_t)l * WIN_L, kb * 64, pb * 64, 1, scr, lane); continue; }
        r -= DEPTH * I_IN;
        if (r < DEPTH * 3 * I_BR) { const int lk = r / I_BR; r %= I_BR; const int nb = DM / 64, kb = r / nb, pb = r % nb;
            tr_item(a.w_branch + (size_t)lk * BW * DM, DM, BW, wbr + (size_t)lk * DM * BW, kb * 64, pb * 64, 0, scr, lane); continue; }
        r -= DEPTH * 3 * I_BR;
        { const int l = r / I_OUT; r %= I_OUT; const int nb = DM / 64, kb = r / nb, pb = r % nb;
            tr_item(a.w_out + (size_t)l * DM * DM, DM, DM, wout + (size_t)l * DM * DM, kb * 64, pb * 64, 0, scr, lane); }
    }
    if (blockIdx.x == 0 && tid < DEPTH) ((unsigned*)(a.ws + WS_CTL))[64 * tid] = 0u;
    { float* wba = (float*)(a.ws + WS_WBA);
      for (int i = blockIdx.x * NTHR + tid; i < DEPTH * 8 * DM; i += gridDim.x * NTHR) { const int k = i & (DM - 1), c = (i >> 10) & 7, ll = i >> 13; wba[i] = a.w_in[((size_t)ll * DM + k) * NIN + 2048 + c]; } }
    bf16* H = (bf16*)(a.ws + WS_REGB);
    for (int m = gw; m < M; m += NGW) norm_row_to_h(a.x + (size_t)m * DM, a.norm_pre, H + (size_t)m * DM, lane);
}

__device__ __forceinline__ void phase_ba(const Args& a, int l, int wv_) {
    const bf16* H = (const bf16*)(a.ws + WS_REGB); float* BA = (float*)(a.ws + WS_BA); const float* wba = (const float*)(a.ws + WS_WBA) + (size_t)l * 8 * DM;
    const int tid = wv_ * 64 + mk_lane(), lane = tid & 63, wave = tid >> 6; const int gw = blockIdx.x * NWAVES + wave, NGW = gridDim.x * NWAVES;
    f32x4 w[8][4];
#pragma unroll
    for (int c = 0; c < 8; ++c)
#pragma unroll
        for (int j = 0; j < 4; ++j) w[c][j] = *(const f32x4*)(wba + c * DM + 4 * lane + 256 * j);
#pragma unroll 1
    for (int row = gw; row < M; row += NGW) {
        f32x4 hv[4];
#pragma unroll
        for (int j = 0; j < 4; ++j) { const v2u hw = *(const v2u*)(H + (size_t)row * DM + 4 * lane + 256 * j); hv[j] = (f32x4){bflo(hw.x), bfhi(hw.x), bflo(hw.y), bfhi(hw.y)}; }
        float mine = 0.f;
#pragma unroll
        for (int c = 0; c < 8; ++c) { float s = 0.f;
#pragma unroll
            for (int j = 0; j < 4; ++j) s += (hv[j].x * w[c][j].x + hv[j].y * w[c][j].y) + (hv[j].z * w[c][j].z + hv[j].w * w[c][j].w);
            s = wave_sum(s); if (lane == c) mine = s; }
        if (lane < 8) BA[(size_t)row * 8 + lane] = mine;
    }
}

typedef short bf16x8 __attribute__((ext_vector_type(8)));
typedef float f32x16 __attribute__((ext_vector_type(16)));
__device__ __forceinline__ int crow(int r, int hi) { return (r & 3) + 8 * (r >> 2) + 4 * hi; }
#define MFMA32(a, b, c) __builtin_amdgcn_mfma_f32_32x32x16_bf16((a), (b), (c), 0, 0, 0)
constexpr int AT_KS = 0, AT_VT = 64 * 144, AT_BUF = 32768, AT_FS = 65536, AT_CTR = AT_FS + 1024;
__device__ __forceinline__ void phase_attn(const Args& a, unsigned char* lds, int l, int wv_) {
    const bf16* P = (const bf16*)(a.ws + WS_PROJ); float* OATT = (float*)(a.ws + WS_REGC);
    int tid_ = wv_ * 64 + mk_lane(); asm volatile("" : "+v"(tid_)); const int tid = tid_, lane = tid & 63, r32 = lane & 31, hi = lane >> 5, wave = tid >> 6;
    float* fs = (float*)(lds + AT_FS) + wave * 32;
    unsigned* ctr = (unsigned*)(a.ws + WS_CTL) + 64 * l;
#pragma unroll 1
    for (;;) {
        __syncthreads();
        if (tid == 0) *(volatile unsigned*)(lds + AT_CTR) = atomicAdd(ctr, 1u);
        __syncthreads();
        const unsigned uidx = *(volatile unsigned*)(lds + AT_CTR);
        if (uidx >= 576u) break;
        int h, rows0, nw; const int bb = (int)((uidx >> 1) & 1u), mp = (int)(uidx & 1u);
        if (uidx < 128u) { h = 3; rows0 = (63 - (int)(uidx >> 2)) * 128; nw = 4; }
        else if (uidx < 192u) { h = 3; rows0 = (15 - (int)((uidx - 128u) >> 2)) * 256; nw = 8; }
        else { const unsigned v = uidx - 192u; h = 2 - (int)(v >> 7); rows0 = (31 - (int)((v & 127u) >> 2)) * 256; nw = 8; }
        const int stream = bb * 8 + h * 2 + mp; const bool act = wave < nw;
        const float slope2 = exp2f(-2.f * (float)(h + 1)) * 1.4426950408889634f;
        const bf16* Kg = P + (size_t)bb * SEQ * NP + C_DK + h * 128 + mp * 64 + (size_t)(tid >> 3) * NP + (tid & 7) * 8;
        const int vp = tid & 31, vc = tid >> 5;
        const bf16* Vg = P + (size_t)bb * SEQ * NP + C_DV + h * 128 + (size_t)(2 * vp) * NP + vc * 8;
        const int vpos = ((2 * vp) & 48) | (((2 * vp) & 4) << 1) | (((2 * vp) & 8) >> 1) | ((2 * vp) & 3);
        {
            const int q0 = rows0 + (act ? wave : 0) * 32, t = q0 + r32;
            bf16x8 qr[4];
            { const bf16* qp = P + ((size_t)bb * SEQ + t) * NP + C_DQ + h * 128 + mp * 64 + hi * 8;
#pragma unroll
              for (int d0 = 0; d0 < 4; ++d0) qr[d0] = *(const bf16x8*)(qp + d0 * 16); }
            float cb[16];
#pragma unroll
            for (int r = 0; r < 16; ++r) cb[r] = slope2 * (float)crow(r, hi);
            float qkb;
            { float qs = 0.f;
#pragma unroll
              for (int d0 = 0; d0 < 4; ++d0)
#pragma unroll
                  for (int j = 0; j < 8; ++j) { const float v = bf2f((unsigned short)qr[d0][j]); qs += v * v; }
              qs += __shfl_xor(qs, 32);
              const float km = __uint_as_float(__hip_atomic_load((unsigned*)(a.ws + WS_CTL) + 1024 + 16 * l + stream, __ATOMIC_RELAXED, __HIP_MEMORY_SCOPE_AGENT));
              qkb = sqrtf(qs * km) * 1.01f + 0.01f; }
            bool wdone = !act;
            f32x16 o[4];
#pragma unroll
            for (int db = 0; db < 4; ++db)
#pragma unroll
                for (int r = 0; r < 16; ++r) o[db][r] = 0.f;
            float m_ref = -1e30f, lsum = 0.f;
            const int ntile = (rows0 + nw * 32) >> 6;
            v4u kreg, vreg0, vreg1;
#define AT_LOAD(tile) do { const size_t jo_ = (size_t)(tile) * 64 * NP; kreg = *(const v4u*)(Kg + jo_); vreg0 = *(const v4u*)(Vg + jo_); vreg1 = *(const v4u*)(Vg + jo_ + NP); } while (0)
#define AT_STORE(bufo) do { *(v4u*)(lds + (bufo) + AT_KS + (tid >> 3) * 144 + (tid & 7) * 16) = kreg; \
                unsigned* vt_ = (unsigned*)(lds + (bufo) + AT_VT + (vc * 8) * 144 + vpos * 2); \
                const unsigned a_[4] = {vreg0.x, vreg0.y, vreg0.z, vreg0.w}, b_[4] = {vreg1.x, vreg1.y, vreg1.z, vreg1.w}; \
                _Pragma("unroll") for (int x = 0; x < 4; ++x) { vt_[(2 * x) * 36] = (a_[x] & 0xffffu) | (b_[x] << 16); vt_[(2 * x + 1) * 36] = (a_[x] >> 16) | (b_[x] & 0xffff0000u); } } while (0)
            AT_LOAD(ntile - 1);
            __syncthreads();
            AT_STORE(0);
            AT_LOAD(ntile - 2);
            int bufo = 0;
#pragma unroll 1
            for (int tt = ntile - 1; tt >= 0; --tt) {
                if (__syncthreads_and(wdone ? 1 : 0)) break;
                if (tt > 0) { AT_STORE(bufo ^ AT_BUF); if (tt > 1) AT_LOAD(tt - 2); }
                const unsigned char* lb = lds + bufo;
                const int j0 = tt * 64;
                if (!wdone && j0 <= q0 + 31) {
                    const float base = slope2 * (float)(j0 - t), base1 = base + 32.f * slope2;
                    f32x16 p0, p1;
#pragma unroll
                    for (int r = 0; r < 16; ++r) { p0[r] = cb[r] + base; p1[r] = cb[r] + base1; }
                    { const unsigned char* kb = lb + AT_KS + r32 * 144 + hi * 16;
#pragma unroll
                      for (int d0 = 0; d0 < 4; ++d0) { const bf16x8 a0 = *(const bf16x8*)(kb + d0 * 32), a1 = *(const bf16x8*)(kb + 32 * 144 + d0 * 32);
                          p0 = MFMA32(a0, qr[d0], p0); p1 = MFMA32(a1, qr[d0], p1); } }
                    if (j0 + 63 > q0) {
#pragma unroll
                        for (int r = 0; r < 16; ++r) { const int kv = j0 + crow(r, hi); if (kv > t) p0[r] = -1e30f; if (kv + 32 > t) p1[r] = -1e30f; }
                    }
                    float mx = fmaxf(p0[0], p1[0]);
#pragma unroll
                    for (int r = 1; r < 16; ++r) mx = fmaxf(mx, fmaxf(p0[r], p1[r]));
                    mx = fmaxf(mx, __shfl_xor(mx, 32));
                    if (__any(mx > m_ref + 8.f)) {
                        const float m_new = fmaxf(m_ref, mx), f = __builtin_amdgcn_exp2f(m_ref - m_new); m_ref = m_new; lsum *= f;
                        if (hi == 0) fs[r32] = f;
                        __builtin_amdgcn_wave_barrier();
#pragma unroll
                        for (int g = 0; g < 4; ++g) { const f32x4 ff = *(const f32x4*)(fs + 8 * g + 4 * hi);
#pragma unroll
                            for (int db = 0; db < 4; ++db) { o[db][4 * g] *= ff.x; o[db][4 * g + 1] *= ff.y; o[db][4 * g + 2] *= ff.z; o[db][4 * g + 3] *= ff.w; } }
                        __builtin_amdgcn_wave_barrier();
                    }
                    float sacc = 0.f;
#pragma unroll
                    for (int r = 0; r < 16; ++r) { p0[r] = __builtin_amdgcn_exp2f(p0[r] - m_ref); p1[r] = __builtin_amdgcn_exp2f(p1[r] - m_ref); sacc += p0[r] + p1[r]; }
                    lsum += sacc;
                    bf16x8 pk[4];
#pragma unroll
                    for (int s = 0; s < 2; ++s) { v4u w0, w1;
                        w0.x = cvtpk(p0[8 * s], p0[8 * s + 1]); w0.y = cvtpk(p0[8 * s + 2], p0[8 * s + 3]); w0.z = cvtpk(p0[8 * s + 4], p0[8 * s + 5]); w0.w = cvtpk(p0[8 * s + 6], p0[8 * s + 7]);
                        w1.x = cvtpk(p1[8 * s], p1[8 * s + 1]); w1.y = cvtpk(p1[8 * s + 2], p1[8 * s + 3]); w1.z = cvtpk(p1[8 * s + 4], p1[8 * s + 5]); w1.w = cvtpk(p1[8 * s + 6], p1[8 * s + 7]);
                        pk[s] = __builtin_bit_cast(bf16x8, w0); pk[2 + s] = __builtin_bit_cast(bf16x8, w1); }
                    const unsigned char* vb = lb + AT_VT + r32 * 144 + hi * 16;
#pragma unroll
                    for (int s = 0; s < 4; ++s)
#pragma unroll
                        for (int db = 0; db < 4; ++db) o[db] = MFMA32(pk[s], *(const bf16x8*)(vb + db * 32 * 144 + s * 32), o[db]);
                    if (__all(qkb + slope2 * (float)(j0 - 1 - t) - m_ref < -40.f)) wdone = true;
                }
                bufo ^= AT_BUF;
            }
#undef AT_LOAD
#undef AT_STORE
            if (act) {
            lsum += __shfl_xor(lsum, 32);
            __builtin_amdgcn_wave_barrier();
            if (hi == 0) fs[r32] = 1.f / lsum;
            __builtin_amdgcn_wave_barrier();
#pragma unroll
            for (int g = 0; g < 4; ++g) { const f32x4 ff = *(const f32x4*)(fs + 8 * g + 4 * hi); const float fv[4] = {ff.x, ff.y, ff.z, ff.w};
#pragma unroll
                for (int x = 0; x < 4; ++x) { const size_t row = (size_t)bb * SEQ + q0 + 8 * g + 4 * hi + x; float* dst = OATT + ((row * 4 + h) * 2 + mp) * 128 + r32;
#pragma unroll
                    for (int db = 0; db < 4; ++db) dst[db * 32] = o[db][4 * g + x] * fv[x]; } }
            }
            __builtin_amdgcn_wave_barrier();
        }
    }
    __syncthreads();
}

__device__ __forceinline__ int afrag_off(int row, int k, int nks) { const int rt = row >> 5, r = row & 31, ks = k >> 4, kk = k & 15, h = (kk >> 2) & 1, j = ((kk >> 3) << 2) | (kk & 3); return ((rt * nks + ks) * 64 + r + 32 * h) * 8 + j; }
__device__ __forceinline__ int clay_off(int c, int dv) { const int rt = c >> 5, cc = c & 31, hi = (cc >> 2) & 1, i = ((cc >> 3) << 2) | (cc & 3), sl = dv >> 5, r32 = dv & 31; return ((rt * 4 + sl) * 64 + r32 + 32 * hi) * 16 + i; }
__device__ __forceinline__ void phase_gdn_local_v1(const Args& a, unsigned char* lds, int l, int wv_) {
    const bf16* P = (const bf16*)(a.ws + WS_PROJ); const float* BA = (const float*)(a.ws + WS_BA);
    bf16* GD = (bf16*)(a.ws + WS_REGD); float* GL = (float*)(a.ws + WS_GL);
    float* qs = (float*)lds; float* ks = qs + 64 * 129; float* vs = ks + 64 * 129; float* KKs = vs + 64 * 129; float* QKs = KKs + 64 * 65;
    float* beta = QKs + 64 * 65; float* gc = beta + 64;
    int tid_ = wv_ * 64 + mk_lane(); asm volatile("" : "+v"(tid_)); const int tid = tid_, lane = tid & 63, wave = tid >> 6;
    const float* cw = a.gdn_conv_w + (size_t)l * 4 * 1536;
    for (int unit = blockIdx.x; unit < NUNIT; unit += gridDim.x) {
        const int bb = unit >> 9, h = (unit >> 7) & 3, n = unit & 127;
        __syncthreads();
#pragma unroll 1
        for (int idx = tid; idx < 3 * 64 * 128; idx += NTHR) {
            const int mat = idx >> 13, rem = idx & 8191, t = rem >> 7, c = rem & 127, col = mat * 512 + h * 128 + c;
            float acc = 0.f;
#pragma unroll
            for (int j = 0; j < 4; ++j) { const int tt = n * 64 + t - 3 + j; if (tt >= 0) acc += cw[j * 1536 + col] * bf2f(P[((size_t)bb * SEQ + tt) * NP + col]); }
            (mat == 0 ? qs : mat == 1 ? ks : vs)[t * 129 + c] = siluf_(acc);
        }
        if (tid < 64) {
            const size_t row = (size_t)bb * SEQ + n * 64 + tid;
            beta[tid] = sigmoidf_(BA[row * 8 + h]);
            const float xx = BA[row * 8 + 4 + h] + a.gdn_dt_bias[l * 4 + h];
            const float sp = xx > 20.f ? xx : log1pf(__expf(xx));
            gc[tid] = -__expf(a.gdn_a_log[l * 4 + h]) * sp;
        }
        __syncthreads();
        if (tid == 0) { float run = 0.f;
#pragma unroll 1
            for (int c = 0; c < 64; ++c) { run += gc[c]; gc[c] = run; } }
        __syncthreads();
#pragma unroll 1
        for (int r = wave * 8; r < wave * 8 + 8; ++r) {
            { float x0 = qs[r * 129 + lane], x1 = qs[r * 129 + 64 + lane]; const float sc = rsqrtf(wave_sum(x0 * x0 + x1 * x1) + 1e-6f) * 0.08838834764831845f; qs[r * 129 + lane] = x0 * sc; qs[r * 129 + 64 + lane] = x1 * sc; }
            { float x0 = ks[r * 129 + lane], x1 = ks[r * 129 + 64 + lane]; const float sc = rsqrtf(wave_sum(x0 * x0 + x1 * x1) + 1e-6f); ks[r * 129 + lane] = x0 * sc; ks[r * 129 + 64 + lane] = x1 * sc; }
        }
        __syncthreads();
#pragma unroll 1
        for (int i = 0; i < 8; ++i) { const int idx = tid + NTHR * i, c = idx >> 6, s = idx & 63; float kk = 0.f, qk = 0.f;
#pragma unroll 4
            for (int d = 0; d < 128; ++d) { const float kv = ks[s * 129 + d]; kk += ks[c * 129 + d] * kv; qk += qs[c * 129 + d] * kv; }
            const float dec = (s <= c) ? __expf(gc[c] - gc[s]) : 0.f;
            KKs[c * 65 + s] = (s < c) ? kk * beta[c] * dec : 0.f; QKs[c * 65 + s] = qk * dec; }
        __syncthreads();
        const size_t ub = (size_t)unit * UREC;
        { const float gl = gc[63];
          for (int idx = tid; idx < 8192; idx += NTHR) { const int c = idx >> 7, d = idx & 127;
              GD[ub + R_QD + afrag_off(c, d, 8)] = (bf16)f2bf(qs[c * 129 + d] * __expf(gc[c])); GD[ub + R_KD + afrag_off(d, c, 4)] = (bf16)f2bf(ks[c * 129 + d] * __expf(gl - gc[c])); }
          for (int idx = tid; idx < 4096; idx += NTHR) { const int c = idx >> 6, s = idx & 63; GD[ub + R_QK + afrag_off(c, s, 4)] = (bf16)f2bf(QKs[c * 65 + s]); }
          if (tid == 0) GL[unit] = __expf(gl); }
        __syncthreads();
        for (int idx = tid; idx < 8192; idx += NTHR) { const int c = idx >> 7, d = idx & 127; vs[c * 129 + d] *= beta[c]; ks[c * 129 + d] *= beta[c] * __expf(gc[c]); }
        __syncthreads();
        if (tid < 256) {
            float* X = (tid < 128 ? vs : ks) + (tid & 127);
#pragma unroll 1
            for (int c = 1; c < 64; ++c) { float acc = X[c * 129]; const float* Ar = KKs + c * 65;
#pragma unroll 4
                for (int s = 0; s < c; ++s) acc -= Ar[s] * X[s * 129];
                X[c * 129] = acc; }
            if (tid < 128) { for (int c = 0; c < 64; ++c) GD[ub + R_U + clay_off(c, tid)] = (bf16)f2bf(X[c * 129]); }
            else { for (int c = 0; c < 64; ++c) GD[ub + R_W + afrag_off(c, tid - 128, 8)] = (bf16)f2bf(-X[c * 129]); }
        }
    }
    __syncthreads();
}

constexpr int GL_QB = 0, GL_KB = 17408, GL_VB = 34816, GL_AM = 52224, GL_QK = 69632, GL_XT = 78848, GL_BETA = 115712, GL_GC = 115968, GL_EGC = 116224;
template <int ROFF> __device__ __forceinline__ void tri_solve32(float (&x)[32], const float* Am) {
#pragma unroll
    for (int c = 1; c < 32; ++c) { int off = (ROFF + c) * 68 + ROFF;
        if (c >= 2) asm volatile("" : "+v"(off), "+v"(x[c - 2])); else asm volatile("" : "+v"(off));
        const float* ar = Am + off; float a0 = x[c], a1 = 0.f, a2 = 0.f, a3 = 0.f;
#pragma unroll
        for (int s4 = 0; s4 < c; s4 += 4) { const f32x4 av = *(const f32x4*)(ar + s4);
            a0 -= av.x * x[s4]; if (s4 + 1 < c) a1 -= av.y * x[s4 + 1]; if (s4 + 2 < c) a2 -= av.z * x[s4 + 2]; if (s4 + 3 < c) a3 -= av.w * x[s4 + 3]; }
        x[c] = (a0 + a1) + (a2 + a3); }
}
__device__ __forceinline__ void phase_gdn_local(const Args& a, unsigned char* lds, int l, int wv_) {
    const bf16* P = (const bf16*)(a.ws + WS_PROJ); const float* BA = (const float*)(a.ws + WS_BA);
    bf16* GD = (bf16*)(a.ws + WS_REGD); float* GL = (float*)(a.ws + WS_GL);
    bf16* qb = (bf16*)(lds + GL_QB); bf16* kb = (bf16*)(lds + GL_KB); bf16* vb = (bf16*)(lds + GL_VB); float* Am = (float*)(lds + GL_AM); bf16* QKb = (bf16*)(lds + GL_QK); bf16* XT = (bf16*)(lds + GL_XT);
    float* beta = (float*)(lds + GL_BETA); float* gc = (float*)(lds + GL_GC); float* egc = (float*)(lds + GL_EGC); float* edec = (float*)(lds + GL_EGC + 256);
    const float* cwp = a.gdn_conv_w + (size_t)l * 4 * 1536;
#pragma unroll 1
    for (int unit = blockIdx.x; unit < NUNIT; unit += gridDim.x) {
        const int bb = unit >> 9, h = (unit >> 7) & 3, n = unit & 127;
        const size_t ub = (size_t)unit * UREC;
        __syncthreads();
        { const int tid = wv_ * 64 + mk_lane(), lane = tid & 63, r32 = lane & 31, hi = lane >> 5, wave = tid >> 6; (void)r32; (void)hi; (void)wave; (void)lane;
        if (tid < 384) {
            const int g = tid >> 4, cg = tid & 15, mat = g >> 3, tg = g & 7, col = mat * 512 + h * 128 + cg * 8;
            float cw[4][8];
#pragma unroll
            for (int j = 0; j < 4; ++j) { const f32x4 w0 = *(const f32x4*)(cwp + j * 1536 + col), w1 = *(const f32x4*)(cwp + j * 1536 + col + 4);
                cw[j][0] = w0.x; cw[j][1] = w0.y; cw[j][2] = w0.z; cw[j][3] = w0.w; cw[j][4] = w1.x; cw[j][5] = w1.y; cw[j][6] = w1.z; cw[j][7] = w1.w; }
            v4u in[11];
#pragma unroll
            for (int r = 0; r < 11; ++r) { const int tt = n * 64 + tg * 8 - 3 + r; in[r] = (v4u){0u, 0u, 0u, 0u}; if (tt >= 0) in[r] = *(const v4u*)(P + ((size_t)bb * SEQ + tt) * NP + col); }
            bf16* dstm = (mat == 0 ? qb : mat == 1 ? kb : vb) + cg * 8;
#pragma unroll
            for (int i = 0; i < 8; ++i) { float o[8];
#pragma unroll
                for (int e = 0; e < 8; ++e) o[e] = 0.f;
#pragma unroll
                for (int j = 0; j < 4; ++j) { const v4u w = in[i + j]; const float f[8] = {bflo(w.x), bfhi(w.x), bflo(w.y), bfhi(w.y), bflo(w.z), bfhi(w.z), bflo(w.w), bfhi(w.w)};
#pragma unroll
                    for (int e = 0; e < 8; ++e) o[e] += cw[j][e] * f[e]; }
                float ss = 0.f;
#pragma unroll
                for (int e = 0; e < 8; ++e) { o[e] = siluf_(o[e]); ss += o[e] * o[e]; }
                ss += __shfl_xor(ss, 1); ss += __shfl_xor(ss, 2); ss += __shfl_xor(ss, 4); ss += __shfl_xor(ss, 8);
                const float sc = mat == 2 ? 1.f : rsqrtf(ss + 1e-6f) * (mat == 0 ? 0.08838834764831845f : 1.f);
#pragma unroll
                for (int e = 0; e < 8; ++e) o[e] *= sc;
                st8(dstm + (tg * 8 + i) * 136, o); }
        } else if (tid < 448) {
            const int t = tid - 384; const size_t row = (size_t)bb * SEQ + n * 64 + t;
            beta[t] = sigmoidf_(BA[row * 8 + h]);
            const float xx = BA[row * 8 + 4 + h] + a.gdn_dt_bias[l * 4 + h];
            const float sp = xx > 20.f ? xx : log1pf(__expf(xx));
            float gv = -__expf(a.gdn_a_log[l * 4 + h]) * sp;
#pragma unroll
            for (int o = 1; o < 64; o <<= 1) { const float v = __shfl_up(gv, o); if (t >= o) gv += v; }
            gc[t] = gv; egc[t] = __expf(gv); edec[t] = __expf(__shfl(gv, 63) - gv);
        }
        }
        __syncthreads();
        { const int tid = wv_ * 64 + mk_lane(), lane = tid & 63, r32 = lane & 31, hi = lane >> 5, wave = tid >> 6; (void)r32; (void)hi; (void)wave; (void)lane;
        { const int mat = wave >> 2, rt = (wave >> 1) & 1, ct = wave & 1;
          if (mat == 1 || !(rt == 0 && ct == 1)) {
            f32x16 acc;
#pragma unroll
            for (int r = 0; r < 16; ++r) acc[r] = 0.f;
            const bf16* Ab = (mat == 0 ? kb : qb) + (32 * rt + r32) * 136 + 8 * hi; const bf16* Bb = kb + (32 * ct + r32) * 136 + 8 * hi;
            if (!(rt == 0 && ct == 1)) {
#pragma unroll
                for (int ks = 0; ks < 8; ++ks) acc = MFMA32(*(const bf16x8*)(Ab + 16 * ks), *(const bf16x8*)(Bb + 16 * ks), acc);
            }
            const int s = 32 * ct + r32; const float gs = gc[s];
#pragma unroll
            for (int i = 0; i < 16; ++i) { const int c = 32 * rt + crow(i, hi); const float dec = (s <= c) ? __expf(gc[c] - gs) : 0.f;
                if (mat == 0) Am[c * 68 + s] = (s < c) ? acc[i] * beta[c] * dec : 0.f;
                else QKb[c * 72 + s] = (bf16)f2bf(acc[i] * dec); }
          } }
        }
        __syncthreads();
        { const int tid = wv_ * 64 + mk_lane(), lane = tid & 63, r32 = lane & 31, hi = lane >> 5, wave = tid >> 6; (void)r32; (void)hi; (void)wave; (void)lane;
        if (tid < 256) {
            const int col = tid; float x[32];
#pragma unroll
            for (int c = 0; c < 32; ++c) x[c] = (col < 128) ? bf2f(vb[c * 136 + col]) * beta[c] : bf2f(kb[c * 136 + col - 128]) * beta[c] * egc[c];
            tri_solve32<0>(x, Am);
#pragma unroll
            for (int c = 0; c < 32; c += 8) st8(XT + col * 72 + c, x + c);
        } else {
            const int lt = tid - 256; const float gl = gc[63];
#pragma unroll 1
            for (int q = 0; q < 4; ++q) { const int item = lt + 256 * q, f = item >> 6, ln = item & 63, r = ln & 31, hh = ln >> 5;
                { const int rt = f >> 3, ks = f & 7, c = 32 * rt + r; const float e = egc[c]; const bf16* sp = qb + c * 136 + 16 * ks + 4 * hh;
                  const v2u lo = *(const v2u*)sp, hi8 = *(const v2u*)(sp + 8); v4u w;
                  w.x = pk2(bflo(lo.x) * e, bfhi(lo.x) * e); w.y = pk2(bflo(lo.y) * e, bfhi(lo.y) * e); w.z = pk2(bflo(hi8.x) * e, bfhi(hi8.x) * e); w.w = pk2(bflo(hi8.y) * e, bfhi(hi8.y) * e);
                  *(v4u*)(GD + ub + R_QD + item * 8) = w; }
                { const int rt = f >> 2, ks = f & 3, dk = 32 * rt + r; float v[8];
#pragma unroll
                  for (int j = 0; j < 8; ++j) { const int c = 16 * ks + 8 * (j >> 2) + 4 * hh + (j & 3); v[j] = bf2f(kb[c * 136 + dk]) * edec[c]; }
                  st8(GD + ub + R_KD + item * 8, v); } }
#pragma unroll 1
            for (int q = 0; q < 2; ++q) { const int item = lt + 256 * q, f = item >> 6, ln = item & 63, r = ln & 31, hh = ln >> 5, rt = f >> 2, ks = f & 3, c = 32 * rt + r;
                const bf16* sp = QKb + c * 72 + 16 * ks + 4 * hh; const v2u lo = *(const v2u*)sp, hi8 = *(const v2u*)(sp + 8); v4u w; w.x = lo.x; w.y = lo.y; w.z = hi8.x; w.w = hi8.y;
                *(v4u*)(GD + ub + R_QK + item * 8) = w; }
            if (lt == 0) GL[unit] = __expf(gl);
        }
        }
        __syncthreads();
        { const int tid = wv_ * 64 + mk_lane(), lane = tid & 63, r32 = lane & 31, hi = lane >> 5, wave = tid >> 6; (void)r32; (void)hi; (void)wave; (void)lane;
        { const int col = 32 * wave + r32; f32x16 acc;
#pragma unroll
          for (int i = 0; i < 16; ++i) { const int c = 32 + crow(i, hi); acc[i] = (col < 128) ? bf2f(vb[c * 136 + col]) * beta[c] : bf2f(kb[c * 136 + col - 128]) * beta[c] * egc[c]; }
#pragma unroll
          for (int ks = 0; ks < 2; ++ks) { const float* ap = Am + (32 + r32) * 68 + 16 * ks + 8 * hi; const f32x4 a0 = *(const f32x4*)ap, a1 = *(const f32x4*)(ap + 4);
              v4u w; w.x = cvtpk(-a0.x, -a0.y); w.y = cvtpk(-a0.z, -a0.w); w.z = cvtpk(-a1.x, -a1.y); w.w = cvtpk(-a1.z, -a1.w);
              acc = MFMA32(__builtin_bit_cast(bf16x8, w), *(const bf16x8*)(XT + col * 72 + 16 * ks + 8 * hi), acc); }
#pragma unroll
          for (int g = 0; g < 4; ++g) { v2u w; w.x = cvtpk(acc[4 * g], acc[4 * g + 1]); w.y = cvtpk(acc[4 * g + 2], acc[4 * g + 3]); *(v2u*)(XT + col * 72 + 32 + 8 * g + 4 * hi) = w; } }
        }
        __syncthreads();
        { const int tid = wv_ * 64 + mk_lane(), lane = tid & 63, r32 = lane & 31, hi = lane >> 5, wave = tid >> 6; (void)r32; (void)hi; (void)wave; (void)lane;
        if (tid < 256) {
            const int col = tid; float x[32];
#pragma unroll
            for (int c = 0; c < 32; c += 8) ld8(XT + col * 72 + 32 + c, x + c);
            tri_solve32<32>(x, Am);
#pragma unroll
            for (int c = 0; c < 32; c += 8) st8(XT + col * 72 + 32 + c, x + c);
        }
        }
        __syncthreads();
        { const int tid = wv_ * 64 + mk_lane(), lane = tid & 63, r32 = lane & 31, hi = lane >> 5, wave = tid >> 6; (void)r32; (void)hi; (void)wave; (void)lane;
        { const int item = tid, tile = item >> 6, ln = item & 63, rr = ln & 31, hh = ln >> 5, rt = tile >> 2, sl = tile & 3, dv = sl * 32 + rr;
          const bf16* xp = XT + dv * 72 + 32 * rt + 4 * hh; const v2u g0 = *(const v2u*)xp, g1 = *(const v2u*)(xp + 8), g2 = *(const v2u*)(xp + 16), g3 = *(const v2u*)(xp + 24);
          v4u w0, w1; w0.x = g0.x; w0.y = g0.y; w0.z = g1.x; w0.w = g1.y; w1.x = g2.x; w1.y = g2.y; w1.z = g3.x; w1.w = g3.y;
          *(v4u*)(GD + ub + R_U + item * 16) = w0; *(v4u*)(GD + ub + R_U + item * 16 + 8) = w1; }
#pragma unroll 1
        for (int q = 0; q < 2; ++q) { const int item = tid + 512 * q, f = item >> 6, ln = item & 63, r = ln & 31, hh = ln >> 5, rt = f >> 3, ks = f & 7, c = 32 * rt + r;
            unsigned short v[8];
#pragma unroll
            for (int j = 0; j < 8; ++j) { const int kc = 16 * ks + 8 * (j >> 2) + 4 * hh + (j & 3); v[j] = XT[(128 + kc) * 72 + c] ^ 0x8000u; }
            v4u w; w.x = v[0] | ((unsigned)v[1] << 16); w.y = v[2] | ((unsigned)v[3] << 16); w.z = v[4] | ((unsigned)v[5] << 16); w.w = v[6] | ((unsigned)v[7] << 16);
            *(v4u*)(GD + ub + R_W + item * 8) = w; }
        }
    }
    { const int tid = wv_ * 64 + mk_lane(), lane = tid & 63, wave = tid >> 6; const int gw = blockIdx.x * NWAVES + wave, NGW = gridDim.x * NWAVES;
      float mx0 = 0.f, mx1 = 0.f;
#pragma unroll 1
      for (int row = gw; row < M; row += NGW) { float f[8]; ld8(P + (size_t)row * NP + C_DK + lane * 8, f); float ss = 0.f;
#pragma unroll
          for (int j = 0; j < 8; ++j) ss += f[j] * f[j];
          ss += __shfl_xor(ss, 1); ss += __shfl_xor(ss, 2); ss += __shfl_xor(ss, 4);
          if (row < SEQ) mx0 = fmaxf(mx0, ss); else mx1 = fmaxf(mx1, ss); }
      unsigned* KM = (unsigned*)(a.ws + WS_CTL) + 1024 + 16 * l;
      float* red = (float*)lds;
      __syncthreads();
      if ((lane & 7) == 0) { red[wave * 16 + (lane >> 3)] = mx0; red[wave * 16 + 8 + (lane >> 3)] = mx1; }
      __syncthreads();
      if (tid < 16) { float m = red[tid];
#pragma unroll
          for (int w = 1; w < 8; ++w) m = fmaxf(m, red[w * 16 + tid]);
          atomicMax(KM + tid, __float_as_uint(m)); } }
    __syncthreads();
}

constexpr int SC_WN = 0, SC_QD = 16384, SC_KDT = 32768, SC_QK = 49152, SC_U = 57344, SC_GL = 61440, SC_BUF = 61504;
__device__ __forceinline__ bf16x8 pack8(const f32x16& x, int s) { v4u w; w.x = cvtpk(x[8 * s], x[8 * s + 1]); w.y = cvtpk(x[8 * s + 2], x[8 * s + 3]); w.z = cvtpk(x[8 * s + 4], x[8 * s + 5]); w.w = cvtpk(x[8 * s + 6], x[8 * s + 7]); return __builtin_bit_cast(bf16x8, w); }
__device__ __forceinline__ void phase_gdn_scan(const Args& a, unsigned char* lds, int l, int wv_) {
    const bf16* GD = (const bf16*)(a.ws + WS_REGD); const float* GL = (const float*)(a.ws + WS_GL); float* OG = (float*)(a.ws + WS_REGB);
    int tid_ = wv_ * 64 + mk_lane(); asm volatile("" : "+v"(tid_)); const int tid = tid_, lane = tid & 63, r32 = lane & 31, hi = lane >> 5, wave = tid >> 6;
#pragma unroll 1
    for (int job = blockIdx.x; job < 32; job += gridDim.x) {
        const int bh = job >> 2, sl = job & 3, bb = bh >> 2, h = bh & 3;
        f32x16 S[4];
#pragma unroll
        for (int b4 = 0; b4 < 4; ++b4)
#pragma unroll
            for (int r = 0; r < 16; ++r) S[b4][r] = 0.f;
        __syncthreads();
        v4u lr[9]; float lgl = 0.f;
#define SC_FETCH(nn) do { const int unit_ = bh * 128 + (nn); const unsigned char* rec_ = (const unsigned char*)(GD + (size_t)unit_ * UREC) + (tid - 64) * 16; \
            _Pragma("unroll") for (int q = 0; q < 8; ++q) lr[q] = *(const v4u*)(rec_ + q * 7168); \
            if (tid - 64 < 256) lr[8] = *(const v4u*)((const unsigned char*)(GD + (size_t)unit_ * UREC + R_U) + (((tid - 64) >> 7) * 512 + sl * 128 + ((tid - 64) & 127)) * 16); \
            if (tid == 64) lgl = GL[unit_]; } while (0)
        if (wave != 0) SC_FETCH(0);
#pragma unroll 1
        for (int n = -1; n < 128; ++n) {
            if (wave != 0 && n + 1 < 128) {
                unsigned char* dstb = lds + ((n + 1) & 1) * SC_BUF + (tid - 64) * 16;
#pragma unroll
                for (int q = 0; q < 8; ++q) *(v4u*)(dstb + q * 7168) = lr[q];
                if (tid - 64 < 256) *(v4u*)(dstb + 8 * 7168) = lr[8];
                if (tid == 64) *(float*)(lds + ((n + 1) & 1) * SC_BUF + SC_GL) = lgl;
                if (n + 2 < 128) SC_FETCH(n + 2);
            }
            if (wave == 0 && n >= 0) {
                const unsigned char* base = lds + (n & 1) * SC_BUF;
#define SFRAG(off, f) (*(const bf16x8*)(base + (off) + (f) * 1024 + lane * 16))
                bf16x8 Spk[8];
#pragma unroll
                for (int ks = 0; ks < 8; ++ks) Spk[ks] = pack8(S[ks >> 1], ks & 1);
                f32x16 Vn[2];
#pragma unroll
                for (int rt = 0; rt < 2; ++rt) { const v4u u0 = *(const v4u*)(base + SC_U + (rt * 64 + lane) * 32), u1 = *(const v4u*)(base + SC_U + (rt * 64 + lane) * 32 + 16);
                    const unsigned uw[8] = {u0.x, u0.y, u0.z, u0.w, u1.x, u1.y, u1.z, u1.w};
#pragma unroll
                    for (int x = 0; x < 8; ++x) { Vn[rt][2 * x] = bflo(uw[x]); Vn[rt][2 * x + 1] = bfhi(uw[x]); }
#pragma unroll
                    for (int ks = 0; ks < 8; ++ks) Vn[rt] = MFMA32(SFRAG(SC_WN, rt * 8 + ks), Spk[ks], Vn[rt]); }
                bf16x8 Vpk[4];
#pragma unroll
                for (int ks = 0; ks < 4; ++ks) Vpk[ks] = pack8(Vn[ks >> 1], ks & 1);
#pragma unroll
                for (int rt = 0; rt < 2; ++rt) { f32x16 O;
#pragma unroll
                    for (int r = 0; r < 16; ++r) O[r] = 0.f;
#pragma unroll
                    for (int ks = 0; ks < 8; ++ks) O = MFMA32(SFRAG(SC_QD, rt * 8 + ks), Spk[ks], O);
#pragma unroll
                    for (int ks = 0; ks < 4; ++ks) O = MFMA32(SFRAG(SC_QK, rt * 4 + ks), Vpk[ks], O);
                    float* op = OG + ((size_t)bb * SEQ + n * 64 + rt * 32) * BW + h * 128 + sl * 32 + r32;
#pragma unroll
                    for (int i = 0; i < 16; ++i) op[(size_t)crow(i, hi) * BW] = O[i]; }
                const float g = *(const float*)(base + SC_GL);
#pragma unroll
                for (int b4 = 0; b4 < 4; ++b4) {
#pragma unroll
                    for (int r = 0; r < 16; ++r) S[b4][r] *= g;
#pragma unroll
                    for (int ks = 0; ks < 4; ++ks) S[b4] = MFMA32(SFRAG(SC_KDT, b4 * 4 + ks), Vpk[ks], S[b4]); }
#undef SFRAG
            }
            __syncthreads();
        }
#undef SC_FETCH
    }
    __syncthreads();
}

__device__ __forceinline__ void phase_finalize(const Args& a, int l, int wv_) {
    const bf16* P = (const bf16*)(a.ws + WS_PROJ); const float* OG = (const float*)(a.ws + WS_REGB); const float* OATT = (const float*)(a.ws + WS_REGC);
    bf16* Y = (bf16*)(a.ws + WS_REGD);
    int tid_ = wv_ * 64 + mk_lane(); asm volatile("" : "+v"(tid_)); const int tid = tid_, lane = tid & 63, wave = tid >> 6;
    const int gw = blockIdx.x * NWAVES + wave, NGW = gridDim.x * NWAVES;
    const float lam_init = 0.8f - 0.6f * expf(-0.3f * (float)l);
    const float* lv = a.diff_lambda + (size_t)l * 256;
    const float lam = expf(wave_sum(lv[lane] * lv[64 + lane])) - expf(wave_sum(lv[128 + lane] * lv[192 + lane])) + lam_init;
    const int e0 = (lane & 15) * 8, hh = lane >> 4, c0 = lane * 8;
    float gnw[8], dnw[8], scw[3][8];
#pragma unroll
    for (int j = 0; j < 8; ++j) { gnw[j] = a.gdn_norm_w[l * 128 + e0 + j]; dnw[j] = a.diff_norm_w[l * 128 + e0 + j] * (1.f - lam_init);
#pragma unroll
        for (int k = 0; k < 3; ++k) scw[k][j] = a.sc_conv_w[((size_t)l * 3 + k) * BW + c0 + j]; }
    for (int row = gw; row < M; row += NGW) {
        const int t = row & (SEQ - 1);
        const bf16* pr = P + (size_t)row * NP;
        float y[8], z[8];
        { const f32x4 o0 = *(const f32x4*)(OG + (size_t)row * BW + c0), o1 = *(const f32x4*)(OG + (size_t)row * BW + c0 + 4);
          float o[8] = {o0.x, o0.y, o0.z, o0.w, o1.x, o1.y, o1.z, o1.w}; float ss = 0.f;
#pragma unroll
          for (int j = 0; j < 8; ++j) ss += o[j] * o[j];
          ss += __shfl_xor(ss, 1); ss += __shfl_xor(ss, 2); ss += __shfl_xor(ss, 4); ss += __shfl_xor(ss, 8);
          const float rs = rsqrtf(ss * (1.f / 128.f) + EPS); ld8(pr + C_GZ + c0, z);
#pragma unroll
          for (int j = 0; j < 8; ++j) y[j] = o[j] * rs * gnw[j] * siluf_(z[j]);
          st8(Y + (size_t)row * BW + c0, y); }
        { const float* op = OATT + (((size_t)row * 4 + hh) * 2) * 128 + e0;
          const f32x4 a0 = *(const f32x4*)op, a1 = *(const f32x4*)(op + 4), b0 = *(const f32x4*)(op + 128), b1 = *(const f32x4*)(op + 132);
          float d[8] = {a0.x - lam * b0.x, a0.y - lam * b0.y, a0.z - lam * b0.z, a0.w - lam * b0.w, a1.x - lam * b1.x, a1.y - lam * b1.y, a1.z - lam * b1.z, a1.w - lam * b1.w}; float ss = 0.f;
#pragma unroll
          for (int j = 0; j < 8; ++j) ss += d[j] * d[j];
          ss += __shfl_xor(ss, 1); ss += __shfl_xor(ss, 2); ss += __shfl_xor(ss, 4); ss += __shfl_xor(ss, 8);
          const float rs = rsqrtf(ss * (1.f / 128.f) + EPS); ld8(pr + C_DZ + c0, z);
#pragma unroll
          for (int j = 0; j < 8; ++j) y[j] = d[j] * rs * dnw[j] * siluf_(z[j]);
          st8(Y + (size_t)M * BW + (size_t)row * BW + c0, y); }
        { float acc[8];
#pragma unroll
          for (int j = 0; j < 8; ++j) acc[j] = 0.f;
#pragma unroll
          for (int k = 0; k < 3; ++k) { const int tt = t - 2 + k; if (tt >= 0) { float cc[8], xx[8]; const bf16* p2 = P + (size_t)(row - 2 + k) * NP; ld8(p2 + C_SC + c0, cc); ld8(p2 + C_SX + c0, xx);
#pragma unroll
              for (int j = 0; j < 8; ++j) acc[j] += scw[k][j] * (cc[j] * xx[j]); } }
          float sb[8]; ld8(pr + C_SB + c0, sb); ld8(pr + C_SZ + c0, z);
#pragma unroll
          for (int j = 0; j < 8; ++j) y[j] = sb[j] * acc[j] * siluf_(z[j]);
          st8(Y + 2 * (size_t)M * BW + (size_t)row * BW + c0, y); }
    }
}

__device__ __forceinline__ void phase_postnorm(const Args& a, int l, int wv_) {
    const bf16* OUT = (const bf16*)(a.ws + WS_REGC); bf16* H = (bf16*)(a.ws + WS_REGB);
    const float* xin = (l == 0) ? a.x : a.out;
    int tid_ = wv_ * 64 + mk_lane(); asm volatile("" : "+v"(tid_)); const int tid = tid_, lane = tid & 63, wave = tid >> 6;
    const int gw = blockIdx.x * NWAVES + wave, NGW = gridDim.x * NWAVES;
    const float* wpost = a.norm_post + (size_t)l * DM; const float* wpre = a.norm_pre + (size_t)(l + 1 < DEPTH ? l + 1 : l) * DM;
    for (int row = gw; row < M; row += NGW) {
        f32x4 o[4], x[4]; float s = 0.f;
#pragma unroll
        for (int j = 0; j < 4; ++j) { { const v2u ow = *(const v2u*)(OUT + (size_t)row * DM + 4 * lane + 256 * j); o[j] = (f32x4){bflo(ow.x), bfhi(ow.x), bflo(ow.y), bfhi(ow.y)}; } x[j] = *(const f32x4*)(xin + (size_t)row * DM + 4 * lane + 256 * j);
            s += (o[j].x * o[j].x + o[j].y * o[j].y) + (o[j].z * o[j].z + o[j].w * o[j].w); }
        const float rs = rsqrtf(wave_sum(s) * (1.f / DM) + EPS); float s2 = 0.f;
#pragma unroll
        for (int j = 0; j < 4; ++j) { const f32x4 w = *(const f32x4*)(wpost + 4 * lane + 256 * j); x[j] = x[j] + o[j] * rs * w; *(f32x4*)(a.out + (size_t)row * DM + 4 * lane + 256 * j) = x[j];
            s2 += (x[j].x * x[j].x + x[j].y * x[j].y) + (x[j].z * x[j].z + x[j].w * x[j].w); }
        if (l + 1 < DEPTH) { const float rs2 = rsqrtf(wave_sum(s2) * (1.f / DM) + EPS);
#pragma unroll
            for (int j = 0; j < 4; ++j) { const f32x4 w = *(const f32x4*)(wpre + 4 * lane + 256 * j); v2u ob; ob.x = pk2(x[j].x * rs2 * w.x, x[j].y * rs2 * w.y); ob.y = pk2(x[j].z * rs2 * w.z, x[j].w * rs2 * w.w);
                *(v2u*)(H + (size_t)row * DM + 4 * lane + 256 * j) = ob; } }
    }
}

#define XB_TMO      128
#define XB_XCNT(j)  (256  + 64 * (j))
#define XB_XSUB(j)  (1280 + 64 * (j))
#define XB_XGEN(j)  (2304 + 64 * (j))
#define XB_TOP      3328
#define XB_TOPGEN   3392
#define XCD_BAR_WORDS 3456
#define XB_SPIN_CAP (1u << 18)

__device__ __forceinline__ unsigned xb_ld(unsigned* p)              { return __hip_atomic_load(p, __ATOMIC_RELAXED, __HIP_MEMORY_SCOPE_AGENT); }
__device__ __forceinline__ unsigned xb_add(unsigned* p, unsigned v) { return __hip_atomic_fetch_add(p, v, __ATOMIC_RELAXED, __HIP_MEMORY_SCOPE_AGENT); }
__device__ __forceinline__ unsigned xb_xcc_id() { return (unsigned)__builtin_amdgcn_s_getreg((3 << 11) | 20) & 0xFu; }
#define XB_SPIN(cond, bar) do { unsigned _sp = 0; while (cond) { __builtin_amdgcn_s_sleep(1); \
    if ((++_sp & 255u) == 0u) { if (xb_ld(&(bar)[XB_TMO])) break; if (_sp > XB_SPIN_CAP) { atomicAdd(&(bar)[XB_TMO], 1u); break; } } } } while (0)

struct XcdBarrier {
    unsigned* bar; unsigned x;
    volatile LAS unsigned* st;
};

__device__ __forceinline__ XcdBarrier xcd_barrier_post(unsigned* bar, volatile LAS unsigned* st) {
    XcdBarrier b; b.bar = bar; b.x = xb_xcc_id(); b.st = st;
    if (threadIdx.x == 0) (void)xb_add(&bar[XB_XCNT(b.x)], 1u);
    return b;
}
__device__ __forceinline__ void xcd_barrier_complete(unsigned* bar, unsigned x, unsigned& nloc, unsigned& nx) {
    const unsigned G = gridDim.x * gridDim.y * gridDim.z;
    unsigned sum, cnt, mine, sp = 0u;
    for (;;) {
        sum = 0u; cnt = 0u; mine = 0u;
#pragma unroll
        for (unsigned j = 0; j < 16; ++j) { const unsigned c = xb_ld(&bar[XB_XCNT(j)]); sum += c; cnt += (c > 0u) ? 1u : 0u; mine = (j == x) ? c : mine; }
        if (sum == G) break;
        __builtin_amdgcn_s_sleep(1);
        if ((++sp & 255u) == 0u) { if (xb_ld(&bar[XB_TMO])) break; if (sp > XB_SPIN_CAP) { atomicAdd(&bar[XB_TMO], 1u); break; } }
    }
    nloc = mine > 0u ? mine : 1u; nx = cnt > 0u ? cnt : 1u;
}

__device__ __forceinline__ void xcd_barrier(const XcdBarrier& b) {
    asm volatile("s_waitcnt vmcnt(0)" ::: "memory");
    __syncthreads();
    if (threadIdx.x == 0) {
        unsigned* bar = b.bar;
        __builtin_amdgcn_s_waitcnt(0);
        unsigned nloc = b.st[0], nx = b.st[1];
        if (nloc == 0u) { xcd_barrier_complete(bar, b.x, nloc, nx); b.st[0] = nloc; b.st[1] = nx; }
        const unsigned old = xb_add(&bar[XB_XSUB(b.x)], 1u);
        const unsigned gen = old / nloc;
        if (old + 1u == (gen + 1u) * nloc) {
            __builtin_amdgcn_fence(__ATOMIC_RELEASE, "agent");
            asm volatile("s_waitcnt vmcnt(0)" ::: "memory");
            const unsigned og = xb_add(&bar[XB_TOP], 1u);
            const unsigned tg = og / nx;
            if (og + 1u == (tg + 1u) * nx) xb_add(&bar[XB_TOPGEN], 1u);
            else XB_SPIN(xb_ld(&bar[XB_TOPGEN]) == tg, bar);
            __builtin_amdgcn_fence(__ATOMIC_ACQUIRE, "agent");
            xb_add(&bar[XB_XGEN(b.x)], 1u);
            asm volatile("s_waitcnt vmcnt(0)" ::: "memory");
        } else {
            XB_SPIN(xb_ld(&bar[XB_XGEN(b.x)]) == gen, bar);
            __builtin_amdgcn_fence(__ATOMIC_ACQUIRE, "agent");
            asm volatile("s_waitcnt vmcnt(0)" ::: "memory");
        }
    }
    __syncthreads();
}

constexpr int XB_ST_OFF = 143360 + 1024;
constexpr int XB_WORD0 = 4096;
constexpr int ARGS_OFF = 143360;
constexpr int ARGS_WORDS = (int)(sizeof(Args) / 4);
#ifndef PROBE_SEL
#define PROBE_SEL -1
#endif
constexpr int TS_OFF = ARGS_OFF + 512;
__device__ __forceinline__ void ts_mark(unsigned char* lds, int k) {
    if (PROBE_SEL >= 0 && blockIdx.x == 0 && threadIdx.x == 0) { volatile LAS unsigned long long* p = (volatile LAS unsigned long long*)((LAS unsigned char*)lds + TS_OFF);
        const unsigned long long t = __builtin_amdgcn_s_memrealtime(); p[1 + k] += t - p[0]; p[0] = t; }
}
__device__ __forceinline__ void load_args(Args& b, unsigned char* lds) {
    volatile LAS unsigned* s = (volatile LAS unsigned*)((LAS unsigned char*)lds + ARGS_OFF); unsigned w[ARGS_WORDS];
#pragma unroll
    for (int i = 0; i < ARGS_WORDS; ++i) w[i] = (unsigned)__builtin_amdgcn_readfirstlane((int)s[i]);
    __builtin_memcpy(&b, w, sizeof(Args));
}
__device__ __forceinline__ void grid_bar(unsigned char* lds) {
    Args a; load_args(a, lds);
    XcdBarrier b; b.bar = (unsigned*)(a.ws + WS_CTL) + XB_WORD0; b.x = xb_xcc_id(); b.st = (volatile LAS unsigned*)((LAS unsigned char*)lds + XB_ST_OFF);
    xcd_barrier(b);
}
template <int L> __device__ __forceinline__ void run_layer(unsigned char* lds, cg::grid_group& grid, int wv) {
    PG8_LAS unsigned char* lds3 = (PG8_LAS unsigned char*)lds;
    constexpr int l = L;
    {
        Args a; load_args(a, lds); const int G = gridDim.x;
        bf16* WIN = (bf16*)(a.ws + WS_WIN); bf16* PROJ = (bf16*)(a.ws + WS_PROJ); float* BA = (float*)(a.ws + WS_BA); bf16* REGB = (bf16*)(a.ws + WS_REGB);
        pg8::Gemm g{REGB, WIN + (size_t)l * WIN_L, M, NPAD, DM}; pg8::StaticOrder S; S.init(M, NPAD, G, (int)blockIdx.x);
        EpiProj E{PROJ, BA};
        pg8::gemm_phase<EpiProj, pg8::StaticOrder, true, true>(lds3, g, S, E, wv);
    }
    { Args a; load_args(a, lds); phase_ba(a, l, wv); }
    grid_bar(lds);
    ts_mark(lds, 1);
    { Args a; load_args(a, lds); phase_gdn_local(a, lds, l, wv); }
    grid_bar(lds);
    ts_mark(lds, 2);
    { Args a; load_args(a, lds); phase_gdn_scan(a, lds, l, wv); }
    ts_mark(lds, 4);
    { Args a; load_args(a, lds); phase_attn(a, lds, l, wv); }
    grid_bar(lds);
    ts_mark(lds, 3);
    { Args a; load_args(a, lds); phase_finalize(a, l, wv); }
    grid_bar(lds);
    ts_mark(lds, 5);
    {
        Args a; load_args(a, lds); const int G = gridDim.x;
        bf16* WBR = (bf16*)(a.ws + WS_WBR); bf16* PROJ = (bf16*)(a.ws + WS_PROJ); bf16* REGB = (bf16*)(a.ws + WS_REGB); float* REGC = (float*)(a.ws + WS_REGC); bf16* Y = (bf16*)(a.ws + WS_REGD);
        pg8::StaticOrder S0; S0.init(M, DM, G, (int)blockIdx.x); pg8::Unit u0; BranchOrder S{0, 0};
        if (S0.next(0, u0)) { S.pm0 = u0.pm; S.pn0 = u0.pn; }
        pg8::Gemm g{Y, WBR + (size_t)l * 3 * DM * BW, 3 * M, 3 * DM, BW}; EpiBranch E{PROJ, REGC, REGB};
        pg8::gemm_phase<EpiBranch, BranchOrder, true, true>(lds3, g, S, E, wv);
    }
    grid_bar(lds);
    ts_mark(lds, 6);
    {
        Args a; load_args(a, lds); const int G = gridDim.x;
        bf16* WOUT = (bf16*)(a.ws + WS_WOUT); bf16* REGB = (bf16*)(a.ws + WS_REGB); float* REGC = (float*)(a.ws + WS_REGC);
        pg8::Gemm g{REGB, WOUT + (size_t)l * DM * DM, M, DM, DM}; pg8::StaticOrder S; S.init(M, DM, G, (int)blockIdx.x);
        EpiOutBf16 E{(bf16*)REGC};
        pg8::gemm_phase<EpiOutBf16, pg8::StaticOrder, true, true>(lds3, g, S, E, wv);
    }
    grid_bar(lds);
    ts_mark(lds, 7);
    { Args a; load_args(a, lds); phase_postnorm(a, l, wv); }
    if (L + 1 < DEPTH) grid_bar(lds);
    ts_mark(lds, 8);
}
__global__ void __launch_bounds__(NTHR, 2) fwd(Args a0) {
    extern __shared__ __attribute__((aligned(16))) unsigned char lds[];
    cg::grid_group grid = cg::this_grid();
    const int wv = __builtin_amdgcn_readfirstlane((int)threadIdx.x >> 6);
    if (threadIdx.x < 2) ((volatile LAS unsigned*)((LAS unsigned char*)lds + XB_ST_OFF))[threadIdx.x] = 0u;
    __syncthreads();
    (void)xcd_barrier_post((unsigned*)(a0.ws + WS_CTL) + XB_WORD0, (volatile LAS unsigned*)((LAS unsigned char*)lds + XB_ST_OFF));
    if (threadIdx.x == 0) { unsigned w[ARGS_WORDS]; __builtin_memcpy(w, &a0, sizeof(Args));
#pragma unroll
        for (int i = 0; i < ARGS_WORDS; ++i) ((volatile LAS unsigned*)((LAS unsigned char*)lds + ARGS_OFF))[i] = w[i]; }
    if (PROBE_SEL >= 0 && threadIdx.x == 0) { volatile LAS unsigned long long* p = (volatile LAS unsigned long long*)((LAS unsigned char*)lds + TS_OFF); for (int i = 1; i < 17; ++i) p[i] = 0; p[0] = __builtin_amdgcn_s_memrealtime(); }
    __syncthreads();
    { Args a; load_args(a, lds); phase_prologue(a, lds, wv); }
    grid.sync();
    ts_mark(lds, 0);
    run_layer<0>(lds, grid, wv);
    run_layer<1>(lds, grid, wv);
    run_layer<2>(lds, grid, wv);
    run_layer<3>(lds, grid, wv);
    if (PROBE_SEL >= 0 && blockIdx.x == 0 && threadIdx.x == 0) { volatile LAS unsigned long long* p = (volatile LAS unsigned long long*)((LAS unsigned char*)lds + TS_OFF);
        Args a; load_args(a, lds); a.out[0] = floorf((float)p[1 + PROBE_SEL] * 0.01f * 0.02f + 0.5f) * 50.f; }
}

extern "C" void kernel_launch(void* const* d_in, const int* in_sizes, int n_in, void* d_out, int out_size, void* d_ws, size_t ws_size, hipStream_t stream) {
    static int grid = 0;
    if (grid == 0) {
        if (n_in != 13 || ws_size < WS_END) { fprintf(stderr, "kernel_launch: unexpected n_in %d or ws %zu\n", n_in, ws_size); grid = -1; return; }
        int dev = 0, cus = 0, per_cu = 0;
        hipGetDevice(&dev); hipDeviceGetAttribute(&cus, hipDeviceAttributeMultiprocessorCount, dev);
        hipFuncSetAttribute((const void*)fwd, hipFuncAttributeMaxDynamicSharedMemorySize, LDS_BYTES);
        hipOccupancyMaxActiveBlocksPerMultiprocessor(&per_cu, (const void*)fwd, NTHR, LDS_BYTES);
        (void)hipGetLastError();
        if (per_cu < 1) { fprintf(stderr, "kernel_launch: occupancy query says %d\n", per_cu); per_cu = 1; }
        grid = cus;
    }
    if (grid < 0) return;
    Args a{};
    a.x = (const float*)d_in[0]; a.norm_pre = (const float*)d_in[1]; a.norm_post = (const float*)d_in[2]; a.w_in = (const float*)d_in[3]; a.gdn_conv_w = (const float*)d_in[4];
    a.gdn_a_log = (const float*)d_in[5]; a.gdn_dt_bias = (const float*)d_in[6]; a.gdn_norm_w = (const float*)d_in[7]; a.diff_lambda = (const float*)d_in[8]; a.diff_norm_w = (const float*)d_in[9];
    a.sc_conv_w = (const float*)d_in[10]; a.w_branch = (const float*)d_in[11]; a.w_out = (const float*)d_in[12];
    a.out = (float*)d_out; a.ws = (unsigned char*)d_ws; a.ph_lo = 0; a.ph_hi = 0; a.coop = 1; a.pad = 0;
    if (hipMemsetAsync((char*)d_ws + WS_CTL, 0, 65536, stream) != hipSuccess) { fprintf(stderr, "kernel_launch: memset of the control words failed\n"); return; }
    void* args[] = {&a};
    hipError_t e = hipLaunchCooperativeKernel((const void*)fwd, dim3(grid), dim3(NTHR), args, LDS_BYTES, stream);
    if (e != hipSuccess) fprintf(stderr, "cooperative launch failed: %s (grid %d)\n", hipGetErrorString(e), grid);
}
```
